# Optimizing an MI355X kernel written in HIP

```python
import jax, jax.numpy as jnp
from jax import lax
import numpy as np

D_MODEL = 1024
BATCH = 32
SEQ = 2048
DEPTH = 2

CHUNK = 64
HEAD_DIM = 64
POOL_WIDTH = D_MODEL // 4
POOL_WINDOWS = (2, 4, 8, 16)
POOL_GROUPS = len(POOL_WINDOWS)
POOL_GROUP_DIM = POOL_WIDTH // POOL_GROUPS
SGU_WIDTH = D_MODEL // 4
SGU_HEADS = SGU_WIDTH // HEAD_DIM
SGU_BLOCK = 2 * CHUNK
SB_WIDTH = D_MODEL - POOL_WIDTH - SGU_WIDTH
SB_HEADS = SB_WIDTH // HEAD_DIM
ATTN_BLOCK = 2 * CHUNK
IN_WIDTHS = (POOL_WIDTH, POOL_WIDTH,
             SGU_WIDTH, SGU_WIDTH, SGU_WIDTH,
             SB_WIDTH, SB_WIDTH, SB_WIDTH, SB_WIDTH)
IN_WIDTH = sum(IN_WIDTHS)
DN_ALPHA = (2 * DEPTH) ** 0.25
DN_BETA = (8 * DEPTH) ** -0.25
LN_EPS = 1e-5

kernel_name = "hybrid_pool_sgu_stickbreak_deepnorm_adaln"


def _layer_norm(x, g, b):
    xf = x.astype(jnp.float32)
    mu = jnp.mean(xf, axis=-1, keepdims=True)
    var = jnp.mean(jnp.square(xf - mu), axis=-1, keepdims=True)
    y = (xf - mu) * lax.rsqrt(var + LN_EPS)
    return (y * g.astype(jnp.float32) + b.astype(jnp.float32)).astype(x.dtype)


def _pool_mixer(a, w, scale):
    B, S, _ = a.shape
    af = a.astype(jnp.float32)
    cs = jnp.cumsum(af, axis=1)
    pos = jnp.arange(S)
    means = []
    for g, win in enumerate(POOL_WINDOWS):
        csg = cs[..., g * POOL_GROUP_DIM:(g + 1) * POOL_GROUP_DIM]
        lag = jnp.pad(csg, ((0, 0), (win, 0), (0, 0)))[:, :S]
        cnt = jnp.minimum(pos + 1, win).astype(jnp.float32)[None, :, None]
        means.append((csg - lag) / cnt)
    mean = jnp.stack(means, axis=2)
    d = (mean - af.reshape(B, S, POOL_GROUPS, POOL_GROUP_DIM)).astype(a.dtype)
    y = jnp.einsum('bsgc,gcd->bsgd', d, w).reshape(B, S, POOL_WIDTH)
    return y * scale


def _spatial_gating(u, v, ln_g, ln_b, w_s, b_s):
    B, S, _ = u.shape
    v = _layer_norm(v, ln_g, ln_b)
    t = jnp.arange(SGU_BLOCK)
    mask = (t[None, :] // CHUNK) <= (t[:, None] // CHUNK)
    w = jnp.where(mask[None], w_s, 0.0)
    vb = v.reshape(B, S // SGU_BLOCK, SGU_BLOCK, SGU_HEADS, HEAD_DIM)
    mixed = jnp.einsum('hts,bnshd->bnthd', w, vb) + b_s.T[None, None, :, :, None]
    return u * mixed.reshape(B, S, SGU_WIDTH)


def _stick_breaking(q, k, v):
    B, S, _ = q.shape
    q = q.reshape(B, S, SB_HEADS, HEAD_DIM).transpose(0, 2, 1, 3)
    k = k.reshape(B, S, SB_HEADS, HEAD_DIM).transpose(0, 2, 1, 3)
    v = v.reshape(B, S, SB_HEADS, HEAD_DIM).transpose(0, 2, 1, 3)
    inv_sqrt_d = HEAD_DIM ** -0.5
    outs = []
    for i in range(S // ATTN_BLOCK):
        start = i * ATTN_BLOCK
        end = start + ATTN_BLOCK
        qb = q[:, :, start:end]
        kb = k[:, :, :end]
        vb = v[:, :, :end]
        z = jnp.einsum('bhtd,bhsd->bhts', qb, kb).astype(jnp.float32) * inv_sqrt_d
        tpos = start + jnp.arange(ATTN_BLOCK)
        spos = jnp.arange(end)
        mask = spos[None, :] < tpos[:, None]
        log_beta = jax.nn.log_sigmoid(z)
        log_1m_beta = jnp.where(mask, log_beta - z, 0.0)
        later = lax.cumsum(log_1m_beta, axis=3, reverse=True) - log_1m_beta
        a = jnp.where(mask, jnp.exp(log_beta + later), 0.0)
        outs.append(jnp.einsum('bhts,bhsd->bhtd', a.astype(v.dtype), vb))
    o = jnp.concatenate(outs, axis=2)
    return o.transpose(0, 2, 1, 3).reshape(B, S, SB_WIDTH)


def setup_inputs(seed: int = 0) -> dict:
    key = jax.random.key(seed)
    ks = jax.random.split(key, 16)
    f32 = jnp.float32
    nrm = lambda k, shape, s: jax.random.normal(k, shape, f32) * s
    x = jax.random.normal(ks[0], (BATCH, SEQ, D_MODEL), f32)
    c = jax.random.normal(ks[1], (BATCH, D_MODEL), f32)
    w_in = nrm(ks[2], (DEPTH, D_MODEL, IN_WIDTH), D_MODEL ** -0.5)
    pool_w = nrm(ks[3], (DEPTH, POOL_GROUPS, POOL_GROUP_DIM, POOL_GROUP_DIM), POOL_GROUP_DIM ** -0.5)
    pool_scale = 1.0 + nrm(ks[4], (DEPTH, POOL_WIDTH), 0.05)
    sgu_ln_g = 1.0 + nrm(ks[5], (DEPTH, SGU_WIDTH), 0.02)
    sgu_ln_b = nrm(ks[6], (DEPTH, SGU_WIDTH), 0.02)
    sgu_w = nrm(ks[7], (DEPTH, SGU_HEADS, SGU_BLOCK, SGU_BLOCK), SGU_BLOCK ** -0.5)
    sgu_b = 1.0 + nrm(ks[8], (DEPTH, SGU_HEADS, SGU_BLOCK), 0.02)
    w_out = nrm(ks[9], (DEPTH, D_MODEL, D_MODEL), DN_BETA * D_MODEL ** -0.5)
    ada_w = nrm(ks[10], (DEPTH, D_MODEL, 3 * D_MODEL), D_MODEL ** -0.5)
    ada_b = nrm(ks[11], (DEPTH, 3 * D_MODEL), 0.02)
    ln_g = 1.0 + nrm(ks[12], (DEPTH, D_MODEL), 0.02)
    ln_b = nrm(ks[13], (DEPTH, D_MODEL), 0.02)
    return {"x": x, "c": c, "w_in": w_in, "pool_w": pool_w, "pool_scale": pool_scale,
            "sgu_ln_g": sgu_ln_g, "sgu_ln_b": sgu_ln_b, "sgu_w": sgu_w, "sgu_b": sgu_b,
            "w_out": w_out, "ada_w": ada_w, "ada_b": ada_b, "ln_g": ln_g, "ln_b": ln_b}


def reference(x, c, w_in, pool_w, pool_scale, sgu_ln_g, sgu_ln_b, sgu_w, sgu_b,
              w_out, ada_w, ada_b, ln_g, ln_b):
    splits = list(np.cumsum(IN_WIDTHS)[:-1])
    for l in range(DEPTH):
        mod = jax.nn.silu(c) @ ada_w[l] + ada_b[l]
        shift, scale, gate = jnp.split(mod, 3, axis=-1)
        h = x * (1.0 + scale[:, None, :]) + shift[:, None, :]
        p = h @ w_in[l]
        a, g_a, u, v_sg, g_b, q, k, v_sb, g_c = jnp.split(p, splits, axis=-1)
        y_a = _pool_mixer(a, pool_w[l], pool_scale[l]) * jax.nn.silu(g_a)
        y_b = _spatial_gating(u, v_sg, sgu_ln_g[l], sgu_ln_b[l], sgu_w[l], sgu_b[l]) * jax.nn.silu(g_b)
        y_c = _stick_breaking(q, k, v_sb) * jax.nn.silu(g_c)
        y = jnp.concatenate([y_a, y_b, y_c], axis=-1) @ w_out[l]
        x = _layer_norm(DN_ALPHA * x + gate[:, None, :] * y, ln_g[l], ln_b[l])
    return x
```

```cpp
#include <hip/hip_runtime.h>
#include <hip/hip_cooperative_groups.h>
#include <cstdio>
#include <cstdint>
namespace cg = cooperative_groups;
__device__ __forceinline__ int launder_v(int x) { asm volatile("" : "+v"(x)); return x; }
__device__ __forceinline__ int launder_s(int x) { asm volatile("" : "+s"(x)); return x; }
namespace pg8 {
#define PG8_LAS __attribute__((address_space(3)))
typedef unsigned short bf16_t;
typedef short bf16x8 __attribute__((ext_vector_type(8)));
typedef float f32x4 __attribute__((ext_vector_type(4)));
typedef unsigned u32x4 __attribute__((ext_vector_type(4)));
constexpr int BM = 256, BK = 64, HALF = 128, HTB = HALF * BK * 2  , STAGE_BYTES = 8 * HTB, NXCD = 8, WGM = 8;

__host__ __device__ __forceinline__ int lds_byte(int r, int c) { const int st = (r >> 4) * 2 + (c >> 5), rr = r & 15, cc = c & 31, ob = rr * 64 + cc * 2; return st * 1024 + (ob ^ (((ob >> 9) & 1) << 5)); }
__host__ __device__ __forceinline__ void stage_rc(int b, int& R, int& C) { const int st = b / 1024, sb = b % 1024, swz = sb ^ (((sb >> 9) & 1) << 5); R = (st >> 1) * 16 + swz / 64; C = (st & 1) * 32 + (swz % 64) / 2; }
__host__ __device__ __forceinline__ int perm32(int rho) { const int n = rho >> 4, i = rho & 15; return 8 * (i >> 2) + 4 * n + (i & 3); }

struct Unit { int pm, pn; };
struct Gemm { const bf16_t* A; const bf16_t* Bt; int M, N, K; };

struct StaticOrder {
    int nM, nN, nwg, G, c;
    __host__ __device__ void init(int M, int N, int G_, int c_) { nM = M / BM; nN = N / BM; nwg = nM * nN; G = G_; c = c_; }
    __host__ __device__ bool next(int i, Unit& u) const {
        const long L = (long)i * G + c; if (L >= nwg) return false;
        int wgid = (int)L; { const int q = nwg / NXCD, r = nwg % NXCD, xcd = wgid % NXCD, off = wgid / NXCD; wgid = (xcd < r ? xcd * (q + 1) : r * (q + 1) + (xcd - r) * q) + off; }
        const int nig = WGM * nN, gid = wgid / nig, fm = gid * WGM, gsz = (nM - fm) < WGM ? (nM - fm) : WGM;
        u.pm = fm + ((wgid % nig) % gsz); u.pn = (wgid % nig) / gsz; return true;
    }
    __device__ __forceinline__ void a_ready(const Unit&) const {}
    __device__ __forceinline__ void done(const Unit&) const {}
};

__device__ __forceinline__ unsigned cvt_pk_bf16(float lo, float hi) { unsigned r; asm volatile("v_cvt_pk_bf16_f32 %0, %1, %2" : "=v"(r) : "v"(lo), "v"(hi)); return r; }
template <class Epi, class Sched, bool ALIGN_EPI = false, bool SP2 = false>
__device__ __forceinline__ void gemm_phase(PG8_LAS unsigned char* lds, const Gemm g, const Sched& S, const Epi& E) {
    const int tid = launder_v(threadIdx.x), wid = __builtin_amdgcn_readfirstlane(tid >> 6), lane = tid & 63, wr = wid >> 2, wc = wid & 3, fr = lane & 15, fq = lane >> 4;
    const int K = g.K, nt = K / BK;
    unsigned voffA[2], voffB[2];
#pragma unroll
    for (int i = 0; i < 2; ++i) { int R, C; stage_rc(tid * 16 + i * 8192, R, C); const int Rb = Epi::PERM ? ((R & ~31) + perm32(R & 31)) : R;
        voffA[i] = (unsigned)(R * K + C) * 2u; voffB[i] = (unsigned)(Rb * K + C) * 2u; }
    const size_t kstep = (size_t)(BK * 2);
    const size_t hstep = (size_t)HALF * K * 2;
    const size_t tstep = 2 * hstep;
    const unsigned ldsw = (unsigned)wid * 1024u;
    const int aoff = lds_byte(wr * 64 + fr, fq * 8), boff = lds_byte(wc * 32 + fr, fq * 8);
#define PG8_SA(b, h) (((b) * 2 + (h)) * HTB)
#define PG8_SB(b, h) ((4 + (b) * 2 + (h)) * HTB)
#define PG8_STAGE(bufoff, gbase, voff) do { _Pragma("unroll") for (int _i = 0; _i < 2; ++_i) \
        __builtin_amdgcn_global_load_lds((const unsigned*)((const char*)(gbase) + (voff)[_i]), (PG8_LAS unsigned*)(lds + (bufoff) + ldsw + _i * 8192), 16, 0, 0); } while (0)
#define PG8_LDA(dst, b, h) do { _Pragma("unroll") for (int m = 0; m < 4; ++m) _Pragma("unroll") for (int k = 0; k < 2; ++k) dst[m][k] = *(const PG8_LAS bf16x8*)(lds + PG8_SA(b, h) + aoff + m * 2048 + k * 1024); } while (0)
#define PG8_LDB(dst, b, h) do { _Pragma("unroll") for (int n = 0; n < 2; ++n) _Pragma("unroll") for (int k = 0; k < 2; ++k) dst[n][k] = *(const PG8_LAS bf16x8*)(lds + PG8_SB(b, h) + boff + n * 2048 + k * 1024); } while (0)
#define PG8_MMA(ai, bj, At, Bt) do { __builtin_amdgcn_s_setprio(1); _Pragma("unroll") for (int m = 0; m < 4; ++m) _Pragma("unroll") for (int n = 0; n < 2; ++n) _Pragma("unroll") for (int k = 0; k < 2; ++k) \
        acc[ai][bj][m][n] = __builtin_amdgcn_mfma_f32_16x16x32_bf16(Bt[n][k], At[m][k], acc[ai][bj][m][n], 0, 0, 0); __builtin_amdgcn_s_setprio(0); } while (0)
#define PG8_WAIT_V(n) asm volatile("s_waitcnt vmcnt(" #n ")" ::: "memory")
#define PG8_WAIT_L(n) asm volatile("s_waitcnt lgkmcnt(" #n ")" ::: "memory")
#define PG8_BAR __builtin_amdgcn_s_barrier()
#define PG8_SCHED __builtin_amdgcn_sched_barrier(0)
    Unit cur, nxt; int ui = 0;
    if (!S.next(0, cur)) return;
    f32x4 acc[2][2][4][2];
#pragma unroll
    for (int a = 0; a < 2; ++a)
#pragma unroll
        for (int b = 0; b < 2; ++b)
#pragma unroll
            for (int m = 0; m < 4; ++m)
#pragma unroll
                for (int n = 0; n < 2; ++n) acc[a][b][m][n] = (f32x4){0.f, 0.f, 0.f, 0.f};
    bf16x8 At[4][2], B0[2][2], B1[2][2];
    const char* cA = (const char*)g.A + (size_t)cur.pm * tstep; const char* cB = (const char*)g.Bt + (size_t)cur.pn * tstep;
    S.a_ready(cur);
    if constexpr (SP2) {
        PG8_STAGE(PG8_SB(0, 0), cB, voffB); PG8_STAGE(PG8_SB(0, 1), cB + hstep, voffB); PG8_STAGE(PG8_SA(0, 0), cA, voffA); PG8_STAGE(PG8_SA(0, 1), cA + hstep, voffA);
        if (wr == 1) PG8_BAR;
        PG8_WAIT_V(2); PG8_BAR;
        PG8_STAGE(PG8_SB(1, 0), cB + kstep, voffB); PG8_STAGE(PG8_SA(1, 0), cA + kstep, voffA); PG8_STAGE(PG8_SB(1, 1), cB + hstep + kstep, voffB);
        PG8_WAIT_V(6); PG8_BAR;
    } else {
        PG8_STAGE(PG8_SB(0, 0), cB, voffB); PG8_STAGE(PG8_SA(0, 0), cA, voffA); PG8_STAGE(PG8_SB(0, 1), cB + hstep, voffB); PG8_STAGE(PG8_SA(0, 1), cA + hstep, voffA);
        if (wr == 1) PG8_BAR;
        PG8_WAIT_V(4); PG8_BAR;
        PG8_STAGE(PG8_SB(1, 0), cB + kstep, voffB); PG8_STAGE(PG8_SA(1, 0), cA + kstep, voffA); PG8_STAGE(PG8_SB(1, 1), cB + hstep + kstep, voffB);
        PG8_WAIT_V(6); PG8_BAR;
    }
    for (;;) {
        const bool has_next = S.next(ui + 1, nxt);
        const char* nA = has_next ? (const char*)g.A + (size_t)nxt.pm * tstep : cA; const char* nB = has_next ? (const char*)g.Bt + (size_t)nxt.pn * tstep : cB;
        for (int t = 0; t < nt; t += 2) {
            const bool last = (t == nt - 2);
            const char* a1 = cA + (size_t)(t + 1) * kstep;
            const char* a2 = last ? nA : cA + (size_t)(t + 2) * kstep; const char* b2 = last ? nB : cB + (size_t)(t + 2) * kstep;
            const char* a3 = a2 + kstep; const char* b3 = b2 + kstep;
            if (last && has_next) S.a_ready(nxt);
            if constexpr (SP2) {
            PG8_LDB(B0, 0, 0); PG8_LDB(B1, 0, 1); PG8_SCHED; PG8_LDA(At, 0, 0); PG8_STAGE(PG8_SA(1, 1), a1 + hstep, voffA);
            PG8_WAIT_V(8); PG8_WAIT_L(0); PG8_BAR; PG8_MMA(0, 0, At, B0); PG8_MMA(0, 1, At, B1); PG8_BAR; PG8_SCHED;
            PG8_LDA(At, 0, 1); PG8_STAGE(PG8_SB(0, 0), b2, voffB); PG8_STAGE(PG8_SB(0, 1), b2 + hstep, voffB); PG8_STAGE(PG8_SA(0, 0), a2, voffA);
            PG8_WAIT_V(8); PG8_WAIT_L(0); PG8_BAR; PG8_MMA(1, 0, At, B0); PG8_MMA(1, 1, At, B1); PG8_BAR; PG8_SCHED;
            PG8_LDB(B0, 1, 0); PG8_LDB(B1, 1, 1); PG8_SCHED; PG8_LDA(At, 1, 0); PG8_STAGE(PG8_SA(0, 1), a2 + hstep, voffA);
            PG8_WAIT_V(8); PG8_WAIT_L(0); PG8_BAR; PG8_MMA(0, 0, At, B0); PG8_MMA(0, 1, At, B1); PG8_BAR; PG8_SCHED;
            PG8_LDA(At, 1, 1); PG8_STAGE(PG8_SB(1, 0), b3, voffB); PG8_STAGE(PG8_SB(1, 1), b3 + hstep, voffB); PG8_STAGE(PG8_SA(1, 0), a3, voffA);
            PG8_WAIT_V(8); PG8_WAIT_L(0); PG8_BAR; PG8_MMA(1, 0, At, B0); PG8_MMA(1, 1, At, B1); PG8_BAR; PG8_SCHED;
            } else {
            PG8_LDB(B0, 0, 0); PG8_SCHED; PG8_LDA(At, 0, 0); PG8_STAGE(PG8_SA(1, 1), a1 + hstep, voffA);
            PG8_WAIT_L(8); PG8_BAR; PG8_WAIT_L(0); PG8_MMA(0, 0, At, B0); PG8_BAR; PG8_SCHED;
            PG8_LDB(B1, 0, 1); PG8_STAGE(PG8_SB(0, 0), b2, voffB);
            PG8_BAR; PG8_WAIT_L(0); PG8_MMA(0, 1, At, B1); PG8_BAR;
            PG8_LDA(At, 0, 1); PG8_STAGE(PG8_SA(0, 0), a2, voffA);
            PG8_BAR; PG8_WAIT_L(0); PG8_MMA(1, 0, At, B0); PG8_BAR; PG8_SCHED;
            PG8_STAGE(PG8_SB(0, 1), b2 + hstep, voffB);
            PG8_WAIT_V(6); PG8_BAR; PG8_MMA(1, 1, At, B1); PG8_BAR;
            PG8_LDB(B0, 1, 0); PG8_SCHED; PG8_LDA(At, 1, 0); PG8_STAGE(PG8_SA(0, 1), a2 + hstep, voffA);
            PG8_WAIT_L(8); PG8_BAR; PG8_WAIT_L(0); PG8_MMA(0, 0, At, B0); PG8_BAR; PG8_SCHED;
            PG8_LDB(B1, 1, 1); PG8_STAGE(PG8_SB(1, 0), b3, voffB);
            PG8_BAR; PG8_WAIT_L(0); PG8_MMA(0, 1, At, B1); PG8_BAR;
            PG8_LDA(At, 1, 1); PG8_STAGE(PG8_SA(1, 0), a3, voffA);
            PG8_BAR; PG8_WAIT_L(0); PG8_MMA(1, 0, At, B0); PG8_BAR; PG8_SCHED;
            PG8_STAGE(PG8_SB(1, 1), b3 + hstep, voffB);
            PG8_WAIT_V(6); PG8_BAR; PG8_MMA(1, 1, At, B1); PG8_BAR;
            }
        }
        if constexpr (ALIGN_EPI) { if (wr == 0) PG8_BAR; }
        if constexpr (!Epi::AFTER_DRAIN) { E(acc, cur, wr, wc, fr, fq); S.done(cur); }
        if (!has_next) break;
#pragma unroll
        for (int a = 0; a < 2; ++a)
#pragma unroll
            for (int b = 0; b < 2; ++b)
#pragma unroll
                for (int m = 0; m < 4; ++m)
#pragma unroll
                    for (int n = 0; n < 2; ++n) acc[a][b][m][n] = (f32x4){0.f, 0.f, 0.f, 0.f};
        cur = nxt; cA = nA; cB = nB; ++ui;
        if constexpr (ALIGN_EPI) { if (wr == 1) PG8_BAR; }
    }
    PG8_WAIT_V(0);
    if constexpr (!ALIGN_EPI) { if (wr == 0) PG8_BAR; }
    PG8_BAR;
    if constexpr (Epi::AFTER_DRAIN) { E.fused(acc, cur, wr, wc, fr, fq, lds, wid, lane); S.done(cur); }
#undef PG8_SA
#undef PG8_SB
#undef PG8_STAGE
#undef PG8_LDA
#undef PG8_LDB
#undef PG8_MMA
#undef PG8_WAIT_V
#undef PG8_WAIT_L
#undef PG8_BAR
#undef PG8_SCHED
}
}

#define DI __device__ __forceinline__
#define LAS __attribute__((address_space(3)))
typedef unsigned short bf16_t;
typedef short bf16x8 __attribute__((ext_vector_type(8)));
typedef float f32x4 __attribute__((ext_vector_type(4)));
typedef float f32x16 __attribute__((ext_vector_type(16)));
typedef unsigned u32x4 __attribute__((ext_vector_type(4)));
typedef unsigned u32x2 __attribute__((ext_vector_type(2)));
typedef __bf16 bf16x2_t __attribute__((ext_vector_type(2)));
typedef float f32x2_t __attribute__((ext_vector_type(2)));

constexpr int D = 1024, BATCH = 32, SEQ = 2048, MTOK = BATCH * SEQ, NIN = 3328, DEPTH = 2;
constexpr int C_A = 0, C_GA = 256, C_U = 512, C_VS = 768, C_GB = 1024, C_Q = 1280, C_K = 1792, C_V = 2304, C_GC = 2816;
constexpr float DN_ALPHA = 1.41421356237309515f;
constexpr float LN_EPS = 1e-5f;
constexpr float LOG2E = 1.44269504088896341f;

constexpr size_t WS_WIN = 0;
constexpr size_t WS_WOUT = WS_WIN + (size_t)DEPTH * NIN * D * 2;
constexpr size_t WS_MOD = WS_WOUT + (size_t)DEPTH * D * D * 2;
constexpr size_t WS_HB = WS_MOD + (size_t)DEPTH * BATCH * 3 * D * 4;
constexpr size_t WS_P = WS_HB + (size_t)MTOK * D * 2;
constexpr size_t WS_Y = WS_P + (size_t)MTOK * NIN * 2;
constexpr size_t WS_R0 = WS_Y + (size_t)MTOK * D * 2;
constexpr size_t WS_PSTAT = WS_R0 + (size_t)MTOK * D * 4;
constexpr size_t WS_RSTAT = WS_PSTAT + (size_t)MTOK * 16 * 2 * 4;
constexpr size_t WS_END = WS_RSTAT + (size_t)MTOK * 2 * 4;

constexpr int LDS_BYTES = 139264;
constexpr int NTHREADS = 512, NWAVES = 8;

struct Params {
    const float *x, *c, *w_in, *pool_w, *pool_scale, *sgu_ln_g, *sgu_ln_b, *sgu_w, *sgu_b, *w_out, *ada_w, *ada_b, *ln_g, *ln_b;
    float* out; unsigned char* ws;
    int ph_lo, ph_hi;
};

DI unsigned pk2(float lo, float hi) { f32x2_t v = {lo, hi}; bf16x2_t b = __builtin_convertvector(v, bf16x2_t); return __builtin_bit_cast(unsigned, b); }
DI float bf2f(unsigned short u) { return __builtin_bit_cast(float, (unsigned)u << 16); }
DI float bflo(unsigned u) { return __builtin_bit_cast(float, u << 16); }
DI float bfhi(unsigned u) { return __builtin_bit_cast(float, u & 0xffff0000u); }
DI float silu_f(float v) { return v * __builtin_amdgcn_rcpf(1.f + __builtin_amdgcn_exp2f(-v * LOG2E)); }
DI float wave_sum(float v) {
#pragma unroll
    for (int o = 1; o < 64; o <<= 1) v += __shfl_xor(v, o);
    return v;
}
DI int crow(int i, int hh) { return (i & 3) + 8 * (i >> 2) + 4 * hh; }
#define MFMA32(a, b, c) __builtin_amdgcn_mfma_f32_32x32x16_bf16((a), (b), (c), 0, 0, 0)
#define LDS_WAIT() asm volatile("s_waitcnt lgkmcnt(0)" ::: "memory")

struct EpiP {
    static constexpr bool PERM = true, AFTER_DRAIN = false;
    bf16_t* O;
    DI void operator()(const pg8::f32x4 (&acc)[2][2][4][2], const pg8::Unit& u, int wr, int wc, int fr, int fq) const {
        const int row0 = u.pm * 256 + wr * 64 + fr, col0 = u.pn * 256 + wc * 32 + 8 * fq;
#pragma unroll
        for (int ai = 0; ai < 2; ++ai)
#pragma unroll
            for (int m = 0; m < 4; ++m) {
                bf16_t* rowp = O + (size_t)(row0 + ai * 128 + m * 16) * NIN + col0;
#pragma unroll
                for (int bj = 0; bj < 2; ++bj) {
                    const pg8::f32x4 v0 = acc[ai][bj][m][0], v1 = acc[ai][bj][m][1];
                    u32x4 w; w.x = pk2(v0[0], v0[1]); w.y = pk2(v0[2], v0[3]); w.z = pk2(v1[0], v1[1]); w.w = pk2(v1[2], v1[3]);
                    *(u32x4*)(rowp + bj * 128) = w;
                }
            }
    }
};
struct EpiRes {
    static constexpr bool PERM = true, AFTER_DRAIN = false;
    const float* xsrc;
    const float* rstat;
    const float* lng; const float* lnb;
    const float* gate;
    float* R; float* pstat;
    DI void operator()(const pg8::f32x4 (&acc)[2][2][4][2], const pg8::Unit& u, int wr, int wc, int fr, int fq) const {
        const int row0 = u.pm * 256 + wr * 64 + fr, col0 = u.pn * 256 + wc * 32 + 8 * fq;
        const int b = (u.pm * 256) >> 11;
        f32x4 ga[2][2];
#pragma unroll
        for (int bj = 0; bj < 2; ++bj)
#pragma unroll
            for (int n = 0; n < 2; ++n) ga[bj][n] = *(const f32x4*)(gate + (size_t)b * 3072 + col0 + bj * 128 + 4 * n);
#pragma unroll
        for (int ai = 0; ai < 2; ++ai)
#pragma unroll
            for (int m = 0; m < 4; ++m) {
                const int row = row0 + ai * 128 + m * 16;
                float mean = 0.f, rstd = 1.f;
                if (rstat) { const f32x2_t st = *(const f32x2_t*)(rstat + (size_t)row * 2); mean = st.x; rstd = st.y; }
                float s = 0.f, ss = 0.f;
#pragma unroll
                for (int bj = 0; bj < 2; ++bj)
#pragma unroll
                    for (int n = 0; n < 2; ++n) {
                        const int col = col0 + bj * 128 + 4 * n;
                        f32x4 xv = *(const f32x4*)(xsrc + (size_t)row * D + col);
                        if (rstat) { const f32x4 g = *(const f32x4*)(lng + col), bb = *(const f32x4*)(lnb + col); xv = (xv - mean) * rstd * g + bb; }
                        const f32x4 a = acc[ai][bj][m][n];
                        const f32x4 v = xv * DN_ALPHA + ga[bj][n] * a;
                        *(f32x4*)(R + (size_t)row * D + col) = v;
                        s += (v[0] + v[1]) + (v[2] + v[3]);
                        ss += (v[0] * v[0] + v[1] * v[1]) + (v[2] * v[2] + v[3] * v[3]);
                    }
                s += __shfl_xor(s, 16); ss += __shfl_xor(ss, 16);
                s += __shfl_xor(s, 32); ss += __shfl_xor(ss, 32);
                if (fq == 0) { f32x2_t o = {s, ss}; *(f32x2_t*)(pstat + ((size_t)row * 16 + u.pn * 4 + wc) * 2) = o; }
            }
    }
};

DI void transpose_item(const float* W, int K, int N, bf16_t* WT, LAS float* scr, int item, int lane) {
    const int nblk = N / 32, kb = item / nblk, nb = item % nblk, k0 = 64 * kb, n0 = 32 * nb;
#pragma unroll 8
    for (int i = 0; i < 32; ++i) { const int kk = 2 * i + (lane >> 5); scr[kk * 33 + (lane & 31)] = W[(size_t)(k0 + kk) * N + n0 + (lane & 31)]; }
    LDS_WAIT();
    const int c = lane & 7;
#pragma unroll
    for (int j = 0; j < 4; ++j) {
        const int n = (lane >> 3) + 8 * j; const LAS float* s = scr + (8 * c) * 33 + n;
        u32x4 o; o.x = pk2(s[0 * 33], s[1 * 33]); o.y = pk2(s[2 * 33], s[3 * 33]); o.z = pk2(s[4 * 33], s[5 * 33]); o.w = pk2(s[6 * 33], s[7 * 33]);
        *(u32x4*)(WT + (size_t)(n0 + n) * K + k0 + 8 * c) = o;
    }
    LDS_WAIT();
}

DI void phase0(const Params& P, LAS unsigned char* lds, int tid, int lane, int wave) {
    tid = launder_v(tid); lane = launder_v(lane); wave = launder_s(wave);
    bf16_t* win_t = (bf16_t*)(P.ws + WS_WIN); bf16_t* wout_t = (bf16_t*)(P.ws + WS_WOUT); float* mod = (float*)(P.ws + WS_MOD);
    {
        LAS float* scr = (LAS float*)(lds + wave * 16384);
        const int gw = blockIdx.x * NWAVES + wave, NGW = gridDim.x * NWAVES;
        constexpr int I_IN = (D / 64) * (NIN / 32), I_OUT = (D / 64) * (D / 32);
        for (int it = gw; it < DEPTH * (I_IN + I_OUT); it += NGW) {
            const int l = it / (I_IN + I_OUT); int r = it % (I_IN + I_OUT);
            if (r < I_IN) transpose_item(P.w_in + (size_t)l * D * NIN, D, NIN, win_t + (size_t)l * NIN * D, scr, r, lane);
            else transpose_item(P.w_out + (size_t)l * D * D, D, D, wout_t + (size_t)l * D * D, scr, r - I_IN, lane);
        }
    }
    __syncthreads();
    LAS float* sc = (LAS float*)lds;
    for (int item = blockIdx.x; item < DEPTH * 96; item += gridDim.x) {
        const int l = item / 96, j0 = (item % 96) * 32;
        for (int e = tid; e < BATCH * D; e += NTHREADS) { const int b = e >> 10, k = e & 1023; sc[k * 32 + b] = silu_f(P.c[e]); }
        __syncthreads();
        const int j = tid & 31, ks = tid >> 5;
        float acc[32];
#pragma unroll
        for (int b = 0; b < 32; ++b) acc[b] = 0.f;
        const float* wp = P.ada_w + ((size_t)l * D + ks * 64) * 3072 + j0 + j;
#pragma unroll 2
        for (int kk = 0; kk < 64; ++kk) {
            const float w = wp[(size_t)kk * 3072];
            const LAS f32x4* s4 = (const LAS f32x4*)(sc + (ks * 64 + kk) * 32);
#pragma unroll
            for (int q = 0; q < 8; ++q) { const f32x4 v = s4[q]; acc[4 * q] += v[0] * w; acc[4 * q + 1] += v[1] * w; acc[4 * q + 2] += v[2] * w; acc[4 * q + 3] += v[3] * w; }
        }
        __syncthreads();
        LAS float* red = (LAS float*)lds;
#pragma unroll
        for (int b = 0; b < 32; ++b) red[(ks * 32 + b) * 32 + j] = acc[b];
        __syncthreads();
#pragma unroll
        for (int o2 = 0; o2 < 2; ++o2) {
            const int o = tid + o2 * NTHREADS, b = o >> 5, jj = o & 31;
            float s = P.ada_b[l * 3072 + j0 + jj];
#pragma unroll
            for (int q = 0; q < 16; ++q) s += red[(q * 32 + b) * 32 + jj];
            mod[((size_t)l * BATCH + b) * 3072 + j0 + jj] = s;
        }
        __syncthreads();
    }
}

template <int MODE>
DI void row_pass(const Params& P, int lane, int wave) {
    lane = launder_v(lane); wave = launder_s(wave);
    const int gw = blockIdx.x * NWAVES + wave, NGW = gridDim.x * NWAVES;
    const float* mod = (const float*)(P.ws + WS_MOD) + (MODE == 1 ? (size_t)BATCH * 3072 : 0);
    const float* pstat = (const float*)(P.ws + WS_PSTAT);
    float* rstat = (float*)(P.ws + WS_RSTAT);
    bf16_t* hb = (bf16_t*)(P.ws + WS_HB);
    const float* src = MODE == 0 ? P.x : (MODE == 1 ? (const float*)(P.ws + WS_R0) : (const float*)P.out);
    const float* lg = P.ln_g + (MODE == 2 ? D : 0); const float* lb = P.ln_b + (MODE == 2 ? D : 0);
    for (int row = gw; row < MTOK; row += NGW) {
        const int b = row >> 11;
        float mean = 0.f, rstd = 1.f;
        if (MODE != 0) {
            float s = 0.f, ss = 0.f;
            if (lane < 16) { const f32x2_t st = *(const f32x2_t*)(pstat + ((size_t)row * 16 + lane) * 2); s = st.x; ss = st.y; }
            s = wave_sum(s); ss = wave_sum(ss);
            mean = s * (1.f / D); const float var = fmaxf(ss * (1.f / D) - mean * mean, 0.f); rstd = 1.f / sqrtf(var + LN_EPS);
            if (MODE == 1 && lane == 0) { f32x2_t o = {mean, rstd}; *(f32x2_t*)(rstat + (size_t)row * 2) = o; }
        }
#pragma unroll
        for (int j = 0; j < 4; ++j) {
            const int col = 4 * lane + 256 * j;
            f32x4 v = *(const f32x4*)(src + (size_t)row * D + col);
            if (MODE != 0) { const f32x4 g = *(const f32x4*)(lg + col), bb = *(const f32x4*)(lb + col); v = (v - mean) * rstd * g + bb; }
            if (MODE == 2) { *(f32x4*)(P.out + (size_t)row * D + col) = v; }
            else {
                const f32x4 sh = *(const f32x4*)(mod + (size_t)b * 3072 + col), scl = *(const f32x4*)(mod + (size_t)b * 3072 + 1024 + col);
                v = v * (scl + 1.f) + sh;
                u32x2 o; o.x = pk2(v[0], v[1]); o.y = pk2(v[2], v[3]);
                *(u32x2*)(hb + (size_t)row * D + col) = o;
            }
        }
    }
}

constexpr int VT_PITCH = 272;
DI void sgu_unit(const Params& P, int l, int unit, LAS unsigned char* lds, int lane, int wave) {
    const bf16_t* p = (const bf16_t*)(P.ws + WS_P); bf16_t* Y = (bf16_t*)(P.ws + WS_Y);
    const int tok0 = unit * 128;
    {
        const float g0 = P.sgu_ln_g[l * 256 + lane], g1 = P.sgu_ln_g[l * 256 + 64 + lane], g2 = P.sgu_ln_g[l * 256 + 128 + lane], g3 = P.sgu_ln_g[l * 256 + 192 + lane];
        const float b0 = P.sgu_ln_b[l * 256 + lane], b1 = P.sgu_ln_b[l * 256 + 64 + lane], b2 = P.sgu_ln_b[l * 256 + 128 + lane], b3 = P.sgu_ln_b[l * 256 + 192 + lane];
#pragma unroll 4
        for (int i = 0; i < 16; ++i) {
            const int s = wave * 16 + i;
            const bf16_t* vp = p + (size_t)(tok0 + s) * NIN + C_VS + lane;
            const float v0 = bf2f(vp[0]), v1 = bf2f(vp[64]), v2 = bf2f(vp[128]), v3 = bf2f(vp[192]);
            const float mean = wave_sum((v0 + v1) + (v2 + v3)) * (1.f / 256.f);
            const float d0 = v0 - mean, d1 = v1 - mean, d2 = v2 - mean, d3 = v3 - mean;
            const float var = wave_sum((d0 * d0 + d1 * d1) + (d2 * d2 + d3 * d3)) * (1.f / 256.f);
            const float rstd = 1.f / sqrtf(var + LN_EPS);
            LAS bf16_t* vt = (LAS bf16_t*)(lds + lane * VT_PITCH + s * 2);
            vt[0] = (bf16_t)(pk2(d0 * rstd * g0 + b0, 0.f) & 0xffffu);
            vt[64 * VT_PITCH / 2] = (bf16_t)(pk2(d1 * rstd * g1 + b1, 0.f) & 0xffffu);
            vt[128 * VT_PITCH / 2] = (bf16_t)(pk2(d2 * rstd * g2 + b2, 0.f) & 0xffffu);
            vt[192 * VT_PITCH / 2] = (bf16_t)(pk2(d3 * rstd * g3 + b3, 0.f) & 0xffffu);
        }
    }
    __syncthreads();
    {
        const int h = wave & 3, dblk = wave >> 2, r = lane & 31, hh = lane >> 5;
        const int ch = h * 64 + 32 * dblk + r;
        f32x16 acc[4];
#pragma unroll
        for (int tb = 0; tb < 4; ++tb)
#pragma unroll
            for (int i = 0; i < 16; ++i) acc[tb][i] = 0.f;
        const float* wbase = P.sgu_w + ((size_t)(l * 4 + h) * 128) * 128;
#pragma unroll 1
        for (int ks = 0; ks < 8; ++ks) {
            const bf16x8 bfrag = *(const LAS bf16x8*)(lds + ch * VT_PITCH + (16 * ks + 8 * hh) * 2);
#pragma unroll
            for (int tb = 0; tb < 4; ++tb) {
                if (ks >= 4 && tb < 2) continue;
                const float* wp = wbase + (size_t)(32 * tb + r) * 128 + 16 * ks + 8 * hh;
                const f32x4 w0 = *(const f32x4*)wp, w1 = *(const f32x4*)(wp + 4);
                u32x4 a; a.x = pk2(w0[0], w0[1]); a.y = pk2(w0[2], w0[3]); a.z = pk2(w1[0], w1[1]); a.w = pk2(w1[2], w1[3]);
                acc[tb] = MFMA32(__builtin_bit_cast(bf16x8, a), bfrag, acc[tb]);
            }
        }
#pragma unroll
        for (int tb = 0; tb < 4; ++tb)
#pragma unroll
            for (int i = 0; i < 16; ++i) {
                const int t = 32 * tb + crow(i, hh);
                const size_t tok = (size_t)(tok0 + t);
                const float mixed = acc[tb][i] + P.sgu_b[(l * 4 + h) * 128 + t];
                const float u = bf2f(p[tok * NIN + C_U + ch]), gb = bf2f(p[tok * NIN + C_GB + ch]);
                Y[tok * D + 256 + ch] = (bf16_t)(pk2(u * mixed * silu_f(gb), 0.f) & 0xffffu);
            }
    }
    __syncthreads();
}

DI void pool_wave(const Params& P, int l, int gw, int NGW, int lane) {
    const bf16_t* p = (const bf16_t*)(P.ws + WS_P); bf16_t* Y = (bf16_t*)(P.ws + WS_Y);
    const int g = gw & 3, r = lane & 31, hh = lane >> 5;
    const int win = 2 << g;
    bf16x8 bw[4][2];
#pragma unroll
    for (int s = 0; s < 4; ++s)
#pragma unroll
        for (int db = 0; db < 2; ++db) {
            const float* wp = P.pool_w + ((size_t)(l * 4 + g) * 64 + 16 * s + 8 * hh) * 64 + 32 * db + r;
            u32x4 a; a.x = pk2(wp[0], wp[64]); a.y = pk2(wp[128], wp[192]); a.z = pk2(wp[256], wp[320]); a.w = pk2(wp[384], wp[448]);
            bw[s][db] = __builtin_bit_cast(bf16x8, a);
        }
    for (int tile = gw >> 2; tile < MTOK / 32; tile += NGW >> 2) {
        const int tok0 = tile * 32, tok = tok0 + r, pos = tok & (SEQ - 1);
        const int cnt = (pos + 1 < win) ? pos + 1 : win;
        const float inv = 1.f / (float)cnt;
        f32x16 acc0, acc1;
#pragma unroll
        for (int i = 0; i < 16; ++i) { acc0[i] = 0.f; acc1[i] = 0.f; }
#pragma unroll
        for (int s = 0; s < 4; ++s) {
            const bf16_t* base = p + (size_t)tok * NIN + C_A + g * 64 + 16 * s + 8 * hh;
            const u32x4 own = *(const u32x4*)base;
            float sum[8];
            sum[0] = bflo(own.x); sum[1] = bfhi(own.x); sum[2] = bflo(own.y); sum[3] = bfhi(own.y); sum[4] = bflo(own.z); sum[5] = bfhi(own.z); sum[6] = bflo(own.w); sum[7] = bfhi(own.w);
            for (int j = 1; j < win; ++j) {
                if (j <= pos) {
                    const u32x4 v = *(const u32x4*)(base - (size_t)j * NIN);
                    sum[0] += bflo(v.x); sum[1] += bfhi(v.x); sum[2] += bflo(v.y); sum[3] += bfhi(v.y); sum[4] += bflo(v.z); sum[5] += bfhi(v.z); sum[6] += bflo(v.w); sum[7] += bfhi(v.w);
                }
            }
            u32x4 a;
            a.x = pk2(sum[0] * inv - bflo(own.x), sum[1] * inv - bfhi(own.x)); a.y = pk2(sum[2] * inv - bflo(own.y), sum[3] * inv - bfhi(own.y));
            a.z = pk2(sum[4] * inv - bflo(own.z), sum[5] * inv - bfhi(own.z)); a.w = pk2(sum[6] * inv - bflo(own.w), sum[7] * inv - bfhi(own.w));
            const bf16x8 af = __builtin_bit_cast(bf16x8, a);
            acc0 = MFMA32(af, bw[s][0], acc0);
            acc1 = MFMA32(af, bw[s][1], acc1);
        }
#pragma unroll
        for (int db = 0; db < 2; ++db) {
            const int ch = g * 64 + 32 * db + r;
            const float psc = P.pool_scale[l * 256 + ch];
#pragma unroll
            for (int i = 0; i < 16; ++i) {
                const size_t t = (size_t)(tok0 + crow(i, hh));
                const float ga = bf2f(p[t * NIN + C_GA + ch]);
                const float v = (db == 0 ? acc0[i] : acc1[i]) * psc * silu_f(ga);
                Y[t * D + ch] = (bf16_t)(pk2(v, 0.f) & 0xffffu);
            }
        }
    }
}

DI void attn_unit(const Params& P, int unit, int lane) {
    const bf16_t* p = (const bf16_t*)(P.ws + WS_P); bf16_t* Y = (bf16_t*)(P.ws + WS_Y);
    const int qt = unit & 63, h = (unit >> 6) & 7, b = unit >> 9;
    const int r = lane & 31, hh = lane >> 5;
    const size_t tokb = (size_t)b * SEQ;
    bf16x8 qf[4];
    {
        const bf16_t* qp = p + (tokb + qt * 32 + r) * NIN + C_Q + h * 64 + 8 * hh;
#pragma unroll
        for (int s = 0; s < 4; ++s) qf[s] = *(const bf16x8*)(qp + 16 * s);
    }
    f32x16 o0, o1;
#pragma unroll
    for (int i = 0; i < 16; ++i) { o0[i] = 0.f; o1[i] = 0.f; }
    float carry = 0.f;
    const float CZ = 0.125f * LOG2E;
    for (int kb = qt; kb >= 0; --kb) {
        const size_t tokk = tokb + (size_t)kb * 32;
        const bf16_t* kp = p + (tokk + r) * NIN + C_K + h * 64 + 8 * hh;
        bf16x8 kf[4];
#pragma unroll
        for (int s = 0; s < 4; ++s) kf[s] = *(const bf16x8*)(kp + 16 * s);
        const bf16_t* vp = p + (tokk + 4 * hh) * NIN + C_V + h * 64 + r;
        unsigned vw[2][2][4];
#pragma unroll
        for (int s = 0; s < 2; ++s)
#pragma unroll
            for (int db = 0; db < 2; ++db)
#pragma unroll
                for (int jp = 0; jp < 4; ++jp) {
                    const int key0 = 16 * s + 8 * (jp >> 1) + 2 * (jp & 1);
                    const unsigned lo = vp[(size_t)key0 * NIN + 32 * db], hi = vp[(size_t)(key0 + 1) * NIN + 32 * db];
                    vw[s][db][jp] = lo | (hi << 16);
                }
        f32x16 z;
#pragma unroll
        for (int i = 0; i < 16; ++i) z[i] = 0.f;
#pragma unroll
        for (int s = 0; s < 4; ++s) z = MFMA32(kf[s], qf[s], z);
        float l1m[16], lbv[16];
#pragma unroll
        for (int i = 0; i < 16; ++i) {
            const float t = z[i] * CZ;
            const float e = __builtin_amdgcn_exp2f(-fabsf(t));
            const float sp = fmaxf(t, 0.f) + __builtin_amdgcn_logf(1.f + e);
            l1m[i] = -sp; lbv[i] = t - sp;
        }
        if (kb == qt) {
#pragma unroll
            for (int i = 0; i < 16; ++i) if (crow(i, hh) >= r) { l1m[i] = 0.f; lbv[i] = -__builtin_inff(); }
        }
        float gs[4], og[4];
#pragma unroll
        for (int q = 0; q < 4; ++q) { gs[q] = (l1m[4 * q] + l1m[4 * q + 1]) + (l1m[4 * q + 2] + l1m[4 * q + 3]); og[q] = __shfl_xor(gs[q], 32); }
        float suf = carry;
        float a[16];
#pragma unroll
        for (int q = 3; q >= 0; --q) {
            float lat = suf + (hh == 0 ? og[q] : 0.f);
            a[4 * q + 3] = __builtin_amdgcn_exp2f(lbv[4 * q + 3] + lat); lat += l1m[4 * q + 3];
            a[4 * q + 2] = __builtin_amdgcn_exp2f(lbv[4 * q + 2] + lat); lat += l1m[4 * q + 2];
            a[4 * q + 1] = __builtin_amdgcn_exp2f(lbv[4 * q + 1] + lat); lat += l1m[4 * q + 1];
            a[4 * q] = __builtin_amdgcn_exp2f(lbv[4 * q] + lat);
            suf += gs[q] + og[q];
        }
        carry = suf;
        u32x4 pa0, pa1;
        pa0.x = pk2(a[0], a[1]); pa0.y = pk2(a[2], a[3]); pa0.z = pk2(a[4], a[5]); pa0.w = pk2(a[6], a[7]);
        pa1.x = pk2(a[8], a[9]); pa1.y = pk2(a[10], a[11]); pa1.z = pk2(a[12], a[13]); pa1.w = pk2(a[14], a[15]);
        u32x4 v00 = {vw[0][0][0], vw[0][0][1], vw[0][0][2], vw[0][0][3]}, v01 = {vw[0][1][0], vw[0][1][1], vw[0][1][2], vw[0][1][3]};
        u32x4 v10 = {vw[1][0][0], vw[1][0][1], vw[1][0][2], vw[1][0][3]}, v11 = {vw[1][1][0], vw[1][1][1], vw[1][1][2], vw[1][1][3]};
        o0 = MFMA32(__builtin_bit_cast(bf16x8, pa0), __builtin_bit_cast(bf16x8, v00), o0);
        o0 = MFMA32(__builtin_bit_cast(bf16x8, pa1), __builtin_bit_cast(bf16x8, v10), o0);
        o1 = MFMA32(__builtin_bit_cast(bf16x8, pa0), __builtin_bit_cast(bf16x8, v01), o1);
        o1 = MFMA32(__builtin_bit_cast(bf16x8, pa1), __builtin_bit_cast(bf16x8, v11), o1);
        if (__ballot(carry > -160.f) == 0ull) break;
    }
#pragma unroll
    for (int db = 0; db < 2; ++db)
#pragma unroll
        for (int i = 0; i < 16; ++i) {
            const size_t t = tokb + qt * 32 + crow(i, hh);
            const int ch = h * 64 + 32 * db + r;
            const float gc = bf2f(p[t * NIN + C_GC + ch]);
            const float v = (db == 0 ? o0[i] : o1[i]) * silu_f(gc);
            Y[t * D + 512 + ch] = (bf16_t)(pk2(v, 0.f) & 0xffffu);
        }
}

DI void mixers(const Params& P, int l, LAS unsigned char* lds, int lane, int wave) {
    lane = launder_v(lane); wave = launder_s(wave);
    const int gw = blockIdx.x * NWAVES + wave, NGW = gridDim.x * NWAVES;
#ifndef MXMASK
#define MXMASK 7
#endif
    if (MXMASK & 1) for (int unit = blockIdx.x; unit < BATCH * 16; unit += gridDim.x) sgu_unit(P, l, unit, lds, lane, wave);
    if (MXMASK & 2) pool_wave(P, l, gw, NGW, lane);
    if (MXMASK & 4) for (int unit = gw; unit < BATCH * 8 * 64; unit += NGW) attn_unit(P, unit, lane);
}

__global__ void __launch_bounds__(NTHREADS, 2) fwd_mega(Params P) {
    extern __shared__ __attribute__((aligned(16))) unsigned char lds_raw[];
    LAS unsigned char* lds = (LAS unsigned char*)lds_raw;
    cg::grid_group grid = cg::this_grid();
    const int tid = threadIdx.x, lane = tid & 63, wave = __builtin_amdgcn_readfirstlane(tid >> 6);
    const int lo = P.ph_lo, hi = P.ph_hi;
#ifndef PHMASK
#define PHMASK 0x3ff
#endif
#define IN(k) (((PHMASK >> (k)) & 1) && lo <= (k) && (k) < hi)
#define SEAM(k) do { if (IN(k) && IN((k) + 1)) grid.sync(); } while (0)
    bf16_t* hb = (bf16_t*)(P.ws + WS_HB); bf16_t* pbuf = (bf16_t*)(P.ws + WS_P); bf16_t* ybuf = (bf16_t*)(P.ws + WS_Y);
    const bf16_t* win_t = (const bf16_t*)(P.ws + WS_WIN); const bf16_t* wout_t = (const bf16_t*)(P.ws + WS_WOUT);
    const float* mod = (const float*)(P.ws + WS_MOD);

    if (IN(0)) phase0(P, lds, tid, lane, wave);
    SEAM(0);
    if (IN(1)) row_pass<0>(P, lane, wave);
    SEAM(1);
#pragma unroll 1
    for (int l = 0; l < DEPTH; ++l) {
        const int pb = 2 + 4 * l;
        if (IN(pb)) {
            pg8::Gemm g{hb, win_t + (size_t)l * NIN * D, MTOK, NIN, D}; pg8::StaticOrder S; S.init(MTOK, NIN, (int)gridDim.x, (int)blockIdx.x);
            EpiP E{pbuf};
            pg8::gemm_phase<EpiP, pg8::StaticOrder, true, true>(lds, g, S, E);
        }
        SEAM(pb);
        if (IN(pb + 1)) mixers(P, l, lds, lane, wave);
        SEAM(pb + 1);
        if (IN(pb + 2)) {
            pg8::Gemm g{ybuf, wout_t + (size_t)l * D * D, MTOK, D, D}; pg8::StaticOrder S; S.init(MTOK, D, (int)gridDim.x, (int)blockIdx.x);
            EpiRes E{l == 0 ? P.x : (const float*)(P.ws + WS_R0), l == 0 ? nullptr : (const float*)(P.ws + WS_RSTAT), P.ln_g, P.ln_b,
                     mod + (size_t)l * BATCH * 3072 + 2048, l == 0 ? (float*)(P.ws + WS_R0) : P.out, (float*)(P.ws + WS_PSTAT)};
            pg8::gemm_phase<EpiRes, pg8::StaticOrder, true, true>(lds, g, S, E);
        }
        SEAM(pb + 2);
        if (IN(pb + 3)) { if (l == 0) row_pass<1>(P, lane, wave); else row_pass<2>(P, lane, wave); }
        SEAM(pb + 3);
    }
#undef IN
#undef SEAM
}

#ifndef N_LAUNCH_PER_PHASE
#define N_LAUNCH_PER_PHASE 0
#endif
extern "C" void kernel_launch(void* const* d_in, const int* in_sizes, int n_in, void* d_out, int out_size, void* d_ws, size_t ws_size, hipStream_t stream) {
    static int grid = 0;
    if (grid == 0) {
        if (n_in != 14 || out_size != MTOK * D || ws_size < WS_END) { fprintf(stderr, "kernel_launch: unexpected shapes (n_in %d out %d ws %zu need %zu)\n", n_in, out_size, ws_size, (size_t)WS_END); grid = -1; return; }
        int dev = 0, cus = 0, per_cu = 0;
        hipGetDevice(&dev);
        hipDeviceGetAttribute(&cus, hipDeviceAttributeMultiprocessorCount, dev);
        if (hipFuncSetAttribute((const void*)fwd_mega, hipFuncAttributeMaxDynamicSharedMemorySize, LDS_BYTES) != hipSuccess) { fprintf(stderr, "kernel_launch: hipFuncSetAttribute failed\n"); grid = -1; return; }
        if (hipOccupancyMaxActiveBlocksPerMultiprocessor(&per_cu, (const void*)fwd_mega, NTHREADS, LDS_BYTES) != hipSuccess || per_cu < 1) { fprintf(stderr, "kernel_launch: occupancy query says %d\n", per_cu); per_cu = 1; }
        (void)hipGetLastError();
        grid = cus * 1;
        if (grid != 256) fprintf(stderr, "kernel_launch: note: grid %d\n", grid);
    }
    if (grid < 0) return;
    Params p{};
    p.x = (const float*)d_in[0]; p.c = (const float*)d_in[1]; p.w_in = (const float*)d_in[2]; p.pool_w = (const float*)d_in[3]; p.pool_scale = (const float*)d_in[4];
    p.sgu_ln_g = (const float*)d_in[5]; p.sgu_ln_b = (const float*)d_in[6]; p.sgu_w = (const float*)d_in[7]; p.sgu_b = (const float*)d_in[8]; p.w_out = (const float*)d_in[9];
    p.ada_w = (const float*)d_in[10]; p.ada_b = (const float*)d_in[11]; p.ln_g = (const float*)d_in[12]; p.ln_b = (const float*)d_in[13];
    p.out = (float*)d_out; p.ws = (unsigned char*)d_ws;
#if N_LAUNCH_PER_PHASE
    for (int ph = 0; ph < 10; ++ph) {
        p.ph_lo = ph; p.ph_hi = ph + 1;
        hipLaunchKernelGGL(fwd_mega, dim3(grid), dim3(NTHREADS), LDS_BYTES, stream, p);
    }
#else
    p.ph_lo = 0; p.ph_hi = 10;
    void* args[] = {&p};
    hipError_t e = hipLaunchCooperativeKernel((const void*)fwd_mega, dim3(grid), dim3(NTHREADS), args, LDS_BYTES, stream);
    if (e != hipSuccess) fprintf(stderr, "kernel_launch: cooperative launch failed: %s (grid %d)\n", hipGetErrorString(e), grid);
#endif
}
```

```cpp
#include <hip/hip_runtime.h>
#include <hip/hip_cooperative_groups.h>
#include <cstdio>
#include <cstdint>
namespace cg = cooperative_groups;
__device__ __forceinline__ int launder_v(int x) { asm volatile("" : "+v"(x)); return x; }
__device__ __forceinline__ int launder_s(int x) { asm volatile("" : "+s"(x)); return x; }
namespace pg8 {
#define PG8_LAS __attribute__((address_space(3)))
typedef unsigned short bf16_t;
typedef short bf16x8 __attribute__((ext_vector_type(8)));
typedef float f32x4 __attribute__((ext_vector_type(4)));
typedef unsigned u32x4 __attribute__((ext_vector_type(4)));
constexpr int BM = 256, BK = 64, HALF = 128, HTB = HALF * BK * 2  , STAGE_BYTES = 8 * HTB, NXCD = 8, WGM = 8;

__host__ __device__ __forceinline__ int lds_byte(int r, int c) { const int st = (r >> 4) * 2 + (c >> 5), rr = r & 15, cc = c & 31, ob = rr * 64 + cc * 2; return st * 1024 + (ob ^ (((ob >> 9) & 1) << 5)); }
__host__ __device__ __forceinline__ void stage_rc(int b, int& R, int& C) { const int st = b / 1024, sb = b % 1024, swz = sb ^ (((sb >> 9) & 1) << 5); R = (st >> 1) * 16 + swz / 64; C = (st & 1) * 32 + (swz % 64) / 2; }
__host__ __device__ __forceinline__ int perm32(int rho) { const int n = rho >> 4, i = rho & 15; return 8 * (i >> 2) + 4 * n + (i & 3); }

struct Unit { int pm, pn; };
struct Gemm { const bf16_t* A; const bf16_t* Bt; int M, N, K; };

struct StaticOrder {
    int nM, nN, nwg, G, c;
    __host__ __device__ void init(int M, int N, int G_, int c_) { nM = M / BM; nN = N / BM; nwg = nM * nN; G = G_; c = c_; }
    __host__ __device__ bool next(int i, Unit& u) const {
        const long L = (long)i * G + c; if (L >= nwg) return false;
        int wgid = (int)L; { const int q = nwg / NXCD, r = nwg % NXCD, xcd = wgid % NXCD, off = wgid / NXCD; wgid = (xcd < r ? xcd * (q + 1) : r * (q + 1) + (xcd - r) * q) + off; }
        const int nig = WGM * nN, gid = wgid / nig, fm = gid * WGM, gsz = (nM - fm) < WGM ? (nM - fm) : WGM;
        u.pm = fm + ((wgid % nig) % gsz); u.pn = (wgid % nig) / gsz; return true;
    }
    __device__ __forceinline__ void a_ready(const Unit&) const {}
    __device__ __forceinline__ void done(const Unit&) const {}
};

__device__ __forceinline__ unsigned cvt_pk_bf16(float lo, float hi) { unsigned r; asm volatile("v_cvt_pk_bf16_f32 %0, %1, %2" : "=v"(r) : "v"(lo), "v"(hi)); return r; }
template <class Epi, class Sched, bool ALIGN_EPI = false, bool SP2 = false>
__device__ __forceinline__ void gemm_phase(PG8_LAS unsigned char* lds, const Gemm g, const Sched& S, const Epi& E) {
    const int tid = launder_v(threadIdx.x), wid = __builtin_amdgcn_readfirstlane(tid >> 6), lane = tid & 63, wr = wid >> 2, wc = wid & 3, fr = lane & 15, fq = lane >> 4;
    const int K = g.K, nt = K / BK;
    unsigned voffA[2], voffB[2];
#pragma unroll
    for (int i = 0; i < 2; ++i) { int R, C; stage_rc(tid * 16 + i * 8192, R, C); const int Rb = Epi::PERM ? ((R & ~31) + perm32(R & 31)) : R;
        voffA[i] = (unsigned)(R * K + C) * 2u; voffB[i] = (unsigned)(Rb * K + C) * 2u; }
    const size_t kstep = (size_t)(BK * 2);
    const size_t hstep = (size_t)HALF * K * 2;
    const size_t tstep = 2 * hstep;
    const unsigned ldsw = (unsigned)wid * 1024u;
    const int aoff = lds_byte(wr * 64 + fr, fq * 8), boff = lds_byte(wc * 32 + fr, fq * 8);
#define PG8_SA(b, h) (((b) * 2 + (h)) * HTB)
#define PG8_SB(b, h) ((4 + (b) * 2 + (h)) * HTB)
#define PG8_STAGE(bufoff, gbase, voff) do { _Pragma("unroll") for (int _i = 0; _i < 2; ++_i) \
        __builtin_amdgcn_global_load_lds((const unsigned*)((const char*)(gbase) + (voff)[_i]), (PG8_LAS unsigned*)(lds + (bufoff) + ldsw + _i * 8192), 16, 0, 0); } while (0)
#define PG8_LDA(dst, b, h) do { _Pragma("unroll") for (int m = 0; m < 4; ++m) _Pragma("unroll") for (int k = 0; k < 2; ++k) dst[m][k] = *(const PG8_LAS bf16x8*)(lds + PG8_SA(b, h) + aoff + m * 2048 + k * 1024); } while (0)
#define PG8_LDB(dst, b, h) do { _Pragma("unroll") for (int n = 0; n < 2; ++n) _Pragma("unroll") for (int k = 0; k < 2; ++k) dst[n][k] = *(const PG8_LAS bf16x8*)(lds + PG8_SB(b, h) + boff + n * 2048 + k * 1024); } while (0)
#define PG8_MMA(ai, bj, At, Bt) do { __builtin_amdgcn_s_setprio(1); _Pragma("unroll") for (int m = 0; m < 4; ++m) _Pragma("unroll") for (int n = 0; n < 2; ++n) _Pragma("unroll") for (int k = 0; k < 2; ++k) \
        acc[ai][bj][m][n] = __builtin_amdgcn_mfma_f32_16x16x32_bf16(Bt[n][k], At[m][k], acc[ai][bj][m][n], 0, 0, 0); __builtin_amdgcn_s_setprio(0); } while (0)
#define PG8_WAIT_V(n) asm volatile("s_waitcnt vmcnt(" #n ")" ::: "memory")
#define PG8_WAIT_L(n) asm volatile("s_waitcnt lgkmcnt(" #n ")" ::: "memory")
#define PG8_BAR __builtin_amdgcn_s_barrier()
#define PG8_SCHED __builtin_amdgcn_sched_barrier(0)
    Unit cur, nxt; int ui = 0;
    if (!S.next(0, cur)) return;
    f32x4 acc[2][2][4][2];
#pragma unroll
    for (int a = 0; a < 2; ++a)
#pragma unroll
        for (int b = 0; b < 2; ++b)
#pragma unroll
            for (int m = 0; m < 4; ++m)
#pragma unroll
                for (int n = 0; n < 2; ++n) acc[a][b][m][n] = (f32x4){0.f, 0.f, 0.f, 0.f};
    bf16x8 At[4][2], B0[2][2], B1[2][2];
    const char* cA = (const char*)g.A + (size_t)cur.pm * tstep; const char* cB = (const char*)g.Bt + (size_t)cur.pn * tstep;
    S.a_ready(cur);
    if constexpr (SP2) {
        PG8_STAGE(PG8_SB(0, 0), cB, voffB); PG8_STAGE(PG8_SB(0, 1), cB + hstep, voffB); PG8_STAGE(PG8_SA(0, 0), cA, voffA); PG8_STAGE(PG8_SA(0, 1), cA + hstep, voffA);
        if (wr == 1) PG8_BAR;
        PG8_WAIT_V(2); PG8_BAR;
        PG8_STAGE(PG8_SB(1, 0), cB + kstep, voffB); PG8_STAGE(PG8_SA(1, 0), cA + kstep, voffA); PG8_STAGE(PG8_SB(1, 1), cB + hstep + kstep, voffB);
        PG8_WAIT_V(6); PG8_BAR;
    } else {
        PG8_STAGE(PG8_SB(0, 0), cB, voffB); PG8_STAGE(PG8_SA(0, 0), cA, voffA); PG8_STAGE(PG8_SB(0, 1), cB + hstep, voffB); PG8_STAGE(PG8_SA(0, 1), cA + hstep, voffA);
        if (wr == 1) PG8_BAR;
        PG8_WAIT_V(4); PG8_BAR;
        PG8_STAGE(PG8_SB(1, 0), cB + kstep, voffB); PG8_STAGE(PG8_SA(1, 0), cA + kstep, voffA); PG8_STAGE(PG8_SB(1, 1), cB + hstep + kstep, voffB);
        PG8_WAIT_V(6); PG8_BAR;
    }
    for (;;) {
        const bool has_next = S.next(ui + 1, nxt);
        const char* nA = has_next ? (const char*)g.A + (size_t)nxt.pm * tstep : cA; const char* nB = has_next ? (const char*)g.Bt + (size_t)nxt.pn * tstep : cB;
        for (int t = 0; t < nt; t += 2) {
            const bool last = (t == nt - 2);
            const char* a1 = cA + (size_t)(t + 1) * kstep;
            const char* a2 = last ? nA : cA + (size_t)(t + 2) * kstep; const char* b2 = last ? nB : cB + (size_t)(t + 2) * kstep;
            const char* a3 = a2 + kstep; const char* b3 = b2 + kstep;
            if (last && has_next) S.a_ready(nxt);
            if constexpr (SP2) {
            PG8_LDB(B0, 0, 0); PG8_LDB(B1, 0, 1); PG8_SCHED; PG8_LDA(At, 0, 0); PG8_STAGE(PG8_SA(1, 1), a1 + hstep, voffA);
            PG8_WAIT_V(8); PG8_WAIT_L(0); PG8_BAR; PG8_MMA(0, 0, At, B0); PG8_MMA(0, 1, At, B1); PG8_BAR; PG8_SCHED;
            PG8_LDA(At, 0, 1); PG8_STAGE(PG8_SB(0, 0), b2, voffB); PG8_STAGE(PG8_SB(0, 1), b2 + hstep, voffB); PG8_STAGE(PG8_SA(0, 0), a2, voffA);
            PG8_WAIT_V(8); PG8_WAIT_L(0); PG8_BAR; PG8_MMA(1, 0, At, B0); PG8_MMA(1, 1, At, B1); PG8_BAR; PG8_SCHED;
            PG8_LDB(B0, 1, 0); PG8_LDB(B1, 1, 1); PG8_SCHED; PG8_LDA(At, 1, 0); PG8_STAGE(PG8_SA(0, 1), a2 + hstep, voffA);
            PG8_WAIT_V(8); PG8_WAIT_L(0); PG8_BAR; PG8_MMA(0, 0, At, B0); PG8_MMA(0, 1, At, B1); PG8_BAR; PG8_SCHED;
            PG8_LDA(At, 1, 1); PG8_STAGE(PG8_SB(1, 0), b3, voffB); PG8_STAGE(PG8_SB(1, 1), b3 + hstep, voffB); PG8_STAGE(PG8_SA(1, 0), a3, voffA);
            PG8_WAIT_V(8); PG8_WAIT_L(0); PG8_BAR; PG8_MMA(1, 0, At, B0); PG8_MMA(1, 1, At, B1); PG8_BAR; PG8_SCHED;
            } else {
            PG8_LDB(B0, 0, 0); PG8_SCHED; PG8_LDA(At, 0, 0); PG8_STAGE(PG8_SA(1, 1), a1 + hstep, voffA);
            PG8_WAIT_L(8); PG8_BAR; PG8_WAIT_L(0); PG8_MMA(0, 0, At, B0); PG8_BAR; PG8_SCHED;
            PG8_LDB(B1, 0, 1); PG8_STAGE(PG8_SB(0, 0), b2, voffB);
            PG8_BAR; PG8_WAIT_L(0); PG8_MMA(0, 1, At, B1); PG8_BAR;
            PG8_LDA(At, 0, 1); PG8_STAGE(PG8_SA(0, 0), a2, voffA);
            PG8_BAR; PG8_WAIT_L(0); PG8_MMA(1, 0, At, B0); PG8_BAR; PG8_SCHED;
            PG8_STAGE(PG8_SB(0, 1), b2 + hstep, voffB);
            PG8_WAIT_V(6); PG8_BAR; PG8_MMA(1, 1, At, B1); PG8_BAR;
            PG8_LDB(B0, 1, 0); PG8_SCHED; PG8_LDA(At, 1, 0); PG8_STAGE(PG8_SA(0, 1), a2 + hstep, voffA);
            PG8_WAIT_L(8); PG8_BAR; PG8_WAIT_L(0); PG8_MMA(0, 0, At, B0); PG8_BAR; PG8_SCHED;
            PG8_LDB(B1, 1, 1); PG8_STAGE(PG8_SB(1, 0), b3, voffB);
            PG8_BAR; PG8_WAIT_L(0); PG8_MMA(0, 1, At, B1); PG8_BAR;
            PG8_LDA(At, 1, 1); PG8_STAGE(PG8_SA(1, 0), a3, voffA);
            PG8_BAR; PG8_WAIT_L(0); PG8_MMA(1, 0, At, B0); PG8_BAR; PG8_SCHED;
            PG8_STAGE(PG8_SB(1, 1), b3 + hstep, voffB);
            PG8_WAIT_V(6); PG8_BAR; PG8_MMA(1, 1, At, B1); PG8_BAR;
            }
        }
        if constexpr (ALIGN_EPI) { if (wr == 0) PG8_BAR; }
        if constexpr (!Epi::AFTER_DRAIN) { E(acc, cur, wr, wc, fr, fq); S.done(cur); }
        if (!has_next) break;
#pragma unroll
        for (int a = 0; a < 2; ++a)
#pragma unroll
            for (int b = 0; b < 2; ++b)
#pragma unroll
                for (int m = 0; m < 4; ++m)
#pragma unroll
                    for (int n = 0; n < 2; ++n) acc[a][b][m][n] = (f32x4){0.f, 0.f, 0.f, 0.f};
        cur = nxt; cA = nA; cB = nB; ++ui;
        if constexpr (ALIGN_EPI) { if (wr == 1) PG8_BAR; }
    }
    PG8_WAIT_V(0);
    if constexpr (!ALIGN_EPI) { if (wr == 0) PG8_BAR; }
    PG8_BAR;
    if constexpr (Epi::AFTER_DRAIN) { E.fused(acc, cur, wr, wc, fr, fq, lds, wid, lane); S.done(cur); }
#undef PG8_SA
#undef PG8_SB
#undef PG8_STAGE
#undef PG8_LDA
#undef PG8_LDB
#undef PG8_MMA
#undef PG8_WAIT_V
#undef PG8_WAIT_L
#undef PG8_BAR
#undef PG8_SCHED
}
}

#define DI __device__ __forceinline__
#define LAS __attribute__((address_space(3)))
typedef unsigned short bf16_t;
typedef short bf16x8 __attribute__((ext_vector_type(8)));
typedef float f32x4 __attribute__((ext_vector_type(4)));
typedef float f32x16 __attribute__((ext_vector_type(16)));
typedef unsigned u32x4 __attribute__((ext_vector_type(4)));
typedef unsigned u32x2 __attribute__((ext_vector_type(2)));
typedef __bf16 bf16x2_t __attribute__((ext_vector_type(2)));
typedef float f32x2_t __attribute__((ext_vector_type(2)));

constexpr int D = 1024, BATCH = 32, SEQ = 2048, MTOK = BATCH * SEQ, NIN = 3328, DEPTH = 2;
constexpr int C_A = 0, C_GA = 256, C_U = 512, C_VS = 768, C_GB = 1024, C_Q = 1280, C_K = 1792, C_V = 2304, C_GC = 2816;
constexpr float DN_ALPHA = 1.41421356237309515f;
constexpr float LN_EPS = 1e-5f;
constexpr float LOG2E = 1.44269504088896341f;

constexpr size_t WS_WIN = 0;
constexpr size_t WS_WOUT = WS_WIN + (size_t)DEPTH * NIN * D * 2;
constexpr size_t WS_MOD = WS_WOUT + (size_t)DEPTH * D * D * 2;
constexpr size_t WS_HB = WS_MOD + (size_t)DEPTH * BATCH * 3 * D * 4;
constexpr size_t WS_P = WS_HB + (size_t)MTOK * D * 2;
constexpr size_t WS_Y = WS_P + (size_t)MTOK * NIN * 2;
constexpr size_t WS_R0 = WS_Y + (size_t)MTOK * D * 2;
constexpr size_t WS_PSTAT = WS_R0 + (size_t)MTOK * D * 4;
constexpr size_t WS_RSTAT = WS_PSTAT + (size_t)MTOK * 16 * 2 * 4;
constexpr size_t WS_END = WS_RSTAT + (size_t)MTOK * 2 * 4;

constexpr int LDS_BYTES = 139264;
constexpr int NTHREADS = 512, NWAVES = 8;
#ifndef DUP
#define DUP 0
#endif

struct Params {
    const float *x, *c, *w_in, *pool_w, *pool_scale, *sgu_ln_g, *sgu_ln_b, *sgu_w, *sgu_b, *w_out, *ada_w, *ada_b, *ln_g, *ln_b;
    float* out; unsigned char* ws;
    int ph_lo, ph_hi;
};

DI unsigned pk2(float lo, float hi) { f32x2_t v = {lo, hi}; bf16x2_t b = __builtin_convertvector(v, bf16x2_t); return __builtin_bit_cast(unsigned, b); }
DI float bf2f(unsigned short u) { return __builtin_bit_cast(float, (unsigned)u << 16); }
DI float bflo(unsigned u) { return __builtin_bit_cast(float, u << 16); }
DI float bfhi(unsigned u) { return __builtin_bit_cast(float, u & 0xffff0000u); }
DI float silu_f(float v) { return v * __builtin_amdgcn_rcpf(1.f + __builtin_amdgcn_exp2f(-v * LOG2E)); }
DI float wave_sum(float v) {
#pragma unroll
    for (int o = 1; o < 64; o <<= 1) v += __shfl_xor(v, o);
    return v;
}
DI int crow(int i, int hh) { return (i & 3) + 8 * (i >> 2) + 4 * hh; }
#define MFMA32(a, b, c) __builtin_amdgcn_mfma_f32_32x32x16_bf16((a), (b), (c), 0, 0, 0)
#define LDS_WAIT() asm volatile("s_waitcnt lgkmcnt(0)" ::: "memory")

struct EpiP {
    static constexpr bool PERM = true, AFTER_DRAIN = false;
    bf16_t* O;
    DI void operator()(const pg8::f32x4 (&acc)[2][2][4][2], const pg8::Unit& u, int wr, int wc, int fr, int fq) const {
        const int row0 = u.pm * 256 + wr * 64 + fr, col0 = u.pn * 256 + wc * 32 + 8 * fq;
#pragma unroll
        for (int ai = 0; ai < 2; ++ai)
#pragma unroll
            for (int m = 0; m < 4; ++m) {
                bf16_t* rowp = O + (size_t)(row0 + ai * 128 + m * 16) * NIN + col0;
#pragma unroll
                for (int bj = 0; bj < 2; ++bj) {
                    const pg8::f32x4 v0 = acc[ai][bj][m][0], v1 = acc[ai][bj][m][1];
                    u32x4 w; w.x = pk2(v0[0], v0[1]); w.y = pk2(v0[2], v0[3]); w.z = pk2(v1[0], v1[1]); w.w = pk2(v1[2], v1[3]);
                    *(u32x4*)(rowp + bj * 128) = w;
                }
            }
    }
};
struct EpiRes {
    static constexpr bool PERM = true, AFTER_DRAIN = false;
    const float* xsrc;
    const float* rstat;
    const float* lng; const float* lnb;
    const float* gate;
    float* R; float* pstat;
    DI void operator()(const pg8::f32x4 (&acc)[2][2][4][2], const pg8::Unit& u, int wr, int wc, int fr, int fq) const {
        const int row0 = u.pm * 256 + wr * 64 + fr, col0 = u.pn * 256 + wc * 32 + 8 * fq;
        const int b = (u.pm * 256) >> 11;
        f32x4 ga[2][2];
#pragma unroll
        for (int bj = 0; bj < 2; ++bj)
#pragma unroll
            for (int n = 0; n < 2; ++n) ga[bj][n] = *(const f32x4*)(gate + (size_t)b * 3072 + col0 + bj * 128 + 4 * n);
#pragma unroll
        for (int ai = 0; ai < 2; ++ai)
#pragma unroll
            for (int m = 0; m < 4; ++m) {
                const int row = row0 + ai * 128 + m * 16;
                float mean = 0.f, rstd = 1.f;
                if (rstat) { const f32x2_t st = *(const f32x2_t*)(rstat + (size_t)row * 2); mean = st.x; rstd = st.y; }
                float s = 0.f, ss = 0.f;
#pragma unroll
                for (int bj = 0; bj < 2; ++bj)
#pragma unroll
                    for (int n = 0; n < 2; ++n) {
                        const int col = col0 + bj * 128 + 4 * n;
                        f32x4 xv = *(const f32x4*)(xsrc + (size_t)row * D + col);
                        if (rstat) { const f32x4 g = *(const f32x4*)(lng + col), bb = *(const f32x4*)(lnb + col); xv = (xv - mean) * rstd * g + bb; }
                        const f32x4 a = acc[ai][bj][m][n];
                        const f32x4 v = xv * DN_ALPHA + ga[bj][n] * a;
                        *(f32x4*)(R + (size_t)row * D + col) = v;
                        s += (v[0] + v[1]) + (v[2] + v[3]);
                        ss += (v[0] * v[0] + v[1] * v[1]) + (v[2] * v[2] + v[3] * v[3]);
                    }
                s += __shfl_xor(s, 16); ss += __shfl_xor(ss, 16);
                s += __shfl_xor(s, 32); ss += __shfl_xor(ss, 32);
                if (fq == 0) { f32x2_t o = {s, ss}; *(f32x2_t*)(pstat + ((size_t)row * 16 + u.pn * 4 + wc) * 2) = o; }
            }
    }
};

DI void transpose_item(const float* W, int K, int N, bf16_t* WT, LAS float* scr, int item, int lane) {
    const int nblk = N / 32, kb = item / nblk, nb = item % nblk, k0 = 64 * kb, n0 = 32 * nb;
#pragma unroll 8
    for (int i = 0; i < 32; ++i) { const int kk = 2 * i + (lane >> 5); scr[kk * 33 + (lane & 31)] = W[(size_t)(k0 + kk) * N + n0 + (lane & 31)]; }
    LDS_WAIT();
    const int c = lane & 7;
#pragma unroll
    for (int j = 0; j < 4; ++j) {
        const int n = (lane >> 3) + 8 * j; const LAS float* s = scr + (8 * c) * 33 + n;
        u32x4 o; o.x = pk2(s[0 * 33], s[1 * 33]); o.y = pk2(s[2 * 33], s[3 * 33]); o.z = pk2(s[4 * 33], s[5 * 33]); o.w = pk2(s[6 * 33], s[7 * 33]);
        *(u32x4*)(WT + (size_t)(n0 + n) * K + k0 + 8 * c) = o;
    }
    LDS_WAIT();
}

DI void phase0(const Params& P, LAS unsigned char* lds, int tid, int lane, int wave) {
    tid = launder_v(tid); lane = launder_v(lane); wave = launder_s(wave);
    bf16_t* win_t = (bf16_t*)(P.ws + WS_WIN); bf16_t* wout_t = (bf16_t*)(P.ws + WS_WOUT); float* mod = (float*)(P.ws + WS_MOD);
    {
        LAS float* scr = (LAS float*)(lds + wave * 16384);
        const int gw = blockIdx.x * NWAVES + wave, NGW = gridDim.x * NWAVES;
        constexpr int I_IN = (D / 64) * (NIN / 32), I_OUT = (D / 64) * (D / 32);
        for (int it = gw; it < DEPTH * (I_IN + I_OUT); it += NGW) {
            const int l = it / (I_IN + I_OUT); int r = it % (I_IN + I_OUT);
            if (r < I_IN) transpose_item(P.w_in + (size_t)l * D * NIN, D, NIN, win_t + (size_t)l * NIN * D, scr, r, lane);
            else transpose_item(P.w_out + (size_t)l * D * D, D, D, wout_t + (size_t)l * D * D, scr, r - I_IN, lane);
        }
    }
    __syncthreads();
    LAS float* sc = (LAS float*)lds;
    for (int item = blockIdx.x; item < DEPTH * 96; item += gridDim.x) {
        const int l = item / 96, j0 = (item % 96) * 32;
        for (int e = tid; e < BATCH * D; e += NTHREADS) { const int b = e >> 10, k = e & 1023; sc[k * 32 + b] = silu_f(P.c[e]); }
        __syncthreads();
        const int j = tid & 31, ks = tid >> 5;
        float acc[32];
#pragma unroll
        for (int b = 0; b < 32; ++b) acc[b] = 0.f;
        const float* wp = P.ada_w + ((size_t)l * D + ks * 64) * 3072 + j0 + j;
#pragma unroll 2
        for (int kk = 0; kk < 64; ++kk) {
            const float w = wp[(size_t)kk * 3072];
            const LAS f32x4* s4 = (const LAS f32x4*)(sc + (ks * 64 + kk) * 32);
#pragma unroll
            for (int q = 0; q < 8; ++q) { const f32x4 v = s4[q]; acc[4 * q] += v[0] * w; acc[4 * q + 1] += v[1] * w; acc[4 * q + 2] += v[2] * w; acc[4 * q + 3] += v[3] * w; }
        }
        __syncthreads();
        LAS float* red = (LAS float*)lds;
#pragma unroll
        for (int b = 0; b < 32; ++b) red[(ks * 32 + b) * 32 + j] = acc[b];
        __syncthreads();
#pragma unroll
        for (int o2 = 0; o2 < 2; ++o2) {
            const int o = tid + o2 * NTHREADS, b = o >> 5, jj = o & 31;
            float s = P.ada_b[l * 3072 + j0 + jj];
#pragma unroll
            for (int q = 0; q < 16; ++q) s += red[(q * 32 + b) * 32 + jj];
            mod[((size_t)l * BATCH + b) * 3072 + j0 + jj] = s;
        }
        __syncthreads();
    }
}

template <int MODE>
DI void row_pass(const Params& P, int lane, int wave) {
    lane = launder_v(lane); wave = launder_s(wave);
    const int gw = blockIdx.x * NWAVES + wave, NGW = gridDim.x * NWAVES;
    const float* mod = (const float*)(P.ws + WS_MOD) + (MODE == 1 ? (size_t)BATCH * 3072 : 0);
    const float* pstat = (const float*)(P.ws + WS_PSTAT);
    float* rstat = (float*)(P.ws + WS_RSTAT);
    bf16_t* hb = (bf16_t*)(P.ws + WS_HB);
    const float* src = MODE == 0 ? P.x : (MODE == 1 ? (const float*)(P.ws + WS_R0) : (const float*)P.out);
    const float* lg = P.ln_g + (MODE == 2 ? D : 0); const float* lb = P.ln_b + (MODE == 2 ? D : 0);
    for (int row = gw; row < MTOK; row += NGW) {
        const int b = row >> 11;
        float mean = 0.f, rstd = 1.f;
        if (MODE != 0) {
            float s = 0.f, ss = 0.f;
            if (lane < 16) { const f32x2_t st = *(const f32x2_t*)(pstat + ((size_t)row * 16 + lane) * 2); s = st.x; ss = st.y; }
            s = wave_sum(s); ss = wave_sum(ss);
            mean = s * (1.f / D); const float var = fmaxf(ss * (1.f / D) - mean * mean, 0.f); rstd = 1.f / sqrtf(var + LN_EPS);
            if (MODE == 1 && lane == 0) { f32x2_t o = {mean, rstd}; *(f32x2_t*)(rstat + (size_t)row * 2) = o; }
        }
#pragma unroll
        for (int j = 0; j < 4; ++j) {
            const int col = 4 * lane + 256 * j;
            f32x4 v = *(const f32x4*)(src + (size_t)row * D + col);
            if (MODE != 0) { const f32x4 g = *(const f32x4*)(lg + col), bb = *(const f32x4*)(lb + col); v = (v - mean) * rstd * g + bb; }
            if (MODE == 2) { *(f32x4*)(P.out + (size_t)row * D + col) = v; }
            else {
                const f32x4 sh = *(const f32x4*)(mod + (size_t)b * 3072 + col), scl = *(const f32x4*)(mod + (size_t)b * 3072 + 1024 + col);
                v = v * (scl + 1.f) + sh;
                u32x2 o; o.x = pk2(v[0], v[1]); o.y = pk2(v[2], v[3]);
                *(u32x2*)(hb + (size_t)row * D + col) = o;
            }
        }
    }
}

constexpr int VT_PITCH = 272;
DI void sgu_unit(const Params& P, int l, int unit, LAS unsigned char* lds, int lane, int wave) {
    const bf16_t* p = (const bf16_t*)(P.ws + WS_P); bf16_t* Y = (bf16_t*)(P.ws + WS_Y);
    const int tok0 = unit * 128;
    {
        const float g0 = P.sgu_ln_g[l * 256 + lane], g1 = P.sgu_ln_g[l * 256 + 64 + lane], g2 = P.sgu_ln_g[l * 256 + 128 + lane], g3 = P.sgu_ln_g[l * 256 + 192 + lane];
        const float b0 = P.sgu_ln_b[l * 256 + lane], b1 = P.sgu_ln_b[l * 256 + 64 + lane], b2 = P.sgu_ln_b[l * 256 + 128 + lane], b3 = P.sgu_ln_b[l * 256 + 192 + lane];
#pragma unroll 4
        for (int i = 0; i < 16; ++i) {
            const int s = wave * 16 + i;
            const bf16_t* vp = p + (size_t)(tok0 + s) * NIN + C_VS + lane;
            const float v0 = bf2f(vp[0]), v1 = bf2f(vp[64]), v2 = bf2f(vp[128]), v3 = bf2f(vp[192]);
            const float mean = wave_sum((v0 + v1) + (v2 + v3)) * (1.f / 256.f);
            const float d0 = v0 - mean, d1 = v1 - mean, d2 = v2 - mean, d3 = v3 - mean;
            const float var = wave_sum((d0 * d0 + d1 * d1) + (d2 * d2 + d3 * d3)) * (1.f / 256.f);
            const float rstd = 1.f / sqrtf(var + LN_EPS);
            LAS bf16_t* vt = (LAS bf16_t*)(lds + lane * VT_PITCH + s * 2);
            vt[0] = (bf16_t)(pk2(d0 * rstd * g0 + b0, 0.f) & 0xffffu);
            vt[64 * VT_PITCH / 2] = (bf16_t)(pk2(d1 * rstd * g1 + b1, 0.f) & 0xffffu);
            vt[128 * VT_PITCH / 2] = (bf16_t)(pk2(d2 * rstd * g2 + b2, 0.f) & 0xffffu);
            vt[192 * VT_PITCH / 2] = (bf16_t)(pk2(d3 * rstd * g3 + b3, 0.f) & 0xffffu);
        }
    }
    __syncthreads();
    {
        const int h = wave & 3, dblk = wave >> 2, r = lane & 31, hh = lane >> 5;
        const int ch = h * 64 + 32 * dblk + r;
        f32x16 acc[4];
#pragma unroll
        for (int tb = 0; tb < 4; ++tb)
#pragma unroll
            for (int i = 0; i < 16; ++i) acc[tb][i] = 0.f;
        const float* wbase = P.sgu_w + ((size_t)(l * 4 + h) * 128) * 128;
#pragma unroll 1
        for (int ks = 0; ks < 8; ++ks) {
            const bf16x8 bfrag = *(const LAS bf16x8*)(lds + ch * VT_PITCH + (16 * ks + 8 * hh) * 2);
#pragma unroll
            for (int tb = 0; tb < 4; ++tb) {
                if (ks >= 4 && tb < 2) continue;
                const float* wp = wbase + (size_t)(32 * tb + r) * 128 + 16 * ks + 8 * hh;
                const f32x4 w0 = *(const f32x4*)wp, w1 = *(const f32x4*)(wp + 4);
                u32x4 a; a.x = pk2(w0[0], w0[1]); a.y = pk2(w0[2], w0[3]); a.z = pk2(w1[0], w1[1]); a.w = pk2(w1[2], w1[3]);
                acc[tb] = MFMA32(__builtin_bit_cast(bf16x8, a), bfrag, acc[tb]);
            }
        }
#pragma unroll
        for (int tb = 0; tb < 4; ++tb)
#pragma unroll
            for (int i = 0; i < 16; ++i) {
                const int t = 32 * tb + crow(i, hh);
                const size_t tok = (size_t)(tok0 + t);
                const float mixed = acc[tb][i] + P.sgu_b[(l * 4 + h) * 128 + t];
                const float u = bf2f(p[tok * NIN + C_U + ch]), gb = bf2f(p[tok * NIN + C_GB + ch]);
                Y[tok * D + 256 + ch] = (bf16_t)(pk2(u * mixed * silu_f(gb), 0.f) & 0xffffu);
            }
    }
    __syncthreads();
}

typedef short v4i16_t __attribute__((ext_vector_type(4)));
DI v4i16_t lds_tr16(const LAS unsigned char* p) { return __builtin_amdgcn_ds_read_tr16_b64_v4i16((LAS v4i16_t*)p); }
constexpr int OST_PITCH = 68;
DI void tile_epilogue(const f32x16& o0, const f32x16& o1, LAS float* ost, int lane, const bf16_t* grow  , bf16_t* yrow, const float* colscale) {
    const int r = lane & 31, hh = lane >> 5;
#pragma unroll
    for (int i = 0; i < 16; ++i) { ost[crow(i, hh) * OST_PITCH + r] = o0[i]; ost[crow(i, hh) * OST_PITCH + 32 + r] = o1[i]; }
#pragma unroll
    for (int it = 0; it < 4; ++it) {
        const int c = lane + 64 * it, q = c >> 3, dc = c & 7;
        const u32x4 g = *(const u32x4*)(grow + (size_t)q * NIN + dc * 8);
        const f32x4 a = *(const LAS f32x4*)(ost + q * OST_PITCH + dc * 8), b = *(const LAS f32x4*)(ost + q * OST_PITCH + dc * 8 + 4);
        f32x4 s0 = {1.f, 1.f, 1.f, 1.f}, s1 = s0;
        if (colscale) { s0 = *(const f32x4*)(colscale + dc * 8); s1 = *(const f32x4*)(colscale + dc * 8 + 4); }
        u32x4 w;
        w.x = pk2(a[0] * s0[0] * silu_f(bflo(g.x)), a[1] * s0[1] * silu_f(bfhi(g.x)));
        w.y = pk2(a[2] * s0[2] * silu_f(bflo(g.y)), a[3] * s0[3] * silu_f(bfhi(g.y)));
        w.z = pk2(b[0] * s1[0] * silu_f(bflo(g.z)), b[1] * s1[1] * silu_f(bfhi(g.z)));
        w.w = pk2(b[2] * s1[2] * silu_f(bflo(g.w)), b[3] * s1[3] * silu_f(bfhi(g.w)));
        *(u32x4*)(yrow + (size_t)q * D + dc * 8) = w;
    }
}

constexpr int PA_PITCH = 144;
DI void pool_wave(const Params& P, int l, int gw, int NGW, int lane, LAS unsigned char* wl) {
    const bf16_t* p = (const bf16_t*)(P.ws + WS_P); bf16_t* Y = (bf16_t*)(P.ws + WS_Y);
    const int g = gw & 3, r = lane & 31, hh = lane >> 5;
    const int win = 2 << g;
    LAS float* ost = (LAS float*)(wl + 7168);
    bf16x8 bw[4][2];
#pragma unroll
    for (int s = 0; s < 4; ++s)
#pragma unroll
        for (int db = 0; db < 2; ++db) {
            const float* wp = P.pool_w + ((size_t)(l * 4 + g) * 64 + 16 * s + 8 * hh) * 64 + 32 * db + r;
            u32x4 a; a.x = pk2(wp[0], wp[64]); a.y = pk2(wp[128], wp[192]); a.z = pk2(wp[256], wp[320]); a.w = pk2(wp[384], wp[448]);
            bw[s][db] = __builtin_bit_cast(bf16x8, a);
        }
    for (int tile = gw >> 2; tile < MTOK / 32; tile += NGW >> 2) {
        const int tok0 = tile * 32, pos0 = tok0 & (SEQ - 1), pos = pos0 + r;
#pragma unroll
        for (int it = 0; it < 6; ++it) {
            const int c = lane + 64 * it, row = c >> 3, dc = c & 7;
            u32x4 v = {0u, 0u, 0u, 0u};
            if (row >= 16 || pos0 != 0) v = *(const u32x4*)(p + (size_t)(tok0 - 16 + row) * NIN + C_A + g * 64 + dc * 8);
            *(LAS u32x4*)(wl + row * PA_PITCH + dc * 16) = v;
        }
        const int cnt = (pos + 1 < win) ? pos + 1 : win;
        const float inv = 1.f / (float)cnt;
        f32x16 acc0, acc1;
#pragma unroll
        for (int i = 0; i < 16; ++i) { acc0[i] = 0.f; acc1[i] = 0.f; }
#pragma unroll
        for (int s = 0; s < 4; ++s) {
            const LAS unsigned char* base = wl + (16 + r) * PA_PITCH + (16 * s + 8 * hh) * 2;
            const u32x4 own = *(const LAS u32x4*)base;
            float sum[8];
            sum[0] = bflo(own.x); sum[1] = bfhi(own.x); sum[2] = bflo(own.y); sum[3] = bfhi(own.y); sum[4] = bflo(own.z); sum[5] = bfhi(own.z); sum[6] = bflo(own.w); sum[7] = bfhi(own.w);
            for (int j = 1; j < win; ++j) {
                const u32x4 v = *(const LAS u32x4*)(base - j * PA_PITCH);
                sum[0] += bflo(v.x); sum[1] += bfhi(v.x); sum[2] += bflo(v.y); sum[3] += bfhi(v.y); sum[4] += bflo(v.z); sum[5] += bfhi(v.z); sum[6] += bflo(v.w); sum[7] += bfhi(v.w);
            }
            u32x4 a;
            a.x = pk2(sum[0] * inv - bflo(own.x), sum[1] * inv - bfhi(own.x)); a.y = pk2(sum[2] * inv - bflo(own.y), sum[3] * inv - bfhi(own.y));
            a.z = pk2(sum[4] * inv - bflo(own.z), sum[5] * inv - bfhi(own.z)); a.w = pk2(sum[6] * inv - bflo(own.w), sum[7] * inv - bfhi(own.w));
            const bf16x8 af = __builtin_bit_cast(bf16x8, a);
            acc0 = MFMA32(af, bw[s][0], acc0);
            acc1 = MFMA32(af, bw[s][1], acc1);
        }
        tile_epilogue(acc0, acc1, ost, lane, p + (size_t)tok0 * NIN + C_GA + g * 64, Y + (size_t)tok0 * D + g * 64, P.pool_scale + l * 256 + g * 64);
    }
}

DI void attn_unit(const Params& P, int unit, int lane, LAS unsigned char* wl) {
    const bf16_t* p = (const bf16_t*)(P.ws + WS_P); bf16_t* Y = (bf16_t*)(P.ws + WS_Y);
    const int qt = unit & 63, h = (unit >> 6) & 7, b = unit >> 9;
    const int r = lane & 31, hh = lane >> 5;
    const size_t tokb = (size_t)b * SEQ;
    LAS float* ost = (LAS float*)(wl + 4096);
    bf16x8 qf[4];
    {
        const bf16_t* qp = p + (tokb + qt * 32 + r) * NIN + C_Q + h * 64 + 8 * hh;
#pragma unroll
        for (int s = 0; s < 4; ++s) qf[s] = *(const bf16x8*)(qp + 16 * s);
    }
    const bf16_t* kp0 = p + (tokb + r) * NIN + C_K + h * 64 + 8 * hh;
    const bf16_t* vp0 = p + (tokb + (lane >> 3)) * NIN + C_V + h * 64 + (lane & 7) * 8;
    const int vlds = ((lane & 7) >> 2) * 2048 + (lane >> 3) * 64 + (lane & 3) * 16;
    const int trbase = (4 * hh + ((lane & 15) >> 2)) * 64 + ((lane >> 4) & 1) * 32 + (lane & 3) * 8;
    bf16x8 kn[4]; u32x4 vn[4];
    {
        const size_t o = (size_t)qt * 32 * NIN;
#pragma unroll
        for (int s = 0; s < 4; ++s) kn[s] = *(const bf16x8*)(kp0 + o + 16 * s);
#pragma unroll
        for (int it = 0; it < 4; ++it) vn[it] = *(const u32x4*)(vp0 + o + (size_t)it * 8 * NIN);
    }
    f32x16 o0, o1;
#pragma unroll
    for (int i = 0; i < 16; ++i) { o0[i] = 0.f; o1[i] = 0.f; }
    float carry = 0.f;
    const float CZ = 0.125f * LOG2E;
    for (int kb = qt; kb >= 0; --kb) {
        bf16x8 kf[4];
#pragma unroll
        for (int s = 0; s < 4; ++s) kf[s] = kn[s];
#pragma unroll
        for (int it = 0; it < 4; ++it) *(LAS u32x4*)(wl + vlds + it * 512) = vn[it];
        if (kb > 0) {
            const size_t o = (size_t)(kb - 1) * 32 * NIN;
#pragma unroll
            for (int s = 0; s < 4; ++s) kn[s] = *(const bf16x8*)(kp0 + o + 16 * s);
#pragma unroll
            for (int it = 0; it < 4; ++it) vn[it] = *(const u32x4*)(vp0 + o + (size_t)it * 8 * NIN);
        }
        f32x16 z;
#pragma unroll
        for (int i = 0; i < 16; ++i) z[i] = 0.f;
#pragma unroll
        for (int s = 0; s < 4; ++s) z = MFMA32(kf[s], qf[s], z);
        float l1m[16], lbv[16];
#pragma unroll
        for (int i = 0; i < 16; ++i) {
            const float t = z[i] * CZ;
            const float e = __builtin_amdgcn_exp2f(-fabsf(t));
            const float sp = fmaxf(t, 0.f) + __builtin_amdgcn_logf(1.f + e);
            l1m[i] = -sp; lbv[i] = t - sp;
        }
        if (kb == qt) {
#pragma unroll
            for (int i = 0; i < 16; ++i) if (crow(i, hh) >= r) { l1m[i] = 0.f; lbv[i] = -__builtin_inff(); }
        }
        float gs[4], og[4];
#pragma unroll
        for (int q = 0; q < 4; ++q) { gs[q] = (l1m[4 * q] + l1m[4 * q + 1]) + (l1m[4 * q + 2] + l1m[4 * q + 3]); og[q] = __shfl_xor(gs[q], 32); }
        float suf = carry;
        float a[16];
#pragma unroll
        for (int q = 3; q >= 0; --q) {
            float lat = suf + (hh == 0 ? og[q] : 0.f);
            a[4 * q + 3] = __builtin_amdgcn_exp2f(lbv[4 * q + 3] + lat); lat += l1m[4 * q + 3];
            a[4 * q + 2] = __builtin_amdgcn_exp2f(lbv[4 * q + 2] + lat); lat += l1m[4 * q + 2];
            a[4 * q + 1] = __builtin_amdgcn_exp2f(lbv[4 * q + 1] + lat); lat += l1m[4 * q + 1];
            a[4 * q] = __builtin_amdgcn_exp2f(lbv[4 * q] + lat);
            suf += gs[q] + og[q];
        }
        carry = suf;
        u32x4 pa0, pa1;
        pa0.x = pk2(a[0], a[1]); pa0.y = pk2(a[2], a[3]); pa0.z = pk2(a[4], a[5]); pa0.w = pk2(a[6], a[7]);
        pa1.x = pk2(a[8], a[9]); pa1.y = pk2(a[10], a[11]); pa1.z = pk2(a[12], a[13]); pa1.w = pk2(a[14], a[15]);
        bf16x8 vf[2][2];
#pragma unroll
        for (int s = 0; s < 2; ++s)
#pragma unroll
            for (int db = 0; db < 2; ++db) {
                const v4i16_t lo = lds_tr16(wl + trbase + db * 2048 + (16 * s) * 64), hi = lds_tr16(wl + trbase + db * 2048 + (16 * s + 8) * 64);
                vf[s][db] = __builtin_shufflevector(lo, hi, 0, 1, 2, 3, 4, 5, 6, 7);
            }
        o0 = MFMA32(__builtin_bit_cast(bf16x8, pa0), vf[0][0], o0);
        o0 = MFMA32(__builtin_bit_cast(bf16x8, pa1), vf[1][0], o0);
        o1 = MFMA32(__builtin_bit_cast(bf16x8, pa0), vf[0][1], o1);
        o1 = MFMA32(__builtin_bit_cast(bf16x8, pa1), vf[1][1], o1);
        if (__ballot(carry > -160.f) == 0ull) break;
    }
    const size_t t0 = tokb + qt * 32;
    tile_epilogue(o0, o1, ost, lane, p + t0 * NIN + C_GC + h * 64, Y + t0 * D + 512 + h * 64, nullptr);
}

DI void mixers(const Params& P, int l, LAS unsigned char* lds, int lane, int wave) {
    lane = launder_v(lane); wave = launder_s(wave);
    const int gw = blockIdx.x * NWAVES + wave, NGW = gridDim.x * NWAVES;
#ifndef MXMASK
#define MXMASK 7
#endif
    for (int rep = 0; rep < ((DUP & 4) ? 2 : 1); ++rep)
    if (MXMASK & 1) for (int unit = blockIdx.x; unit < BATCH * 16; unit += gridDim.x) sgu_unit(P, l, unit, lds, lane, wave);
    for (int rep = 0; rep < ((DUP & 8) ? 2 : 1); ++rep)
    if (MXMASK & 2) pool_wave(P, l, gw, NGW, lane, lds + wave * 16384);
    for (int rep = 0; rep < ((DUP & 16) ? 2 : 1); ++rep)
    if (MXMASK & 4) for (int unit = gw; unit < BATCH * 8 * 64; unit += NGW) attn_unit(P, unit, lane, lds + wave * 16384);
}

__global__ void __launch_bounds__(NTHREADS, 2) fwd_mega(Params P) {
    extern __shared__ __attribute__((aligned(16))) unsigned char lds_raw[];
    LAS unsigned char* lds = (LAS unsigned char*)lds_raw;
    cg::grid_group grid = cg::this_grid();
    const int tid = threadIdx.x, lane = tid & 63, wave = __builtin_amdgcn_readfirstlane(tid >> 6);
    const int lo = P.ph_lo, hi = P.ph_hi;
#ifndef PHMASK
#define PHMASK 0x3ff
#endif
#define IN(k) (((PHMASK >> (k)) & 1) && lo <= (k) && (k) < hi)
#define SEAM(k) do { if (IN(k) && IN((k) + 1)) grid.sync(); } while (0)
    bf16_t* hb = (bf16_t*)(P.ws + WS_HB); bf16_t* pbuf = (bf16_t*)(P.ws + WS_P); bf16_t* ybuf = (bf16_t*)(P.ws + WS_Y);
    const bf16_t* win_t = (const bf16_t*)(P.ws + WS_WIN); const bf16_t* wout_t = (const bf16_t*)(P.ws + WS_WOUT);
    const float* mod = (const float*)(P.ws + WS_MOD);

    if (IN(0)) for (int rep = 0; rep < ((DUP & 64) ? 2 : 1); ++rep) phase0(P, lds, tid, lane, wave);
    SEAM(0);
    if (IN(1)) for (int rep = 0; rep < ((DUP & 32) ? 2 : 1); ++rep) row_pass<0>(P, lane, wave);
    SEAM(1);
#pragma unroll 1
    for (int l = 0; l < DEPTH; ++l) {
        const int pb = 2 + 4 * l;
        if (IN(pb)) for (int rep = 0; rep < ((DUP & 1) ? 2 : 1); ++rep) {
            pg8::Gemm g{hb, win_t + (size_t)l * NIN * D, MTOK, NIN, D}; pg8::StaticOrder S; S.init(MTOK, NIN, (int)gridDim.x, (int)blockIdx.x);
            EpiP E{pbuf};
            pg8::gemm_phase<EpiP, pg8::StaticOrder, true, true>(lds, g, S, E);
        }
        SEAM(pb);
        if (IN(pb + 1)) mixers(P, l, lds, lane, wave);
        SEAM(pb + 1);
        if (IN(pb + 2)) for (int rep = 0; rep < ((DUP & 2) ? 2 : 1); ++rep) {
            pg8::Gemm g{ybuf, wout_t + (size_t)l * D * D, MTOK, D, D}; pg8::StaticOrder S; S.init(MTOK, D, (int)gridDim.x, (int)blockIdx.x);
            EpiRes E{l == 0 ? P.x : (const float*)(P.ws + WS_R0), l == 0 ? nullptr : (const float*)(P.ws + WS_RSTAT), P.ln_g, P.ln_b,
                     mod + (size_t)l * BATCH * 3072 + 2048, l == 0 ? (float*)(P.ws + WS_R0) : P.out, (float*)(P.ws + WS_PSTAT)};
            pg8::gemm_phase<EpiRes, pg8::StaticOrder, true, true>(lds, g, S, E);
        }
        SEAM(pb + 2);
        if (IN(pb + 3)) { if (l == 0) { for (int rep = 0; rep < ((DUP & 32) ? 2 : 1); ++rep) row_pass<1>(P, lane, wave); } else row_pass<2>(P, lane, wave); }
        SEAM(pb + 3);
    }
#undef IN
#undef SEAM
}

#ifndef N_LAUNCH_PER_PHASE
#define N_LAUNCH_PER_PHASE 0
#endif
extern "C" void kernel_launch(void* const* d_in, const int* in_sizes, int n_in, void* d_out, int out_size, void* d_ws, size_t ws_size, hipStream_t stream) {
    static int grid = 0;
    if (grid == 0) {
        if (n_in != 14 || out_size != MTOK * D || ws_size < WS_END) { fprintf(stderr, "kernel_launch: unexpected shapes (n_in %d out %d ws %zu need %zu)\n", n_in, out_size, ws_size, (size_t)WS_END); grid = -1; return; }
        int dev = 0, cus = 0, per_cu = 0;
        hipGetDevice(&dev);
        hipDeviceGetAttribute(&cus, hipDeviceAttributeMultiprocessorCount, dev);
        if (hipFuncSetAttribute((const void*)fwd_mega, hipFuncAttributeMaxDynamicSharedMemorySize, LDS_BYTES) != hipSuccess) { fprintf(stderr, "kernel_launch: hipFuncSetAttribute failed\n"); grid = -1; return; }
        if (hipOccupancyMaxActiveBlocksPerMultiprocessor(&per_cu, (const void*)fwd_mega, NTHREADS, LDS_BYTES) != hipSuccess || per_cu < 1) { fprintf(stderr, "kernel_launch: occupancy query says %d\n", per_cu); per_cu = 1; }
        (void)hipGetLastError();
        grid = cus * 1;
        if (grid != 256) fprintf(stderr, "kernel_launch: note: grid %d\n", grid);
    }
    if (grid < 0) return;
    Params p{};
    p.x = (const float*)d_in[0]; p.c = (const float*)d_in[1]; p.w_in = (const float*)d_in[2]; p.pool_w = (const float*)d_in[3]; p.pool_scale = (const float*)d_in[4];
    p.sgu_ln_g = (const float*)d_in[5]; p.sgu_ln_b = (const float*)d_in[6]; p.sgu_w = (const float*)d_in[7]; p.sgu_b = (const float*)d_in[8]; p.w_out = (const float*)d_in[9];
    p.ada_w = (const float*)d_in[10]; p.ada_b = (const float*)d_in[11]; p.ln_g = (const float*)d_in[12]; p.ln_b = (const float*)d_in[13];
    p.out = (float*)d_out; p.ws = (unsigned char*)d_ws;
#if N_LAUNCH_PER_PHASE
    for (int ph = 0; ph < 10; ++ph) {
        p.ph_lo = ph; p.ph_hi = ph + 1;
        hipLaunchKernelGGL(fwd_mega, dim3(grid), dim3(NTHREADS), LDS_BYTES, stream, p);
    }
#else
    p.ph_lo = 0; p.ph_hi = 10;
    void* args[] = {&p};
    hipError_t e = hipLaunchCooperativeKernel((const void*)fwd_mega, dim3(grid), dim3(NTHREADS), args, LDS_BYTES, stream);
    if (e != hipSuccess) fprintf(stderr, "kernel_launch: cooperative launch failed: %s (grid %d)\n", hipGetErrorString(e), grid);
#endif
}
```

```cpp
#include <hip/hip_runtime.h>
#include <hip/hip_cooperative_groups.h>
#include <cstdio>
#include <cstdint>
namespace cg = cooperative_groups;
__device__ __forceinline__ int launder_v(int x) { asm volatile("" : "+v"(x)); return x; }
__device__ __forceinline__ int launder_s(int x) { asm volatile("" : "+s"(x)); return x; }
namespace pg8 {
#define PG8_LAS __attribute__((address_space(3)))
typedef unsigned short bf16_t;
typedef short bf16x8 __attribute__((ext_vector_type(8)));
typedef float f32x4 __attribute__((ext_vector_type(4)));
typedef unsigned u32x4 __attribute__((ext_vector_type(4)));
constexpr int BM = 256, BK = 64, HALF = 128, HTB = HALF * BK * 2  , STAGE_BYTES = 8 * HTB, NXCD = 8, WGM = 8;

__host__ __device__ __forceinline__ int lds_byte(int r, int c) { const int st = (r >> 4) * 2 + (c >> 5), rr = r & 15, cc = c & 31, ob = rr * 64 + cc * 2; return st * 1024 + (ob ^ (((ob >> 9) & 1) << 5)); }
__host__ __device__ __forceinline__ void stage_rc(int b, int& R, int& C) { const int st = b / 1024, sb = b % 1024, swz = sb ^ (((sb >> 9) & 1) << 5); R = (st >> 1) * 16 + swz / 64; C = (st & 1) * 32 + (swz % 64) / 2; }
__host__ __device__ __forceinline__ int perm32(int rho) { const int n = rho >> 4, i = rho & 15; return 8 * (i >> 2) + 4 * n + (i & 3); }

struct Unit { int pm, pn; };
struct Gemm { const bf16_t* A; const bf16_t* Bt; int M, N, K; };

struct StaticOrder {
    int nM, nN, nwg, G, c;
    __host__ __device__ void init(int M, int N, int G_, int c_) { nM = M / BM; nN = N / BM; nwg = nM * nN; G = G_; c = c_; }
    __host__ __device__ bool next(int i, Unit& u) const {
        const long L = (long)i * G + c; if (L >= nwg) return false;
        int wgid = (int)L; { const int q = nwg / NXCD, r = nwg % NXCD, xcd = wgid % NXCD, off = wgid / NXCD; wgid = (xcd < r ? xcd * (q + 1) : r * (q + 1) + (xcd - r) * q) + off; }
        const int nig = WGM * nN, gid = wgid / nig, fm = gid * WGM, gsz = (nM - fm) < WGM ? (nM - fm) : WGM;
        u.pm = fm + ((wgid % nig) % gsz); u.pn = (wgid % nig) / gsz; return true;
    }
    __device__ __forceinline__ void a_ready(const Unit&) const {}
    __device__ __forceinline__ void done(const Unit&) const {}
};

__device__ __forceinline__ unsigned cvt_pk_bf16(float lo, float hi) { unsigned r; asm volatile("v_cvt_pk_bf16_f32 %0, %1, %2" : "=v"(r) : "v"(lo), "v"(hi)); return r; }
template <class Epi, class Sched, bool ALIGN_EPI = false, bool SP2 = false>
__device__ __forceinline__ void gemm_phase(PG8_LAS unsigned char* lds, const Gemm g, const Sched& S, const Epi& E) {
    const int tid = launder_v(threadIdx.x), wid = __builtin_amdgcn_readfirstlane(tid >> 6), lane = tid & 63, wr = wid >> 2, wc = wid & 3, fr = lane & 15, fq = lane >> 4;
    const int K = g.K, nt = K / BK;
    unsigned voffA[2], voffB[2];
#pragma unroll
    for (int i = 0; i < 2; ++i) { int R, C; stage_rc(tid * 16 + i * 8192, R, C); const int Rb = Epi::PERM ? ((R & ~31) + perm32(R & 31)) : R;
        voffA[i] = (unsigned)(R * K + C) * 2u; voffB[i] = (unsigned)(Rb * K + C) * 2u; }
    const size_t kstep = (size_t)(BK * 2);
    const size_t hstep = (size_t)HALF * K * 2;
    const size_t tstep = 2 * hstep;
    const unsigned ldsw = (unsigned)wid * 1024u;
    const int aoff = lds_byte(wr * 64 + fr, fq * 8), boff = lds_byte(wc * 32 + fr, fq * 8);
#define PG8_SA(b, h) (((b) * 2 + (h)) * HTB)
#define PG8_SB(b, h) ((4 + (b) * 2 + (h)) * HTB)
#define PG8_STAGE(bufoff, gbase, voff) do { _Pragma("unroll") for (int _i = 0; _i < 2; ++_i) \
        __builtin_amdgcn_global_load_lds((const unsigned*)((const char*)(gbase) + (voff)[_i]), (PG8_LAS unsigned*)(lds + (bufoff) + ldsw + _i * 8192), 16, 0, 0); } while (0)
#define PG8_LDA(dst, b, h) do { _Pragma("unroll") for (int m = 0; m < 4; ++m) _Pragma("unroll") for (int k = 0; k < 2; ++k) dst[m][k] = *(const PG8_LAS bf16x8*)(lds + PG8_SA(b, h) + aoff + m * 2048 + k * 1024); } while (0)
#define PG8_LDB(dst, b, h) do { _Pragma("unroll") for (int n = 0; n < 2; ++n) _Pragma("unroll") for (int k = 0; k < 2; ++k) dst[n][k] = *(const PG8_LAS bf16x8*)(lds + PG8_SB(b, h) + boff + n * 2048 + k * 1024); } while (0)
#define PG8_MMA(ai, bj, At, Bt) do { __builtin_amdgcn_s_setprio(1); _Pragma("unroll") for (int m = 0; m < 4; ++m) _Pragma("unroll") for (int n = 0; n < 2; ++n) _Pragma("unroll") for (int k = 0; k < 2; ++k) \
        acc[ai][bj][m][n] = __builtin_amdgcn_mfma_f32_16x16x32_bf16(Bt[n][k], At[m][k], acc[ai][bj][m][n], 0, 0, 0); __builtin_amdgcn_s_setprio(0); } while (0)
#define PG8_WAIT_V(n) asm volatile("s_waitcnt vmcnt(" #n ")" ::: "memory")
#define PG8_WAIT_L(n) asm volatile("s_waitcnt lgkmcnt(" #n ")" ::: "memory")
#define PG8_BAR __builtin_amdgcn_s_barrier()
#define PG8_SCHED __builtin_amdgcn_sched_barrier(0)
    Unit cur, nxt; int ui = 0;
    if (!S.next(0, cur)) return;
    f32x4 acc[2][2][4][2];
#pragma unroll
    for (int a = 0; a < 2; ++a)
#pragma unroll
        for (int b = 0; b < 2; ++b)
#pragma unroll
            for (int m = 0; m < 4; ++m)
#pragma unroll
                for (int n = 0; n < 2; ++n) acc[a][b][m][n] = (f32x4){0.f, 0.f, 0.f, 0.f};
    bf16x8 At[4][2], B0[2][2], B1[2][2];
    const char* cA = (const char*)g.A + (size_t)cur.pm * tstep; const char* cB = (const char*)g.Bt + (size_t)cur.pn * tstep;
    S.a_ready(cur);
    if constexpr (SP2) {
        PG8_STAGE(PG8_SB(0, 0), cB, voffB); PG8_STAGE(PG8_SB(0, 1), cB + hstep, voffB); PG8_STAGE(PG8_SA(0, 0), cA, voffA); PG8_STAGE(PG8_SA(0, 1), cA + hstep, voffA);
        if (wr == 1) PG8_BAR;
        PG8_WAIT_V(2); PG8_BAR;
        PG8_STAGE(PG8_SB(1, 0), cB + kstep, voffB); PG8_STAGE(PG8_SA(1, 0), cA + kstep, voffA); PG8_STAGE(PG8_SB(1, 1), cB + hstep + kstep, voffB);
        PG8_WAIT_V(6); PG8_BAR;
    } else {
        PG8_STAGE(PG8_SB(0, 0), cB, voffB); PG8_STAGE(PG8_SA(0, 0), cA, voffA); PG8_STAGE(PG8_SB(0, 1), cB + hstep, voffB); PG8_STAGE(PG8_SA(0, 1), cA + hstep, voffA);
        if (wr == 1) PG8_BAR;
        PG8_WAIT_V(4); PG8_BAR;
        PG8_STAGE(PG8_SB(1, 0), cB + kstep, voffB); PG8_STAGE(PG8_SA(1, 0), cA + kstep, voffA); PG8_STAGE(PG8_SB(1, 1), cB + hstep + kstep, voffB);
        PG8_WAIT_V(6); PG8_BAR;
    }
    for (;;) {
        const bool has_next = S.next(ui + 1, nxt);
        const char* nA = has_next ? (const char*)g.A + (size_t)nxt.pm * tstep : cA; const char* nB = has_next ? (const char*)g.Bt + (size_t)nxt.pn * tstep : cB;
        for (int t = 0; t < nt; t += 2) {
            const bool last = (t == nt - 2);
            const char* a1 = cA + (size_t)(t + 1) * kstep;
            const char* a2 = last ? nA : cA + (size_t)(t + 2) * kstep; const char* b2 = last ? nB : cB + (size_t)(t + 2) * kstep;
            const char* a3 = a2 + kstep; const char* b3 = b2 + kstep;
            if (last && has_next) S.a_ready(nxt);
            if constexpr (SP2) {
            PG8_LDB(B0, 0, 0); PG8_LDB(B1, 0, 1); PG8_SCHED; PG8_LDA(At, 0, 0); PG8_STAGE(PG8_SA(1, 1), a1 + hstep, voffA);
            PG8_WAIT_V(8); PG8_WAIT_L(0); PG8_BAR; PG8_MMA(0, 0, At, B0); PG8_MMA(0, 1, At, B1); PG8_BAR; PG8_SCHED;
            PG8_LDA(At, 0, 1); PG8_STAGE(PG8_SB(0, 0), b2, voffB); PG8_STAGE(PG8_SB(0, 1), b2 + hstep, voffB); PG8_STAGE(PG8_SA(0, 0), a2, voffA);
            PG8_WAIT_V(8); PG8_WAIT_L(0); PG8_BAR; PG8_MMA(1, 0, At, B0); PG8_MMA(1, 1, At, B1); PG8_BAR; PG8_SCHED;
            PG8_LDB(B0, 1, 0); PG8_LDB(B1, 1, 1); PG8_SCHED; PG8_LDA(At, 1, 0); PG8_STAGE(PG8_SA(0, 1), a2 + hstep, voffA);
            PG8_WAIT_V(8); PG8_WAIT_L(0); PG8_BAR; PG8_MMA(0, 0, At, B0); PG8_MMA(0, 1, At, B1); PG8_BAR; PG8_SCHED;
            PG8_LDA(At, 1, 1); PG8_STAGE(PG8_SB(1, 0), b3, voffB); PG8_STAGE(PG8_SB(1, 1), b3 + hstep, voffB); PG8_STAGE(PG8_SA(1, 0), a3, voffA);
            PG8_WAIT_V(8); PG8_WAIT_L(0); PG8_BAR; PG8_MMA(1, 0, At, B0); PG8_MMA(1, 1, At, B1); PG8_BAR; PG8_SCHED;
            } else {
            PG8_LDB(B0, 0, 0); PG8_SCHED; PG8_LDA(At, 0, 0); PG8_STAGE(PG8_SA(1, 1), a1 + hstep, voffA);
            PG8_WAIT_L(8); PG8_BAR; PG8_WAIT_L(0); PG8_MMA(0, 0, At, B0); PG8_BAR; PG8_SCHED;
            PG8_LDB(B1, 0, 1); PG8_STAGE(PG8_SB(0, 0), b2, voffB);
            PG8_BAR; PG8_WAIT_L(0); PG8_MMA(0, 1, At, B1); PG8_BAR;
            PG8_LDA(At, 0, 1); PG8_STAGE(PG8_SA(0, 0), a2, voffA);
            PG8_BAR; PG8_WAIT_L(0); PG8_MMA(1, 0, At, B0); PG8_BAR; PG8_SCHED;
            PG8_STAGE(PG8_SB(0, 1), b2 + hstep, voffB);
            PG8_WAIT_V(6); PG8_BAR; PG8_MMA(1, 1, At, B1); PG8_BAR;
            PG8_LDB(B0, 1, 0); PG8_SCHED; PG8_LDA(At, 1, 0); PG8_STAGE(PG8_SA(0, 1), a2 + hstep, voffA);
            PG8_WAIT_L(8); PG8_BAR; PG8_WAIT_L(0); PG8_MMA(0, 0, At, B0); PG8_BAR; PG8_SCHED;
            PG8_LDB(B1, 1, 1); PG8_STAGE(PG8_SB(1, 0), b3, voffB);
            PG8_BAR; PG8_WAIT_L(0); PG8_MMA(0, 1, At, B1); PG8_BAR;
            PG8_LDA(At, 1, 1); PG8_STAGE(PG8_SA(1, 0), a3, voffA);
            PG8_BAR; PG8_WAIT_L(0); PG8_MMA(1, 0, At, B0); PG8_BAR; PG8_SCHED;
            PG8_STAGE(PG8_SB(1, 1), b3 + hstep, voffB);
            PG8_WAIT_V(6); PG8_BAR; PG8_MMA(1, 1, At, B1); PG8_BAR;
            }
        }
        if constexpr (ALIGN_EPI) { if (wr == 0) PG8_BAR; }
        if constexpr (!Epi::AFTER_DRAIN) { E(acc, cur, wr, wc, fr, fq); S.done(cur); }
        if (!has_next) break;
#pragma unroll
        for (int a = 0; a < 2; ++a)
#pragma unroll
            for (int b = 0; b < 2; ++b)
#pragma unroll
                for (int m = 0; m < 4; ++m)
#pragma unroll
                    for (int n = 0; n < 2; ++n) acc[a][b][m][n] = (f32x4){0.f, 0.f, 0.f, 0.f};
        cur = nxt; cA = nA; cB = nB; ++ui;
        if constexpr (ALIGN_EPI) { if (wr == 1) PG8_BAR; }
    }
    PG8_WAIT_V(0);
    if constexpr (!ALIGN_EPI) { if (wr == 0) PG8_BAR; }
    PG8_BAR;
    if constexpr (Epi::AFTER_DRAIN) { E.fused(acc, cur, wr, wc, fr, fq, lds, wid, lane); S.done(cur); }
#undef PG8_SA
#undef PG8_SB
#undef PG8_STAGE
#undef PG8_LDA
#undef PG8_LDB
#undef PG8_MMA
#undef PG8_WAIT_V
#undef PG8_WAIT_L
#undef PG8_BAR
#undef PG8_SCHED
}
}

#define DI __device__ __forceinline__
#define LAS __attribute__((address_space(3)))
typedef unsigned short bf16_t;
typedef short bf16x8 __attribute__((ext_vector_type(8)));
typedef float f32x4 __attribute__((ext_vector_type(4)));
typedef float f32x16 __attribute__((ext_vector_type(16)));
typedef unsigned u32x4 __attribute__((ext_vector_type(4)));
typedef unsigned u32x2 __attribute__((ext_vector_type(2)));
typedef __bf16 bf16x2_t __attribute__((ext_vector_type(2)));
typedef float f32x2_t __attribute__((ext_vector_type(2)));

constexpr int D = 1024, BATCH = 32, SEQ = 2048, MTOK = BATCH * SEQ, NIN = 3328, DEPTH = 2;
constexpr int C_A = 0, C_GA = 256, C_U = 512, C_VS = 768, C_GB = 1024, C_Q = 1280, C_K = 1792, C_V = 2304, C_GC = 2816;
constexpr float DN_ALPHA = 1.41421356237309515f;
constexpr float LN_EPS = 1e-5f;
constexpr float LOG2E = 1.44269504088896341f;

constexpr size_t WS_WIN = 0;
constexpr size_t WS_WOUT = WS_WIN + (size_t)DEPTH * NIN * D * 2;
constexpr size_t WS_MOD = WS_WOUT + (size_t)DEPTH * D * D * 2;
constexpr size_t WS_HB = WS_MOD + (size_t)DEPTH * BATCH * 3 * D * 4;
constexpr size_t WS_P = WS_HB + (size_t)MTOK * D * 2;
constexpr size_t WS_Y = WS_P + (size_t)MTOK * NIN * 2;
constexpr size_t WS_R0 = WS_Y + (size_t)MTOK * D * 2;
constexpr size_t WS_PSTAT = WS_R0 + (size_t)MTOK * D * 4;
constexpr size_t WS_RSTAT = WS_PSTAT + (size_t)MTOK * 16 * 2 * 4;
constexpr size_t WS_END = WS_RSTAT + (size_t)MTOK * 2 * 4;

constexpr int LDS_BYTES = 139264;
constexpr int NTHREADS = 512, NWAVES = 8;
#ifndef DUP
#define DUP 0
#endif

struct Params {
    const float *x, *c, *w_in, *pool_w, *pool_scale, *sgu_ln_g, *sgu_ln_b, *sgu_w, *sgu_b, *w_out, *ada_w, *ada_b, *ln_g, *ln_b;
    float* out; unsigned char* ws;
    int ph_lo, ph_hi;
};

DI unsigned pk2(float lo, float hi) { f32x2_t v = {lo, hi}; bf16x2_t b = __builtin_convertvector(v, bf16x2_t); return __builtin_bit_cast(unsigned, b); }
DI float bf2f(unsigned short u) { return __builtin_bit_cast(float, (unsigned)u << 16); }
DI float bflo(unsigned u) { return __builtin_bit_cast(float, u << 16); }
DI float bfhi(unsigned u) { return __builtin_bit_cast(float, u & 0xffff0000u); }
DI float silu_f(float v) { return v * __builtin_amdgcn_rcpf(1.f + __builtin_amdgcn_exp2f(-v * LOG2E)); }
DI float wave_sum(float v) {
#pragma unroll
    for (int o = 1; o < 64; o <<= 1) v += __shfl_xor(v, o);
    return v;
}
DI float swap32(float v, int hh) {
    const unsigned u = __builtin_bit_cast(unsigned, v);
    const auto rr = __builtin_amdgcn_permlane32_swap(u, u, false, false);
    return __builtin_bit_cast(float, hh ? rr[0] : rr[1]);
}
DI int crow(int i, int hh) { return (i & 3) + 8 * (i >> 2) + 4 * hh; }
#define MFMA32(a, b, c) __builtin_amdgcn_mfma_f32_32x32x16_bf16((a), (b), (c), 0, 0, 0)
#define LDS_WAIT() asm volatile("s_waitcnt lgkmcnt(0)" ::: "memory")

struct EpiP {
    static constexpr bool PERM = true, AFTER_DRAIN = false;
    bf16_t* O;
    DI void operator()(const pg8::f32x4 (&acc)[2][2][4][2], const pg8::Unit& u, int wr, int wc, int fr, int fq) const {
        const int row0 = u.pm * 256 + wr * 64 + fr, col0 = u.pn * 256 + wc * 32 + 8 * fq;
#pragma unroll
        for (int ai = 0; ai < 2; ++ai)
#pragma unroll
            for (int m = 0; m < 4; ++m) {
                bf16_t* rowp = O + (size_t)(row0 + ai * 128 + m * 16) * NIN + col0;
#pragma unroll
                for (int bj = 0; bj < 2; ++bj) {
                    const pg8::f32x4 v0 = acc[ai][bj][m][0], v1 = acc[ai][bj][m][1];
                    u32x4 w; w.x = pk2(v0[0], v0[1]); w.y = pk2(v0[2], v0[3]); w.z = pk2(v1[0], v1[1]); w.w = pk2(v1[2], v1[3]);
                    *(u32x4*)(rowp + bj * 128) = w;
                }
            }
    }
};
struct EpiRes {
    static constexpr bool PERM = true, AFTER_DRAIN = false;
    const float* xsrc;
    const float* rstat;
    const float* lng; const float* lnb;
    const float* gate;
    float* R; float* pstat;
    DI void operator()(const pg8::f32x4 (&acc)[2][2][4][2], const pg8::Unit& u, int wr, int wc, int fr, int fq) const {
        const int row0 = u.pm * 256 + wr * 64 + fr, col0 = u.pn * 256 + wc * 32 + 8 * fq;
        const int b = (u.pm * 256) >> 11;
        f32x4 ga[2][2];
#pragma unroll
        for (int bj = 0; bj < 2; ++bj)
#pragma unroll
            for (int n = 0; n < 2; ++n) ga[bj][n] = *(const f32x4*)(gate + (size_t)b * 3072 + col0 + bj * 128 + 4 * n);
#pragma unroll
        for (int ai = 0; ai < 2; ++ai)
#pragma unroll
            for (int m = 0; m < 4; ++m) {
                const int row = row0 + ai * 128 + m * 16;
                float mean = 0.f, rstd = 1.f;
                if (rstat) { const f32x2_t st = *(const f32x2_t*)(rstat + (size_t)row * 2); mean = st.x; rstd = st.y; }
                float s = 0.f, ss = 0.f;
#pragma unroll
                for (int bj = 0; bj < 2; ++bj)
#pragma unroll
                    for (int n = 0; n < 2; ++n) {
                        const int col = col0 + bj * 128 + 4 * n;
                        f32x4 xv = *(const f32x4*)(xsrc + (size_t)row * D + col);
                        if (rstat) { const f32x4 g = *(const f32x4*)(lng + col), bb = *(const f32x4*)(lnb + col); xv = (xv - mean) * rstd * g + bb; }
                        const f32x4 a = acc[ai][bj][m][n];
                        const f32x4 v = xv * DN_ALPHA + ga[bj][n] * a;
                        *(f32x4*)(R + (size_t)row * D + col) = v;
                        s += (v[0] + v[1]) + (v[2] + v[3]);
                        ss += (v[0] * v[0] + v[1] * v[1]) + (v[2] * v[2] + v[3] * v[3]);
                    }
                s += __shfl_xor(s, 16); ss += __shfl_xor(ss, 16);
                s += __shfl_xor(s, 32); ss += __shfl_xor(ss, 32);
                if (fq == 0) { f32x2_t o = {s, ss}; *(f32x2_t*)(pstat + ((size_t)row * 16 + u.pn * 4 + wc) * 2) = o; }
            }
    }
};

DI void transpose_item(const float* W, int K, int N, bf16_t* WT, LAS float* scr, int item, int lane) {
    const int nblk = N / 32, kb = item / nblk, nb = item % nblk, k0 = 64 * kb, n0 = 32 * nb;
#pragma unroll 8
    for (int i = 0; i < 32; ++i) { const int kk = 2 * i + (lane >> 5); scr[kk * 33 + (lane & 31)] = W[(size_t)(k0 + kk) * N + n0 + (lane & 31)]; }
    LDS_WAIT();
    const int c = lane & 7;
#pragma unroll
    for (int j = 0; j < 4; ++j) {
        const int n = (lane >> 3) + 8 * j; const LAS float* s = scr + (8 * c) * 33 + n;
        u32x4 o; o.x = pk2(s[0 * 33], s[1 * 33]); o.y = pk2(s[2 * 33], s[3 * 33]); o.z = pk2(s[4 * 33], s[5 * 33]); o.w = pk2(s[6 * 33], s[7 * 33]);
        *(u32x4*)(WT + (size_t)(n0 + n) * K + k0 + 8 * c) = o;
    }
    LDS_WAIT();
}

DI void phase0(const Params& P, LAS unsigned char* lds, int tid, int lane, int wave) {
    tid = launder_v(tid); lane = launder_v(lane); wave = launder_s(wave);
    bf16_t* win_t = (bf16_t*)(P.ws + WS_WIN); bf16_t* wout_t = (bf16_t*)(P.ws + WS_WOUT); float* mod = (float*)(P.ws + WS_MOD);
    {
        LAS float* scr = (LAS float*)(lds + wave * 16384);
        const int gw = blockIdx.x * NWAVES + wave, NGW = gridDim.x * NWAVES;
        constexpr int I_IN = (D / 64) * (NIN / 32), I_OUT = (D / 64) * (D / 32);
        for (int it = gw; it < DEPTH * (I_IN + I_OUT); it += NGW) {
            const int l = it / (I_IN + I_OUT); int r = it % (I_IN + I_OUT);
            if (r < I_IN) transpose_item(P.w_in + (size_t)l * D * NIN, D, NIN, win_t + (size_t)l * NIN * D, scr, r, lane);
            else transpose_item(P.w_out + (size_t)l * D * D, D, D, wout_t + (size_t)l * D * D, scr, r - I_IN, lane);
        }
    }
    __syncthreads();
    LAS float* sc = (LAS float*)lds;
    for (int item = blockIdx.x; item < DEPTH * 96; item += gridDim.x) {
        const int l = item / 96, j0 = (item % 96) * 32;
        for (int e = tid; e < BATCH * D; e += NTHREADS) { const int b = e >> 10, k = e & 1023; sc[k * 32 + b] = silu_f(P.c[e]); }
        __syncthreads();
        const int j = tid & 31, ks = tid >> 5;
        float acc[32];
#pragma unroll
        for (int b = 0; b < 32; ++b) acc[b] = 0.f;
        const float* wp = P.ada_w + ((size_t)l * D + ks * 64) * 3072 + j0 + j;
#pragma unroll 2
        for (int kk = 0; kk < 64; ++kk) {
            const float w = wp[(size_t)kk * 3072];
            const LAS f32x4* s4 = (const LAS f32x4*)(sc + (ks * 64 + kk) * 32);
#pragma unroll
            for (int q = 0; q < 8; ++q) { const f32x4 v = s4[q]; acc[4 * q] += v[0] * w; acc[4 * q + 1] += v[1] * w; acc[4 * q + 2] += v[2] * w; acc[4 * q + 3] += v[3] * w; }
        }
        __syncthreads();
        LAS float* red = (LAS float*)lds;
#pragma unroll
        for (int b = 0; b < 32; ++b) red[(ks * 32 + b) * 32 + j] = acc[b];
        __syncthreads();
#pragma unroll
        for (int o2 = 0; o2 < 2; ++o2) {
            const int o = tid + o2 * NTHREADS, b = o >> 5, jj = o & 31;
            float s = P.ada_b[l * 3072 + j0 + jj];
#pragma unroll
            for (int q = 0; q < 16; ++q) s += red[(q * 32 + b) * 32 + jj];
            mod[((size_t)l * BATCH + b) * 3072 + j0 + jj] = s;
        }
        __syncthreads();
    }
}

template <int MODE>
DI void row_pass(const Params& P, int lane, int wave) {
    lane = launder_v(lane); wave = launder_s(wave);
    const int gw = blockIdx.x * NWAVES + wave, NGW = gridDim.x * NWAVES;
    const float* mod = (const float*)(P.ws + WS_MOD) + (MODE == 1 ? (size_t)BATCH * 3072 : 0);
    const float* pstat = (const float*)(P.ws + WS_PSTAT);
    float* rstat = (float*)(P.ws + WS_RSTAT);
    bf16_t* hb = (bf16_t*)(P.ws + WS_HB);
    const float* src = MODE == 0 ? P.x : (MODE == 1 ? (const float*)(P.ws + WS_R0) : (const float*)P.out);
    const float* lg = P.ln_g + (MODE == 2 ? D : 0); const float* lb = P.ln_b + (MODE == 2 ? D : 0);
    constexpr int RU = 4;
    for (int row0 = gw * RU; row0 < MTOK; row0 += NGW * RU) {
        f32x4 v[RU][4];
#pragma unroll
        for (int u = 0; u < RU; ++u)
#pragma unroll
            for (int j = 0; j < 4; ++j) v[u][j] = *(const f32x4*)(src + (size_t)(row0 + u) * D + 4 * lane + 256 * j);
        float mean[RU], rstd[RU];
#pragma unroll
        for (int u = 0; u < RU; ++u) { mean[u] = 0.f; rstd[u] = 1.f; }
        if (MODE != 0) {
            const f32x2_t st = *(const f32x2_t*)(pstat + ((size_t)(row0 + (lane >> 4)) * 16 + (lane & 15)) * 2);
            float s = st.x, ss = st.y;
#pragma unroll
            for (int o = 1; o < 16; o <<= 1) { s += __shfl_xor(s, o); ss += __shfl_xor(ss, o); }
            const float m = s * (1.f / D); const float var = fmaxf(ss * (1.f / D) - m * m, 0.f); const float rs = 1.f / sqrtf(var + LN_EPS);
            if (MODE == 1 && (lane & 15) == 0) { f32x2_t o = {m, rs}; *(f32x2_t*)(rstat + (size_t)(row0 + (lane >> 4)) * 2) = o; }
#pragma unroll
            for (int u = 0; u < RU; ++u) { mean[u] = __shfl(m, 16 * u); rstd[u] = __shfl(rs, 16 * u); }
        }
        const int b = row0 >> 11;
#pragma unroll
        for (int j = 0; j < 4; ++j) {
            const int col = 4 * lane + 256 * j;
            f32x4 g = {1.f, 1.f, 1.f, 1.f}, bb = {0.f, 0.f, 0.f, 0.f}, sh = bb, scl = bb;
            if (MODE != 0) { g = *(const f32x4*)(lg + col); bb = *(const f32x4*)(lb + col); }
            if (MODE != 2) { sh = *(const f32x4*)(mod + (size_t)b * 3072 + col); scl = *(const f32x4*)(mod + (size_t)b * 3072 + 1024 + col); }
#pragma unroll
            for (int u = 0; u < RU; ++u) {
                f32x4 w = v[u][j];
                if (MODE != 0) w = (w - mean[u]) * rstd[u] * g + bb;
                if (MODE == 2) { *(f32x4*)(P.out + (size_t)(row0 + u) * D + col) = w; }
                else {
                    w = w * (scl + 1.f) + sh;
                    u32x2 o; o.x = pk2(w[0], w[1]); o.y = pk2(w[2], w[3]);
                    *(u32x2*)(hb + (size_t)(row0 + u) * D + col) = o;
                }
            }
        }
    }
}

constexpr int VT_PITCH = 272;
DI void sgu_unit(const Params& P, int l, int unit, LAS unsigned char* lds, int lane, int wave) {
    const bf16_t* p = (const bf16_t*)(P.ws + WS_P); bf16_t* Y = (bf16_t*)(P.ws + WS_Y);
    const int tok0 = unit * 128;
    {
        const float g0 = P.sgu_ln_g[l * 256 + lane], g1 = P.sgu_ln_g[l * 256 + 64 + lane], g2 = P.sgu_ln_g[l * 256 + 128 + lane], g3 = P.sgu_ln_g[l * 256 + 192 + lane];
        const float b0 = P.sgu_ln_b[l * 256 + lane], b1 = P.sgu_ln_b[l * 256 + 64 + lane], b2 = P.sgu_ln_b[l * 256 + 128 + lane], b3 = P.sgu_ln_b[l * 256 + 192 + lane];
#pragma unroll 4
        for (int i = 0; i < 16; ++i) {
            const int s = wave * 16 + i;
            const bf16_t* vp = p + (size_t)(tok0 + s) * NIN + C_VS + lane;
            const float v0 = bf2f(vp[0]), v1 = bf2f(vp[64]), v2 = bf2f(vp[128]), v3 = bf2f(vp[192]);
            const float mean = wave_sum((v0 + v1) + (v2 + v3)) * (1.f / 256.f);
            const float d0 = v0 - mean, d1 = v1 - mean, d2 = v2 - mean, d3 = v3 - mean;
            const float var = wave_sum((d0 * d0 + d1 * d1) + (d2 * d2 + d3 * d3)) * (1.f / 256.f);
            const float rstd = 1.f / sqrtf(var + LN_EPS);
            LAS bf16_t* vt = (LAS bf16_t*)(lds + lane * VT_PITCH + s * 2);
            vt[0] = (bf16_t)(pk2(d0 * rstd * g0 + b0, 0.f) & 0xffffu);
            vt[64 * VT_PITCH / 2] = (bf16_t)(pk2(d1 * rstd * g1 + b1, 0.f) & 0xffffu);
            vt[128 * VT_PITCH / 2] = (bf16_t)(pk2(d2 * rstd * g2 + b2, 0.f) & 0xffffu);
            vt[192 * VT_PITCH / 2] = (bf16_t)(pk2(d3 * rstd * g3 + b3, 0.f) & 0xffffu);
        }
    }
    __syncthreads();
    {
        const int h = wave & 3, dblk = wave >> 2, r = lane & 31, hh = lane >> 5;
        const int ch = h * 64 + 32 * dblk + r;
        f32x16 acc[4];
#pragma unroll
        for (int tb = 0; tb < 4; ++tb)
#pragma unroll
            for (int i = 0; i < 16; ++i) acc[tb][i] = 0.f;
        const float* wbase = P.sgu_w + ((size_t)(l * 4 + h) * 128) * 128;
#pragma unroll 1
        for (int ks = 0; ks < 8; ++ks) {
            const bf16x8 bfrag = *(const LAS bf16x8*)(lds + ch * VT_PITCH + (16 * ks + 8 * hh) * 2);
#pragma unroll
            for (int tb = 0; tb < 4; ++tb) {
                if (ks >= 4 && tb < 2) continue;
                const float* wp = wbase + (size_t)(32 * tb + r) * 128 + 16 * ks + 8 * hh;
                const f32x4 w0 = *(const f32x4*)wp, w1 = *(const f32x4*)(wp + 4);
                u32x4 a; a.x = pk2(w0[0], w0[1]); a.y = pk2(w0[2], w0[3]); a.z = pk2(w1[0], w1[1]); a.w = pk2(w1[2], w1[3]);
                acc[tb] = MFMA32(__builtin_bit_cast(bf16x8, a), bfrag, acc[tb]);
            }
        }
#pragma unroll
        for (int tb = 0; tb < 4; ++tb)
#pragma unroll
            for (int i = 0; i < 16; ++i) {
                const int t = 32 * tb + crow(i, hh);
                const size_t tok = (size_t)(tok0 + t);
                const float mixed = acc[tb][i] + P.sgu_b[(l * 4 + h) * 128 + t];
                const float u = bf2f(p[tok * NIN + C_U + ch]), gb = bf2f(p[tok * NIN + C_GB + ch]);
                Y[tok * D + 256 + ch] = (bf16_t)(pk2(u * mixed * silu_f(gb), 0.f) & 0xffffu);
            }
    }
    __syncthreads();
}

typedef short v4i16_t __attribute__((ext_vector_type(4)));
DI v4i16_t lds_tr16(const LAS unsigned char* p) { return __builtin_amdgcn_ds_read_tr16_b64_v4i16((LAS v4i16_t*)p); }
constexpr int OST_PITCH = 68;
DI void tile_epilogue(const f32x16& o0, const f32x16& o1, LAS float* ost, int lane, const bf16_t* grow  , bf16_t* yrow, const float* colscale) {
    const int r = lane & 31, hh = lane >> 5;
#pragma unroll
    for (int i = 0; i < 16; ++i) { ost[crow(i, hh) * OST_PITCH + r] = o0[i]; ost[crow(i, hh) * OST_PITCH + 32 + r] = o1[i]; }
#pragma unroll
    for (int it = 0; it < 4; ++it) {
        const int c = lane + 64 * it, q = c >> 3, dc = c & 7;
        const u32x4 g = *(const u32x4*)(grow + (size_t)q * NIN + dc * 8);
        const f32x4 a = *(const LAS f32x4*)(ost + q * OST_PITCH + dc * 8), b = *(const LAS f32x4*)(ost + q * OST_PITCH + dc * 8 + 4);
        f32x4 s0 = {1.f, 1.f, 1.f, 1.f}, s1 = s0;
        if (colscale) { s0 = *(const f32x4*)(colscale + dc * 8); s1 = *(const f32x4*)(colscale + dc * 8 + 4); }
        u32x4 w;
        w.x = pk2(a[0] * s0[0] * silu_f(bflo(g.x)), a[1] * s0[1] * silu_f(bfhi(g.x)));
        w.y = pk2(a[2] * s0[2] * silu_f(bflo(g.y)), a[3] * s0[3] * silu_f(bfhi(g.y)));
        w.z = pk2(b[0] * s1[0] * silu_f(bflo(g.z)), b[1] * s1[1] * silu_f(bfhi(g.z)));
        w.w = pk2(b[2] * s1[2] * silu_f(bflo(g.w)), b[3] * s1[3] * silu_f(bfhi(g.w)));
        *(u32x4*)(yrow + (size_t)q * D + dc * 8) = w;
    }
}

constexpr int PA_PITCH = 144;
DI void pool_wave(const Params& P, int l, int gw, int NGW, int lane, LAS unsigned char* wl) {
    const bf16_t* p = (const bf16_t*)(P.ws + WS_P); bf16_t* Y = (bf16_t*)(P.ws + WS_Y);
    const int g = gw & 3, r = lane & 31, hh = lane >> 5;
    const int win = 2 << g;
    LAS float* ost = (LAS float*)(wl + 7168);
    bf16x8 bw[4][2];
#pragma unroll
    for (int s = 0; s < 4; ++s)
#pragma unroll
        for (int db = 0; db < 2; ++db) {
            const float* wp = P.pool_w + ((size_t)(l * 4 + g) * 64 + 16 * s + 8 * hh) * 64 + 32 * db + r;
            u32x4 a; a.x = pk2(wp[0], wp[64]); a.y = pk2(wp[128], wp[192]); a.z = pk2(wp[256], wp[320]); a.w = pk2(wp[384], wp[448]);
            bw[s][db] = __builtin_bit_cast(bf16x8, a);
        }
    for (int tile = gw >> 2; tile < MTOK / 32; tile += NGW >> 2) {
        const int tok0 = tile * 32, pos0 = tok0 & (SEQ - 1), pos = pos0 + r;
#pragma unroll
        for (int it = 0; it < 6; ++it) {
            const int c = lane + 64 * it, row = c >> 3, dc = c & 7;
            u32x4 v = {0u, 0u, 0u, 0u};
            if (row >= 16 || pos0 != 0) v = *(const u32x4*)(p + (size_t)(tok0 - 16 + row) * NIN + C_A + g * 64 + dc * 8);
            *(LAS u32x4*)(wl + row * PA_PITCH + dc * 16) = v;
        }
        const int cnt = (pos + 1 < win) ? pos + 1 : win;
        const float inv = 1.f / (float)cnt;
        f32x16 acc0, acc1;
#pragma unroll
        for (int i = 0; i < 16; ++i) { acc0[i] = 0.f; acc1[i] = 0.f; }
#pragma unroll
        for (int s = 0; s < 4; ++s) {
            const LAS unsigned char* base = wl + (16 + r) * PA_PITCH + (16 * s + 8 * hh) * 2;
            const u32x4 own = *(const LAS u32x4*)base;
            float sum[8];
            sum[0] = bflo(own.x); sum[1] = bfhi(own.x); sum[2] = bflo(own.y); sum[3] = bfhi(own.y); sum[4] = bflo(own.z); sum[5] = bfhi(own.z); sum[6] = bflo(own.w); sum[7] = bfhi(own.w);
            for (int j = 1; j < win; ++j) {
                const u32x4 v = *(const LAS u32x4*)(base - j * PA_PITCH);
                sum[0] += bflo(v.x); sum[1] += bfhi(v.x); sum[2] += bflo(v.y); sum[3] += bfhi(v.y); sum[4] += bflo(v.z); sum[5] += bfhi(v.z); sum[6] += bflo(v.w); sum[7] += bfhi(v.w);
            }
            u32x4 a;
            a.x = pk2(sum[0] * inv - bflo(own.x), sum[1] * inv - bfhi(own.x)); a.y = pk2(sum[2] * inv - bflo(own.y), sum[3] * inv - bfhi(own.y));
            a.z = pk2(sum[4] * inv - bflo(own.z), sum[5] * inv - bfhi(own.z)); a.w = pk2(sum[6] * inv - bflo(own.w), sum[7] * inv - bfhi(own.w));
            const bf16x8 af = __builtin_bit_cast(bf16x8, a);
            acc0 = MFMA32(af, bw[s][0], acc0);
            acc1 = MFMA32(af, bw[s][1], acc1);
        }
        tile_epilogue(acc0, acc1, ost, lane, p + (size_t)tok0 * NIN + C_GA + g * 64, Y + (size_t)tok0 * D + g * 64, P.pool_scale + l * 256 + g * 64);
    }
}

constexpr int KT_PITCH = 144;
constexpr int VT_OFF = 32 * KT_PITCH;
DI void attn_unit(const Params& P, int unit, int lane, LAS unsigned char* wl) {
    const bf16_t* p = (const bf16_t*)(P.ws + WS_P); bf16_t* Y = (bf16_t*)(P.ws + WS_Y);
    const int qt = unit & 63, h = (unit >> 6) & 7, b = unit >> 9;
    const int r = lane & 31, hh = lane >> 5;
    const size_t tokb = (size_t)b * SEQ;
    LAS float* ost = (LAS float*)wl;
    const size_t rowoff = (tokb + (lane >> 3)) * NIN + h * 64 + (lane & 7) * 8;
    const bf16_t* qp0 = p + rowoff + C_Q; const bf16_t* kp0 = p + rowoff + C_K; const bf16_t* vp0 = p + rowoff + C_V; const bf16_t* gp0 = p + rowoff + C_GC;
    const int klds = (lane >> 3) * KT_PITCH + (lane & 7) * 16;
    const int vlds = VT_OFF + ((lane & 7) >> 2) * 2048 + (lane >> 3) * 64 + (lane & 3) * 16;
    const int frd = r * KT_PITCH + hh * 16;
    const int trbase = VT_OFF + (4 * hh + ((lane & 15) >> 2)) * 64 + ((lane >> 4) & 1) * 32 + (lane & 3) * 8;
    bf16x8 qf[4]; u32x4 gt[4], kn[4], vn[4];
    {
        const size_t o = (size_t)qt * 32 * NIN;
        u32x4 qv[4];
#pragma unroll
        for (int it = 0; it < 4; ++it) qv[it] = *(const u32x4*)(qp0 + o + (size_t)it * 8 * NIN);
#pragma unroll
        for (int it = 0; it < 4; ++it) kn[it] = *(const u32x4*)(kp0 + o + (size_t)it * 8 * NIN);
#pragma unroll
        for (int it = 0; it < 4; ++it) vn[it] = *(const u32x4*)(vp0 + o + (size_t)it * 8 * NIN);
#pragma unroll
        for (int it = 0; it < 4; ++it) gt[it] = *(const u32x4*)(gp0 + o + (size_t)it * 8 * NIN);
#pragma unroll
        for (int it = 0; it < 4; ++it) *(LAS u32x4*)(wl + klds + it * 8 * KT_PITCH) = qv[it];
#pragma unroll
        for (int s = 0; s < 4; ++s) qf[s] = *(const LAS bf16x8*)(wl + frd + s * 32);
    }
    f32x16 o0, o1;
#pragma unroll
    for (int i = 0; i < 16; ++i) { o0[i] = 0.f; o1[i] = 0.f; }
    float carry = 0.f;
    const float CZ = 0.125f * LOG2E;
    for (int kb = qt; kb >= 0; --kb) {
#pragma unroll
        for (int it = 0; it < 4; ++it) *(LAS u32x4*)(wl + klds + it * 8 * KT_PITCH) = kn[it];
#pragma unroll
        for (int it = 0; it < 4; ++it) *(LAS u32x4*)(wl + vlds + it * 512) = vn[it];
        if (kb > 0) {
            const size_t o = (size_t)(kb - 1) * 32 * NIN;
#pragma unroll
            for (int it = 0; it < 4; ++it) kn[it] = *(const u32x4*)(kp0 + o + (size_t)it * 8 * NIN);
#pragma unroll
            for (int it = 0; it < 4; ++it) vn[it] = *(const u32x4*)(vp0 + o + (size_t)it * 8 * NIN);
        }
        f32x16 z;
#pragma unroll
        for (int i = 0; i < 16; ++i) z[i] = 0.f;
#pragma unroll
        for (int s = 0; s < 4; ++s) { const bf16x8 kf = *(const LAS bf16x8*)(wl + frd + s * 32); z = MFMA32(kf, qf[s], z); }
        float l1m[16], lbv[16];
#pragma unroll
        for (int i = 0; i < 16; ++i) {
            const float t = z[i] * CZ;
            const float e = __builtin_amdgcn_exp2f(-fabsf(t));
            const float sp = fmaxf(t, 0.f) + __builtin_amdgcn_logf(1.f + e);
            l1m[i] = -sp; lbv[i] = t - sp;
        }
        if (kb == qt) {
#pragma unroll
            for (int i = 0; i < 16; ++i) if (crow(i, hh) >= r) { l1m[i] = 0.f; lbv[i] = -__builtin_inff(); }
        }
        float gs[4], og[4];
#pragma unroll
        for (int q = 0; q < 4; ++q) { gs[q] = (l1m[4 * q] + l1m[4 * q + 1]) + (l1m[4 * q + 2] + l1m[4 * q + 3]); og[q] = swap32(gs[q], hh); }
        float suf = carry;
        float a[16];
#pragma unroll
        for (int q = 3; q >= 0; --q) {
            float lat = suf + (hh == 0 ? og[q] : 0.f);
            a[4 * q + 3] = __builtin_amdgcn_exp2f(lbv[4 * q + 3] + lat); lat += l1m[4 * q + 3];
            a[4 * q + 2] = __builtin_amdgcn_exp2f(lbv[4 * q + 2] + lat); lat += l1m[4 * q + 2];
            a[4 * q + 1] = __builtin_amdgcn_exp2f(lbv[4 * q + 1] + lat); lat += l1m[4 * q + 1];
            a[4 * q] = __builtin_amdgcn_exp2f(lbv[4 * q] + lat);
            suf += gs[q] + og[q];
        }
        carry = suf;
        u32x4 pa0, pa1;
        pa0.x = pk2(a[0], a[1]); pa0.y = pk2(a[2], a[3]); pa0.z = pk2(a[4], a[5]); pa0.w = pk2(a[6], a[7]);
        pa1.x = pk2(a[8], a[9]); pa1.y = pk2(a[10], a[11]); pa1.z = pk2(a[12], a[13]); pa1.w = pk2(a[14], a[15]);
        bf16x8 vf[2][2];
#pragma unroll
        for (int s = 0; s < 2; ++s)
#pragma unroll
            for (int db = 0; db < 2; ++db) {
                const v4i16_t lo = lds_tr16(wl + trbase + db * 2048 + (16 * s) * 64), hi = lds_tr16(wl + trbase + db * 2048 + (16 * s + 8) * 64);
                vf[s][db] = __builtin_shufflevector(lo, hi, 0, 1, 2, 3, 4, 5, 6, 7);
            }
        o0 = MFMA32(__builtin_bit_cast(bf16x8, pa0), vf[0][0], o0);
        o0 = MFMA32(__builtin_bit_cast(bf16x8, pa1), vf[1][0], o0);
        o1 = MFMA32(__builtin_bit_cast(bf16x8, pa0), vf[0][1], o1);
        o1 = MFMA32(__builtin_bit_cast(bf16x8, pa1), vf[1][1], o1);
        if (__ballot(carry > -160.f) == 0ull) break;
    }
#pragma unroll
    for (int i = 0; i < 16; ++i) { ost[crow(i, hh) * OST_PITCH + r] = o0[i]; ost[crow(i, hh) * OST_PITCH + 32 + r] = o1[i]; }
    bf16_t* yp0 = Y + (tokb + qt * 32 + (lane >> 3)) * D + 512 + h * 64 + (lane & 7) * 8;
#pragma unroll
    for (int it = 0; it < 4; ++it) {
        const LAS float* op = ost + ((lane >> 3) + 8 * it) * OST_PITCH + (lane & 7) * 8;
        const f32x4 a = *(const LAS f32x4*)op, bq = *(const LAS f32x4*)(op + 4);
        const u32x4 g = gt[it];
        u32x4 w;
        w.x = pk2(a[0] * silu_f(bflo(g.x)), a[1] * silu_f(bfhi(g.x)));
        w.y = pk2(a[2] * silu_f(bflo(g.y)), a[3] * silu_f(bfhi(g.y)));
        w.z = pk2(bq[0] * silu_f(bflo(g.z)), bq[1] * silu_f(bfhi(g.z)));
        w.w = pk2(bq[2] * silu_f(bflo(g.w)), bq[3] * silu_f(bfhi(g.w)));
        *(u32x4*)(yp0 + (size_t)it * 8 * D) = w;
    }
}

DI void mixers(const Params& P, int l, LAS unsigned char* lds, int lane, int wave) {
    lane = launder_v(lane); wave = launder_s(wave);
    const int gw = blockIdx.x * NWAVES + wave, NGW = gridDim.x * NWAVES;
#ifndef MXMASK
#define MXMASK 7
#endif
    for (int rep = 0; rep < ((DUP & 4) ? 2 : 1); ++rep)
    if (MXMASK & 1) for (int unit = blockIdx.x; unit < BATCH * 16; unit += gridDim.x) sgu_unit(P, l, unit, lds, lane, wave);
    for (int rep = 0; rep < ((DUP & 8) ? 2 : 1); ++rep)
    if (MXMASK & 2) pool_wave(P, l, gw, NGW, lane, lds + wave * 16384);
    for (int rep = 0; rep < ((DUP & 16) ? 2 : 1); ++rep)
    if (MXMASK & 4) for (int unit = gw; unit < BATCH * 8 * 64; unit += NGW) attn_unit(P, unit, lane, lds + wave * 16384);
}

__global__ void __launch_bounds__(NTHREADS, 2) fwd_mega(Params P) {
    extern __shared__ __attribute__((aligned(16))) unsigned char lds_raw[];
    LAS unsigned char* lds = (LAS unsigned char*)lds_raw;
    cg::grid_group grid = cg::this_grid();
    const int tid = threadIdx.x, lane = tid & 63, wave = __builtin_amdgcn_readfirstlane(tid >> 6);
    const int lo = P.ph_lo, hi = P.ph_hi;
#ifndef PHMASK
#define PHMASK 0x3ff
#endif
#define IN(k) (((PHMASK >> (k)) & 1) && lo <= (k) && (k) < hi)
#define SEAM(k) do { if (IN(k) && IN((k) + 1)) grid.sync(); } while (0)
    bf16_t* hb = (bf16_t*)(P.ws + WS_HB); bf16_t* pbuf = (bf16_t*)(P.ws + WS_P); bf16_t* ybuf = (bf16_t*)(P.ws + WS_Y);
    const bf16_t* win_t = (const bf16_t*)(P.ws + WS_WIN); const bf16_t* wout_t = (const bf16_t*)(P.ws + WS_WOUT);
    const float* mod = (const float*)(P.ws + WS_MOD);

    if (IN(0)) for (int rep = 0; rep < ((DUP & 64) ? 2 : 1); ++rep) phase0(P, lds, tid, lane, wave);
    SEAM(0);
    if (IN(1)) for (int rep = 0; rep < ((DUP & 32) ? 2 : 1); ++rep) row_pass<0>(P, lane, wave);
    SEAM(1);
#pragma unroll 1
    for (int l = 0; l < DEPTH; ++l) {
        const int pb = 2 + 4 * l;
        if (IN(pb)) for (int rep = 0; rep < ((DUP & 1) ? 2 : 1); ++rep) {
            pg8::Gemm g{hb, win_t + (size_t)l * NIN * D, MTOK, NIN, D}; pg8::StaticOrder S; S.init(MTOK, NIN, (int)gridDim.x, (int)blockIdx.x);
            EpiP E{pbuf};
            pg8::gemm_phase<EpiP, pg8::StaticOrder, true, true>(lds, g, S, E);
        }
        SEAM(pb);
        if (IN(pb + 1)) mixers(P, l, lds, lane, wave);
        SEAM(pb + 1);
        if (IN(pb + 2)) for (int rep = 0; rep < ((DUP & 2) ? 2 : 1); ++rep) {
            pg8::Gemm g{ybuf, wout_t + (size_t)l * D * D, MTOK, D, D}; pg8::StaticOrder S; S.init(MTOK, D, (int)gridDim.x, (int)blockIdx.x);
            EpiRes E{l == 0 ? P.x : (const float*)(P.ws + WS_R0), l == 0 ? nullptr : (const float*)(P.ws + WS_RSTAT), P.ln_g, P.ln_b,
                     mod + (size_t)l * BATCH * 3072 + 2048, l == 0 ? (float*)(P.ws + WS_R0) : P.out, (float*)(P.ws + WS_PSTAT)};
            pg8::gemm_phase<EpiRes, pg8::StaticOrder, true, true>(lds, g, S, E);
        }
        SEAM(pb + 2);
        if (IN(pb + 3)) { if (l == 0) { for (int rep = 0; rep < ((DUP & 32) ? 2 : 1); ++rep) row_pass<1>(P, lane, wave); } else row_pass<2>(P, lane, wave); }
        SEAM(pb + 3);
    }
#undef IN
#undef SEAM
}

#ifndef N_LAUNCH_PER_PHASE
#define N_LAUNCH_PER_PHASE 0
#endif
extern "C" void kernel_launch(void* const* d_in, const int* in_sizes, int n_in, void* d_out, int out_size, void* d_ws, size_t ws_size, hipStream_t stream) {
    static int grid = 0;
    if (grid == 0) {
        if (n_in != 14 || out_size != MTOK * D || ws_size < WS_END) { fprintf(stderr, "kernel_launch: unexpected shapes (n_in %d out %d ws %zu need %zu)\n", n_in, out_size, ws_size, (size_t)WS_END); grid = -1; return; }
        int dev = 0, cus = 0, per_cu = 0;
        hipGetDevice(&dev);
        hipDeviceGetAttribute(&cus, hipDeviceAttributeMultiprocessorCount, dev);
        if (hipFuncSetAttribute((const void*)fwd_mega, hipFuncAttributeMaxDynamicSharedMemorySize, LDS_BYTES) != hipSuccess) { fprintf(stderr, "kernel_launch: hipFuncSetAttribute failed\n"); grid = -1; return; }
        if (hipOccupancyMaxActiveBlocksPerMultiprocessor(&per_cu, (const void*)fwd_mega, NTHREADS, LDS_BYTES) != hipSuccess || per_cu < 1) { fprintf(stderr, "kernel_launch: occupancy query says %d\n", per_cu); per_cu = 1; }
        (void)hipGetLastError();
        grid = cus * 1;
        if (grid != 256) fprintf(stderr, "kernel_launch: note: grid %d\n", grid);
    }
    if (grid < 0) return;
    Params p{};
    p.x = (const float*)d_in[0]; p.c = (const float*)d_in[1]; p.w_in = (const float*)d_in[2]; p.pool_w = (const float*)d_in[3]; p.pool_scale = (const float*)d_in[4];
    p.sgu_ln_g = (const float*)d_in[5]; p.sgu_ln_b = (const float*)d_in[6]; p.sgu_w = (const float*)d_in[7]; p.sgu_b = (const float*)d_in[8]; p.w_out = (const float*)d_in[9];
    p.ada_w = (const float*)d_in[10]; p.ada_b = (const float*)d_in[11]; p.ln_g = (const float*)d_in[12]; p.ln_b = (const float*)d_in[13];
    p.out = (float*)d_out; p.ws = (unsigned char*)d_ws;
#if N_LAUNCH_PER_PHASE
    for (int ph = 0; ph < 10; ++ph) {
        p.ph_lo = ph; p.ph_hi = ph + 1;
        hipLaunchKernelGGL(fwd_mega, dim3(grid), dim3(NTHREADS), LDS_BYTES, stream, p);
    }
#else
    p.ph_lo = 0; p.ph_hi = 10;
    void* args[] = {&p};
    hipError_t e = hipLaunchCooperativeKernel((const void*)fwd_mega, dim3(grid), dim3(NTHREADS), args, LDS_BYTES, stream);
    if (e != hipSuccess) fprintf(stderr, "kernel_launch: cooperative launch failed: %s (grid %d)\n", hipGetErrorString(e), grid);
#endif
}
```

```cpp
#include <hip/hip_runtime.h>
#include <hip/hip_cooperative_groups.h>
#include <cstdio>
#include <cstdint>
namespace cg = cooperative_groups;
__device__ __forceinline__ int launder_v(int x) { asm volatile("" : "+v"(x)); return x; }
__device__ __forceinline__ int launder_s(int x) { asm volatile("" : "+s"(x)); return x; }
namespace pg8 {
#define PG8_LAS __attribute__((address_space(3)))
typedef unsigned short bf16_t;
typedef short bf16x8 __attribute__((ext_vector_type(8)));
typedef float f32x4 __attribute__((ext_vector_type(4)));
typedef unsigned u32x4 __attribute__((ext_vector_type(4)));
constexpr int BM = 256, BK = 64, HALF = 128, HTB = HALF * BK * 2  , STAGE_BYTES = 8 * HTB, NXCD = 8, WGM = 8;

__host__ __device__ __forceinline__ int lds_byte(int r, int c) { const int st = (r >> 4) * 2 + (c >> 5), rr = r & 15, cc = c & 31, ob = rr * 64 + cc * 2; return st * 1024 + (ob ^ (((ob >> 9) & 1) << 5)); }
__host__ __device__ __forceinline__ void stage_rc(int b, int& R, int& C) { const int st = b / 1024, sb = b % 1024, swz = sb ^ (((sb >> 9) & 1) << 5); R = (st >> 1) * 16 + swz / 64; C = (st & 1) * 32 + (swz % 64) / 2; }
__host__ __device__ __forceinline__ int perm32(int rho) { const int n = rho >> 4, i = rho & 15; return 8 * (i >> 2) + 4 * n + (i & 3); }

struct Unit { int pm, pn; };
struct Gemm { const bf16_t* A; const bf16_t* Bt; int M, N, K; };

struct StaticOrder {
    int nM, nN, nwg, G, c;
    __host__ __device__ void init(int M, int N, int G_, int c_) { nM = M / BM; nN = N / BM; nwg = nM * nN; G = G_; c = c_; }
    __host__ __device__ bool next(int i, Unit& u) const {
        const long L = (long)i * G + c; if (L >= nwg) return false;
        int wgid = (int)L; { const int q = nwg / NXCD, r = nwg % NXCD, xcd = wgid % NXCD, off = wgid / NXCD; wgid = (xcd < r ? xcd * (q + 1) : r * (q + 1) + (xcd - r) * q) + off; }
        const int nig = WGM * nN, gid = wgid / nig, fm = gid * WGM, gsz = (nM - fm) < WGM ? (nM - fm) : WGM;
        u.pm = fm + ((wgid % nig) % gsz); u.pn = (wgid % nig) / gsz; return true;
    }
    __device__ __forceinline__ void a_ready(const Unit&) const {}
    __device__ __forceinline__ void done(const Unit&) const {}
};

__device__ __forceinline__ unsigned cvt_pk_bf16(float lo, float hi) { unsigned r; asm volatile("v_cvt_pk_bf16_f32 %0, %1, %2" : "=v"(r) : "v"(lo), "v"(hi)); return r; }
template <class Epi, class Sched, bool ALIGN_EPI = false, bool SP2 = false>
__device__ __forceinline__ void gemm_phase(PG8_LAS unsigned char* lds, const Gemm g, const Sched& S, const Epi& E) {
    const int tid = launder_v(threadIdx.x), wid = __builtin_amdgcn_readfirstlane(tid >> 6), lane = tid & 63, wr = wid >> 2, wc = wid & 3, fr = lane & 15, fq = lane >> 4;
    const int K = g.K, nt = K / BK;
    unsigned voffA[2], voffB[2];
#pragma unroll
    for (int i = 0; i < 2; ++i) { int R, C; stage_rc(tid * 16 + i * 8192, R, C); const int Rb = Epi::PERM ? ((R & ~31) + perm32(R & 31)) : R;
        voffA[i] = (unsigned)(R * K + C) * 2u; voffB[i] = (unsigned)(Rb * K + C) * 2u; }
    const size_t kstep = (size_t)(BK * 2);
    const size_t hstep = (size_t)HALF * K * 2;
    const size_t tstep = 2 * hstep;
    const unsigned ldsw = (unsigned)wid * 1024u;
    const int aoff = lds_byte(wr * 64 + fr, fq * 8), boff = lds_byte(wc * 32 + fr, fq * 8);
#define PG8_SA(b, h) (((b) * 2 + (h)) * HTB)
#define PG8_SB(b, h) ((4 + (b) * 2 + (h)) * HTB)
#define PG8_STAGE(bufoff, gbase, voff) do { _Pragma("unroll") for (int _i = 0; _i < 2; ++_i) \
        __builtin_amdgcn_global_load_lds((const unsigned*)((const char*)(gbase) + (voff)[_i]), (PG8_LAS unsigned*)(lds + (bufoff) + ldsw + _i * 8192), 16, 0, 0); } while (0)
#define PG8_LDA(dst, b, h) do { _Pragma("unroll") for (int m = 0; m < 4; ++m) _Pragma("unroll") for (int k = 0; k < 2; ++k) dst[m][k] = *(const PG8_LAS bf16x8*)(lds + PG8_SA(b, h) + aoff + m * 2048 + k * 1024); } while (0)
#define PG8_LDB(dst, b, h) do { _Pragma("unroll") for (int n = 0; n < 2; ++n) _Pragma("unroll") for (int k = 0; k < 2; ++k) dst[n][k] = *(const PG8_LAS bf16x8*)(lds + PG8_SB(b, h) + boff + n * 2048 + k * 1024); } while (0)
#define PG8_MMA(ai, bj, At, Bt) do { __builtin_amdgcn_s_setprio(1); _Pragma("unroll") for (int m = 0; m < 4; ++m) _Pragma("unroll") for (int n = 0; n < 2; ++n) _Pragma("unroll") for (int k = 0; k < 2; ++k) \
        acc[ai][bj][m][n] = __builtin_amdgcn_mfma_f32_16x16x32_bf16(Bt[n][k], At[m][k], acc[ai][bj][m][n], 0, 0, 0); __builtin_amdgcn_s_setprio(0); } while (0)
#define PG8_WAIT_V(n) asm volatile("s_waitcnt vmcnt(" #n ")" ::: "memory")
#define PG8_WAIT_L(n) asm volatile("s_waitcnt lgkmcnt(" #n ")" ::: "memory")
#define PG8_BAR __builtin_amdgcn_s_barrier()
#define PG8_SCHED __builtin_amdgcn_sched_barrier(0)
    Unit cur, nxt; int ui = 0;
    if (!S.next(0, cur)) return;
    f32x4 acc[2][2][4][2];
#pragma unroll
    for (int a = 0; a < 2; ++a)
#pragma unroll
        for (int b = 0; b < 2; ++b)
#pragma unroll
            for (int m = 0; m < 4; ++m)
#pragma unroll
                for (int n = 0; n < 2; ++n) acc[a][b][m][n] = (f32x4){0.f, 0.f, 0.f, 0.f};
    bf16x8 At[4][2], B0[2][2], B1[2][2];
    const char* cA = (const char*)g.A + (size_t)cur.pm * tstep; const char* cB = (const char*)g.Bt + (size_t)cur.pn * tstep;
    S.a_ready(cur);
    if constexpr (SP2) {
        PG8_STAGE(PG8_SB(0, 0), cB, voffB); PG8_STAGE(PG8_SB(0, 1), cB + hstep, voffB); PG8_STAGE(PG8_SA(0, 0), cA, voffA); PG8_STAGE(PG8_SA(0, 1), cA + hstep, voffA);
        if (wr == 1) PG8_BAR;
        PG8_WAIT_V(2); PG8_BAR;
        PG8_STAGE(PG8_SB(1, 0), cB + kstep, voffB); PG8_STAGE(PG8_SA(1, 0), cA + kstep, voffA); PG8_STAGE(PG8_SB(1, 1), cB + hstep + kstep, voffB);
        PG8_WAIT_V(6); PG8_BAR;
    } else {
        PG8_STAGE(PG8_SB(0, 0), cB, voffB); PG8_STAGE(PG8_SA(0, 0), cA, voffA); PG8_STAGE(PG8_SB(0, 1), cB + hstep, voffB); PG8_STAGE(PG8_SA(0, 1), cA + hstep, voffA);
        if (wr == 1) PG8_BAR;
        PG8_WAIT_V(4); PG8_BAR;
        PG8_STAGE(PG8_SB(1, 0), cB + kstep, voffB); PG8_STAGE(PG8_SA(1, 0), cA + kstep, voffA); PG8_STAGE(PG8_SB(1, 1), cB + hstep + kstep, voffB);
        PG8_WAIT_V(6); PG8_BAR;
    }
    for (;;) {
        const bool has_next = S.next(ui + 1, nxt);
        const char* nA = has_next ? (const char*)g.A + (size_t)nxt.pm * tstep : cA; const char* nB = has_next ? (const char*)g.Bt + (size_t)nxt.pn * tstep : cB;
        for (int t = 0; t < nt; t += 2) {
            const bool last = (t == nt - 2);
            const char* a1 = cA + (size_t)(t + 1) * kstep;
            const char* a2 = last ? nA : cA + (size_t)(t + 2) * kstep; const char* b2 = last ? nB : cB + (size_t)(t + 2) * kstep;
            const char* a3 = a2 + kstep; const char* b3 = b2 + kstep;
            if (last && has_next) S.a_ready(nxt);
            if constexpr (SP2) {
            PG8_LDB(B0, 0, 0); PG8_LDB(B1, 0, 1); PG8_SCHED; PG8_LDA(At, 0, 0); PG8_STAGE(PG8_SA(1, 1), a1 + hstep, voffA);
            PG8_WAIT_V(8); PG8_WAIT_L(0); PG8_BAR; PG8_MMA(0, 0, At, B0); PG8_MMA(0, 1, At, B1); PG8_BAR; PG8_SCHED;
            PG8_LDA(At, 0, 1); PG8_STAGE(PG8_SB(0, 0), b2, voffB); PG8_STAGE(PG8_SB(0, 1), b2 + hstep, voffB); PG8_STAGE(PG8_SA(0, 0), a2, voffA);
            PG8_WAIT_V(8); PG8_WAIT_L(0); PG8_BAR; PG8_MMA(1, 0, At, B0); PG8_MMA(1, 1, At, B1); PG8_BAR; PG8_SCHED;
            PG8_LDB(B0, 1, 0); PG8_LDB(B1, 1, 1); PG8_SCHED; PG8_LDA(At, 1, 0); PG8_STAGE(PG8_SA(0, 1), a2 + hstep, voffA);
            PG8_WAIT_V(8); PG8_WAIT_L(0); PG8_BAR; PG8_MMA(0, 0, At, B0); PG8_MMA(0, 1, At, B1); PG8_BAR; PG8_SCHED;
            PG8_LDA(At, 1, 1); PG8_STAGE(PG8_SB(1, 0), b3, voffB); PG8_STAGE(PG8_SB(1, 1), b3 + hstep, voffB); PG8_STAGE(PG8_SA(1, 0), a3, voffA);
            PG8_WAIT_V(8); PG8_WAIT_L(0); PG8_BAR; PG8_MMA(1, 0, At, B0); PG8_MMA(1, 1, At, B1); PG8_BAR; PG8_SCHED;
            } else {
            PG8_LDB(B0, 0, 0); PG8_SCHED; PG8_LDA(At, 0, 0); PG8_STAGE(PG8_SA(1, 1), a1 + hstep, voffA);
            PG8_WAIT_L(8); PG8_BAR; PG8_WAIT_L(0); PG8_MMA(0, 0, At, B0); PG8_BAR; PG8_SCHED;
            PG8_LDB(B1, 0, 1); PG8_STAGE(PG8_SB(0, 0), b2, voffB);
            PG8_BAR; PG8_WAIT_L(0); PG8_MMA(0, 1, At, B1); PG8_BAR;
            PG8_LDA(At, 0, 1); PG8_STAGE(PG8_SA(0, 0), a2, voffA);
            PG8_BAR; PG8_WAIT_L(0); PG8_MMA(1, 0, At, B0); PG8_BAR; PG8_SCHED;
            PG8_STAGE(PG8_SB(0, 1), b2 + hstep, voffB);
            PG8_WAIT_V(6); PG8_BAR; PG8_MMA(1, 1, At, B1); PG8_BAR;
            PG8_LDB(B0, 1, 0); PG8_SCHED; PG8_LDA(At, 1, 0); PG8_STAGE(PG8_SA(0, 1), a2 + hstep, voffA);
            PG8_WAIT_L(8); PG8_BAR; PG8_WAIT_L(0); PG8_MMA(0, 0, At, B0); PG8_BAR; PG8_SCHED;
            PG8_LDB(B1, 1, 1); PG8_STAGE(PG8_SB(1, 0), b3, voffB);
            PG8_BAR; PG8_WAIT_L(0); PG8_MMA(0, 1, At, B1); PG8_BAR;
            PG8_LDA(At, 1, 1); PG8_STAGE(PG8_SA(1, 0), a3, voffA);
            PG8_BAR; PG8_WAIT_L(0); PG8_MMA(1, 0, At, B0); PG8_BAR; PG8_SCHED;
            PG8_STAGE(PG8_SB(1, 1), b3 + hstep, voffB);
            PG8_WAIT_V(6); PG8_BAR; PG8_MMA(1, 1, At, B1); PG8_BAR;
            }
        }
        if constexpr (ALIGN_EPI) { if (wr == 0) PG8_BAR; }
        if constexpr (!Epi::AFTER_DRAIN) { E(acc, cur, wr, wc, fr, fq); S.done(cur); }
        if (!has_next) break;
#pragma unroll
        for (int a = 0; a < 2; ++a)
#pragma unroll
            for (int b = 0; b < 2; ++b)
#pragma unroll
                for (int m = 0; m < 4; ++m)
#pragma unroll
                    for (int n = 0; n < 2; ++n) acc[a][b][m][n] = (f32x4){0.f, 0.f, 0.f, 0.f};
        cur = nxt; cA = nA; cB = nB; ++ui;
        if constexpr (ALIGN_EPI) { if (wr == 1) PG8_BAR; }
    }
    PG8_WAIT_V(0);
    if constexpr (!ALIGN_EPI) { if (wr == 0) PG8_BAR; }
    PG8_BAR;
    if constexpr (Epi::AFTER_DRAIN) { E.fused(acc, cur, wr, wc, fr, fq, lds, wid, lane); S.done(cur); }
#undef PG8_SA
#undef PG8_SB
#undef PG8_STAGE
#undef PG8_LDA
#undef PG8_LDB
#undef PG8_MMA
#undef PG8_WAIT_V
#undef PG8_WAIT_L
#undef PG8_BAR
#undef PG8_SCHED
}
}

#define DI __device__ __forceinline__
#define LAS __attribute__((address_space(3)))
typedef unsigned short bf16_t;
typedef short bf16x8 __attribute__((ext_vector_type(8)));
typedef float f32x4 __attribute__((ext_vector_type(4)));
typedef float f32x16 __attribute__((ext_vector_type(16)));
typedef unsigned u32x4 __attribute__((ext_vector_type(4)));
typedef unsigned u32x2 __attribute__((ext_vector_type(2)));
typedef __bf16 bf16x2_t __attribute__((ext_vector_type(2)));
typedef float f32x2_t __attribute__((ext_vector_type(2)));

constexpr int D = 1024, BATCH = 32, SEQ = 2048, MTOK = BATCH * SEQ, NIN = 3328, DEPTH = 2;
constexpr int C_A = 0, C_GA = 256, C_U = 512, C_VS = 768, C_GB = 1024, C_Q = 1280, C_K = 1792, C_V = 2304, C_GC = 2816;
constexpr float DN_ALPHA = 1.41421356237309515f;
constexpr float LN_EPS = 1e-5f;
constexpr float LOG2E = 1.44269504088896341f;

constexpr size_t WS_WIN = 0;
constexpr size_t WS_WOUT = WS_WIN + (size_t)DEPTH * NIN * D * 2;
constexpr size_t WS_MOD = WS_WOUT + (size_t)DEPTH * D * D * 2;
constexpr size_t WS_HB = WS_MOD + (size_t)DEPTH * BATCH * 3 * D * 4;
constexpr size_t WS_P = WS_HB + (size_t)MTOK * D * 2;
constexpr size_t WS_Y = WS_P + (size_t)MTOK * NIN * 2;
constexpr size_t WS_R0 = WS_Y + (size_t)MTOK * D * 2;
constexpr size_t WS_PSTAT = WS_R0 + (size_t)MTOK * D * 4;
constexpr size_t WS_RSTAT = WS_PSTAT + (size_t)MTOK * 16 * 2 * 4;
constexpr size_t WS_SGW = WS_RSTAT + (size_t)MTOK * 2 * 4;
constexpr size_t WS_END = WS_SGW + (size_t)DEPTH * 4 * 128 * 128 * 2;

constexpr int LDS_BYTES = 139264;
constexpr int NTHREADS = 512, NWAVES = 8;
#ifndef DUP
#define DUP 0
#endif

struct Params {
    const float *x, *c, *w_in, *pool_w, *pool_scale, *sgu_ln_g, *sgu_ln_b, *sgu_w, *sgu_b, *w_out, *ada_w, *ada_b, *ln_g, *ln_b;
    float* out; unsigned char* ws;
    int ph_lo, ph_hi;
};

DI unsigned pk2(float lo, float hi) { f32x2_t v = {lo, hi}; bf16x2_t b = __builtin_convertvector(v, bf16x2_t); return __builtin_bit_cast(unsigned, b); }
DI float bf2f(unsigned short u) { return __builtin_bit_cast(float, (unsigned)u << 16); }
DI float bflo(unsigned u) { return __builtin_bit_cast(float, u << 16); }
DI float bfhi(unsigned u) { return __builtin_bit_cast(float, u & 0xffff0000u); }
DI float silu_f(float v) { return v * __builtin_amdgcn_rcpf(1.f + __builtin_amdgcn_exp2f(-v * LOG2E)); }
DI float wave_sum(float v) {
#pragma unroll
    for (int o = 1; o < 64; o <<= 1) v += __shfl_xor(v, o);
    return v;
}
DI float swap32(float v, int hh) {
    const unsigned u = __builtin_bit_cast(unsigned, v);
    const auto rr = __builtin_amdgcn_permlane32_swap(u, u, false, false);
    return __builtin_bit_cast(float, hh ? rr[0] : rr[1]);
}
DI int crow(int i, int hh) { return (i & 3) + 8 * (i >> 2) + 4 * hh; }
#define MFMA32(a, b, c) __builtin_amdgcn_mfma_f32_32x32x16_bf16((a), (b), (c), 0, 0, 0)
#define LDS_WAIT() asm volatile("s_waitcnt lgkmcnt(0)" ::: "memory")

struct EpiP {
    static constexpr bool PERM = true, AFTER_DRAIN = false;
    bf16_t* O;
    DI void operator()(const pg8::f32x4 (&acc)[2][2][4][2], const pg8::Unit& u, int wr, int wc, int fr, int fq) const {
        const int row0 = u.pm * 256 + wr * 64 + fr, col0 = u.pn * 256 + wc * 32 + 8 * fq;
#pragma unroll
        for (int ai = 0; ai < 2; ++ai)
#pragma unroll
            for (int m = 0; m < 4; ++m) {
                bf16_t* rowp = O + (size_t)(row0 + ai * 128 + m * 16) * NIN + col0;
#pragma unroll
                for (int bj = 0; bj < 2; ++bj) {
                    const pg8::f32x4 v0 = acc[ai][bj][m][0], v1 = acc[ai][bj][m][1];
                    u32x4 w; w.x = pk2(v0[0], v0[1]); w.y = pk2(v0[2], v0[3]); w.z = pk2(v1[0], v1[1]); w.w = pk2(v1[2], v1[3]);
                    *(u32x4*)(rowp + bj * 128) = w;
                }
            }
    }
};
struct EpiRes {
    static constexpr bool PERM = true, AFTER_DRAIN = false;
    const float* xsrc;
    const float* rstat;
    const float* lng; const float* lnb;
    const float* gate;
    float* R; float* pstat;
    DI void operator()(const pg8::f32x4 (&acc)[2][2][4][2], const pg8::Unit& u, int wr, int wc, int fr, int fq) const {
        const int row0 = u.pm * 256 + wr * 64 + fr, col0 = u.pn * 256 + wc * 32 + 8 * fq;
        const int b = (u.pm * 256) >> 11;
        f32x4 ga[2][2];
#pragma unroll
        for (int bj = 0; bj < 2; ++bj)
#pragma unroll
            for (int n = 0; n < 2; ++n) ga[bj][n] = *(const f32x4*)(gate + (size_t)b * 3072 + col0 + bj * 128 + 4 * n);
#pragma unroll
        for (int ai = 0; ai < 2; ++ai)
#pragma unroll
            for (int m = 0; m < 4; ++m) {
                const int row = row0 + ai * 128 + m * 16;
                float mean = 0.f, rstd = 1.f;
                if (rstat) { const f32x2_t st = *(const f32x2_t*)(rstat + (size_t)row * 2); mean = st.x; rstd = st.y; }
                float s = 0.f, ss = 0.f;
#pragma unroll
                for (int bj = 0; bj < 2; ++bj)
#pragma unroll
                    for (int n = 0; n < 2; ++n) {
                        const int col = col0 + bj * 128 + 4 * n;
                        f32x4 xv = *(const f32x4*)(xsrc + (size_t)row * D + col);
                        if (rstat) { const f32x4 g = *(const f32x4*)(lng + col), bb = *(const f32x4*)(lnb + col); xv = (xv - mean) * rstd * g + bb; }
                        const f32x4 a = acc[ai][bj][m][n];
                        const f32x4 v = xv * DN_ALPHA + ga[bj][n] * a;
                        *(f32x4*)(R + (size_t)row * D + col) = v;
                        s += (v[0] + v[1]) + (v[2] + v[3]);
                        ss += (v[0] * v[0] + v[1] * v[1]) + (v[2] * v[2] + v[3] * v[3]);
                    }
                s += __shfl_xor(s, 16); ss += __shfl_xor(ss, 16);
                s += __shfl_xor(s, 32); ss += __shfl_xor(ss, 32);
                if (fq == 0) { f32x2_t o = {s, ss}; *(f32x2_t*)(pstat + ((size_t)row * 16 + u.pn * 4 + wc) * 2) = o; }
            }
    }
};

DI void transpose_item(const float* W, int K, int N, bf16_t* WT, LAS float* scr, int item, int lane) {
    const int nblk = N / 32, kb = item / nblk, nb = item % nblk, k0 = 64 * kb, n0 = 32 * nb;
#pragma unroll 8
    for (int i = 0; i < 32; ++i) { const int kk = 2 * i + (lane >> 5); scr[kk * 33 + (lane & 31)] = W[(size_t)(k0 + kk) * N + n0 + (lane & 31)]; }
    LDS_WAIT();
    const int c = lane & 7;
#pragma unroll
    for (int j = 0; j < 4; ++j) {
        const int n = (lane >> 3) + 8 * j; const LAS float* s = scr + (8 * c) * 33 + n;
        u32x4 o; o.x = pk2(s[0 * 33], s[1 * 33]); o.y = pk2(s[2 * 33], s[3 * 33]); o.z = pk2(s[4 * 33], s[5 * 33]); o.w = pk2(s[6 * 33], s[7 * 33]);
        *(u32x4*)(WT + (size_t)(n0 + n) * K + k0 + 8 * c) = o;
    }
    LDS_WAIT();
}

DI void phase0(const Params& P, LAS unsigned char* lds, int tid, int lane, int wave) {
    tid = launder_v(tid); lane = launder_v(lane); wave = launder_s(wave);
    bf16_t* win_t = (bf16_t*)(P.ws + WS_WIN); bf16_t* wout_t = (bf16_t*)(P.ws + WS_WOUT); float* mod = (float*)(P.ws + WS_MOD);
    for (int i = blockIdx.x * NTHREADS + tid; i < DEPTH * 4 * 128 * 128 / 8; i += gridDim.x * NTHREADS) {
        const f32x4 w0 = *(const f32x4*)(P.sgu_w + (size_t)i * 8), w1 = *(const f32x4*)(P.sgu_w + (size_t)i * 8 + 4);
        u32x4 o; o.x = pk2(w0[0], w0[1]); o.y = pk2(w0[2], w0[3]); o.z = pk2(w1[0], w1[1]); o.w = pk2(w1[2], w1[3]);
        *(u32x4*)(P.ws + WS_SGW + (size_t)i * 16) = o;
    }
    {
        LAS float* scr = (LAS float*)(lds + wave * 16384);
        const int gw = blockIdx.x * NWAVES + wave, NGW = gridDim.x * NWAVES;
        constexpr int I_IN = (D / 64) * (NIN / 32), I_OUT = (D / 64) * (D / 32);
        for (int it = gw; it < DEPTH * (I_IN + I_OUT); it += NGW) {
            const int l = it / (I_IN + I_OUT); int r = it % (I_IN + I_OUT);
            if (r < I_IN) transpose_item(P.w_in + (size_t)l * D * NIN, D, NIN, win_t + (size_t)l * NIN * D, scr, r, lane);
            else transpose_item(P.w_out + (size_t)l * D * D, D, D, wout_t + (size_t)l * D * D, scr, r - I_IN, lane);
        }
    }
    __syncthreads();
    LAS float* sc = (LAS float*)lds;
    for (int item = blockIdx.x; item < DEPTH * 96; item += gridDim.x) {
        const int l = item / 96, j0 = (item % 96) * 32;
        for (int e = tid; e < BATCH * D; e += NTHREADS) { const int b = e >> 10, k = e & 1023; sc[k * 32 + b] = silu_f(P.c[e]); }
        __syncthreads();
        const int j = tid & 31, ks = tid >> 5;
        float acc[32];
#pragma unroll
        for (int b = 0; b < 32; ++b) acc[b] = 0.f;
        const float* wp = P.ada_w + ((size_t)l * D + ks * 64) * 3072 + j0 + j;
#pragma unroll 2
        for (int kk = 0; kk < 64; ++kk) {
            const float w = wp[(size_t)kk * 3072];
            const LAS f32x4* s4 = (const LAS f32x4*)(sc + (ks * 64 + kk) * 32);
#pragma unroll
            for (int q = 0; q < 8; ++q) { const f32x4 v = s4[q]; acc[4 * q] += v[0] * w; acc[4 * q + 1] += v[1] * w; acc[4 * q + 2] += v[2] * w; acc[4 * q + 3] += v[3] * w; }
        }
        __syncthreads();
        LAS float* red = (LAS float*)lds;
#pragma unroll
        for (int b = 0; b < 32; ++b) red[(ks * 32 + b) * 32 + j] = acc[b];
        __syncthreads();
#pragma unroll
        for (int o2 = 0; o2 < 2; ++o2) {
            const int o = tid + o2 * NTHREADS, b = o >> 5, jj = o & 31;
            float s = P.ada_b[l * 3072 + j0 + jj];
#pragma unroll
            for (int q = 0; q < 16; ++q) s += red[(q * 32 + b) * 32 + jj];
            mod[((size_t)l * BATCH + b) * 3072 + j0 + jj] = s;
        }
        __syncthreads();
    }
}

template <int MODE>
DI void row_pass(const Params& P, int lane, int wave) {
    lane = launder_v(lane); wave = launder_s(wave);
    const int gw = blockIdx.x * NWAVES + wave, NGW = gridDim.x * NWAVES;
    const float* mod = (const float*)(P.ws + WS_MOD) + (MODE == 1 ? (size_t)BATCH * 3072 : 0);
    const float* pstat = (const float*)(P.ws + WS_PSTAT);
    float* rstat = (float*)(P.ws + WS_RSTAT);
    bf16_t* hb = (bf16_t*)(P.ws + WS_HB);
    const float* src = MODE == 0 ? P.x : (MODE == 1 ? (const float*)(P.ws + WS_R0) : (const float*)P.out);
    const float* lg = P.ln_g + (MODE == 2 ? D : 0); const float* lb = P.ln_b + (MODE == 2 ? D : 0);
    constexpr int RU = 4;
    for (int row0 = gw * RU; row0 < MTOK; row0 += NGW * RU) {
        f32x4 v[RU][4];
#pragma unroll
        for (int u = 0; u < RU; ++u)
#pragma unroll
            for (int j = 0; j < 4; ++j) v[u][j] = *(const f32x4*)(src + (size_t)(row0 + u) * D + 4 * lane + 256 * j);
        float mean[RU], rstd[RU];
#pragma unroll
        for (int u = 0; u < RU; ++u) { mean[u] = 0.f; rstd[u] = 1.f; }
        if (MODE != 0) {
            const f32x2_t st = *(const f32x2_t*)(pstat + ((size_t)(row0 + (lane >> 4)) * 16 + (lane & 15)) * 2);
            float s = st.x, ss = st.y;
#pragma unroll
            for (int o = 1; o < 16; o <<= 1) { s += __shfl_xor(s, o); ss += __shfl_xor(ss, o); }
            const float m = s * (1.f / D); const float var = fmaxf(ss * (1.f / D) - m * m, 0.f); const float rs = 1.f / sqrtf(var + LN_EPS);
            if (MODE == 1 && (lane & 15) == 0) { f32x2_t o = {m, rs}; *(f32x2_t*)(rstat + (size_t)(row0 + (lane >> 4)) * 2) = o; }
#pragma unroll
            for (int u = 0; u < RU; ++u) { mean[u] = __shfl(m, 16 * u); rstd[u] = __shfl(rs, 16 * u); }
        }
        const int b = row0 >> 11;
#pragma unroll
        for (int j = 0; j < 4; ++j) {
            const int col = 4 * lane + 256 * j;
            f32x4 g = {1.f, 1.f, 1.f, 1.f}, bb = {0.f, 0.f, 0.f, 0.f}, sh = bb, scl = bb;
            if (MODE != 0) { g = *(const f32x4*)(lg + col); bb = *(const f32x4*)(lb + col); }
            if (MODE != 2) { sh = *(const f32x4*)(mod + (size_t)b * 3072 + col); scl = *(const f32x4*)(mod + (size_t)b * 3072 + 1024 + col); }
#pragma unroll
            for (int u = 0; u < RU; ++u) {
                f32x4 w = v[u][j];
                if (MODE != 0) w = (w - mean[u]) * rstd[u] * g + bb;
                if (MODE == 2) { *(f32x4*)(P.out + (size_t)(row0 + u) * D + col) = w; }
                else {
                    w = w * (scl + 1.f) + sh;
                    u32x2 o; o.x = pk2(w[0], w[1]); o.y = pk2(w[2], w[3]);
                    *(u32x2*)(hb + (size_t)(row0 + u) * D + col) = o;
                }
            }
        }
    }
}

constexpr int VT_PITCH = 272;
constexpr int SG_OST = 36;
DI int vt_off(int ch) { return ch * VT_PITCH + (ch >> 6) * 32; }
DI void sgu_unit(const Params& P, int l, int unit, LAS unsigned char* lds, int tid, int lane, int wave) {
    const bf16_t* p = (const bf16_t*)(P.ws + WS_P); bf16_t* Y = (bf16_t*)(P.ws + WS_Y);
    const int tok0 = unit * 128;
    {
        const int s = tid >> 2, qd = tid & 3;
        const bf16_t* vp = p + (size_t)(tok0 + s) * NIN + C_VS + qd * 64;
        u32x4 raw[8];
#pragma unroll
        for (int c = 0; c < 8; ++c) raw[c] = *(const u32x4*)(vp + 8 * c);
        float sm = 0.f, sq = 0.f;
#pragma unroll
        for (int c = 0; c < 8; ++c) {
            const float a0 = bflo(raw[c].x), a1 = bfhi(raw[c].x), a2 = bflo(raw[c].y), a3 = bfhi(raw[c].y), a4 = bflo(raw[c].z), a5 = bfhi(raw[c].z), a6 = bflo(raw[c].w), a7 = bfhi(raw[c].w);
            sm += ((a0 + a1) + (a2 + a3)) + ((a4 + a5) + (a6 + a7));
            sq += ((a0 * a0 + a1 * a1) + (a2 * a2 + a3 * a3)) + ((a4 * a4 + a5 * a5) + (a6 * a6 + a7 * a7));
        }
        sm += __shfl_xor(sm, 1); sq += __shfl_xor(sq, 1);
        sm += __shfl_xor(sm, 2); sq += __shfl_xor(sq, 2);
        const float mean = sm * (1.f / 256.f);
        const float var = fmaxf(sq * (1.f / 256.f) - mean * mean, 0.f);
        const float rstd = 1.f / sqrtf(var + LN_EPS);
        const float* gp = P.sgu_ln_g + l * 256 + qd * 64; const float* bp = P.sgu_ln_b + l * 256 + qd * 64;
        LAS bf16_t* vt = (LAS bf16_t*)(lds + vt_off(qd * 64) + s * 2);
#pragma unroll
        for (int c = 0; c < 8; ++c) {
            const f32x4 g0 = *(const f32x4*)(gp + 8 * c), g1 = *(const f32x4*)(gp + 8 * c + 4), b0 = *(const f32x4*)(bp + 8 * c), b1 = *(const f32x4*)(bp + 8 * c + 4);
            const float a[8] = {bflo(raw[c].x), bfhi(raw[c].x), bflo(raw[c].y), bfhi(raw[c].y), bflo(raw[c].z), bfhi(raw[c].z), bflo(raw[c].w), bfhi(raw[c].w)};
#pragma unroll
            for (int e = 0; e < 8; ++e) {
                const float gg = e < 4 ? g0[e & 3] : g1[e & 3], bb = e < 4 ? b0[e & 3] : b1[e & 3];
                vt[(8 * c + e) * (VT_PITCH / 2)] = (bf16_t)(pk2((a[e] - mean) * rstd * gg + bb, 0.f) & 0xffffu);
            }
        }
    }
    const int h = wave & 3, dblk = wave >> 2, r = lane & 31, hh = lane >> 5;
    const int ch = h * 64 + 32 * dblk + r;
    const bf16_t* wb = (const bf16_t*)(P.ws + WS_SGW) + ((size_t)(l * 4 + h) * 128 + r) * 128 + 8 * hh;
    bf16x8 af[24];
#pragma unroll
    for (int ks = 0; ks < 4; ++ks)
#pragma unroll
        for (int tb = 0; tb < 4; ++tb) af[ks * 4 + tb] = *(const bf16x8*)(wb + (size_t)(32 * tb) * 128 + 16 * ks);
#pragma unroll
    for (int ks = 4; ks < 8; ++ks)
#pragma unroll
        for (int tb = 2; tb < 4; ++tb) af[16 + (ks - 4) * 2 + (tb - 2)] = *(const bf16x8*)(wb + (size_t)(32 * tb) * 128 + 16 * ks);
    __syncthreads();
    f32x16 acc[4];
#pragma unroll
    for (int tb = 0; tb < 4; ++tb)
#pragma unroll
        for (int i = 0; i < 16; ++i) acc[tb][i] = 0.f;
#pragma unroll
    for (int ks = 0; ks < 8; ++ks) {
        const bf16x8 bfrag = *(const LAS bf16x8*)(lds + vt_off(ch) + (16 * ks + 8 * hh) * 2);
#pragma unroll
        for (int tb = (ks < 4 ? 0 : 2); tb < 4; ++tb)
            acc[tb] = MFMA32(ks < 4 ? af[ks * 4 + tb] : af[16 + (ks - 4) * 2 + (tb - 2)], bfrag, acc[tb]);
    }
    const int erow = lane >> 2, edc = lane & 3;
    const size_t ecol = (size_t)h * 64 + 32 * dblk + edc * 8;
    u32x4 uu[8], gg[8];
#pragma unroll
    for (int k = 0; k < 8; ++k) {
        const size_t tok = (size_t)(tok0 + erow + 16 * k);
        uu[k] = *(const u32x4*)(p + tok * NIN + C_U + ecol); gg[k] = *(const u32x4*)(p + tok * NIN + C_GB + ecol);
    }
    __syncthreads();
    LAS float* ost = (LAS float*)(lds + wave * (64 * SG_OST * 4));
    const float* sb = P.sgu_b + (l * 4 + h) * 128;
#pragma unroll
    for (int half = 0; half < 2; ++half) {
#pragma unroll
        for (int tb2 = 0; tb2 < 2; ++tb2)
#pragma unroll
            for (int i = 0; i < 16; ++i) ost[(32 * tb2 + crow(i, hh)) * SG_OST + r] = acc[2 * half + tb2][i];
#pragma unroll
        for (int it = 0; it < 4; ++it) {
            const int k = 4 * half + it, t = erow + 16 * k;
            const LAS float* op = ost + (erow + 16 * it) * SG_OST + edc * 8;
            const f32x4 a = *(const LAS f32x4*)op, b = *(const LAS f32x4*)(op + 4);
            const float bias = sb[t];
            const u32x4 u = uu[k], g = gg[k];
            u32x4 w;
            w.x = pk2(bflo(u.x) * (a[0] + bias) * silu_f(bflo(g.x)), bfhi(u.x) * (a[1] + bias) * silu_f(bfhi(g.x)));
            w.y = pk2(bflo(u.y) * (a[2] + bias) * silu_f(bflo(g.y)), bfhi(u.y) * (a[3] + bias) * silu_f(bfhi(g.y)));
            w.z = pk2(bflo(u.z) * (b[0] + bias) * silu_f(bflo(g.z)), bfhi(u.z) * (b[1] + bias) * silu_f(bfhi(g.z)));
            w.w = pk2(bflo(u.w) * (b[2] + bias) * silu_f(bflo(g.w)), bfhi(u.w) * (b[3] + bias) * silu_f(bfhi(g.w)));
            *(u32x4*)(Y + (size_t)(tok0 + t) * D + 256 + ecol) = w;
        }
    }
    __syncthreads();
}

typedef short v4i16_t __attribute__((ext_vector_type(4)));
DI v4i16_t lds_tr16(const LAS unsigned char* p) { return __builtin_amdgcn_ds_read_tr16_b64_v4i16((LAS v4i16_t*)p); }
constexpr int OST_PITCH = 68;
DI void tile_epilogue(const f32x16& o0, const f32x16& o1, LAS float* ost, int lane, const bf16_t* grow  , bf16_t* yrow, const float* colscale) {
    const int r = lane & 31, hh = lane >> 5;
#pragma unroll
    for (int i = 0; i < 16; ++i) { ost[crow(i, hh) * OST_PITCH + r] = o0[i]; ost[crow(i, hh) * OST_PITCH + 32 + r] = o1[i]; }
#pragma unroll
    for (int it = 0; it < 4; ++it) {
        const int c = lane + 64 * it, q = c >> 3, dc = c & 7;
        const u32x4 g = *(const u32x4*)(grow + (size_t)q * NIN + dc * 8);
        const f32x4 a = *(const LAS f32x4*)(ost + q * OST_PITCH + dc * 8), b = *(const LAS f32x4*)(ost + q * OST_PITCH + dc * 8 + 4);
        f32x4 s0 = {1.f, 1.f, 1.f, 1.f}, s1 = s0;
        if (colscale) { s0 = *(const f32x4*)(colscale + dc * 8); s1 = *(const f32x4*)(colscale + dc * 8 + 4); }
        u32x4 w;
        w.x = pk2(a[0] * s0[0] * silu_f(bflo(g.x)), a[1] * s0[1] * silu_f(bfhi(g.x)));
        w.y = pk2(a[2] * s0[2] * silu_f(bflo(g.y)), a[3] * s0[3] * silu_f(bfhi(g.y)));
        w.z = pk2(b[0] * s1[0] * silu_f(bflo(g.z)), b[1] * s1[1] * silu_f(bfhi(g.z)));
        w.w = pk2(b[2] * s1[2] * silu_f(bflo(g.w)), b[3] * s1[3] * silu_f(bfhi(g.w)));
        *(u32x4*)(yrow + (size_t)q * D + dc * 8) = w;
    }
}

constexpr int PA_PITCH = 144;
DI void pool_wave(const Params& P, int l, int gw, int NGW, int lane, LAS unsigned char* wl) {
    const bf16_t* p = (const bf16_t*)(P.ws + WS_P); bf16_t* Y = (bf16_t*)(P.ws + WS_Y);
    const int g = gw & 3, r = lane & 31, hh = lane >> 5;
    const int win = 2 << g;
    LAS float* ost = (LAS float*)(wl + 7168);
    bf16x8 bw[4][2];
#pragma unroll
    for (int s = 0; s < 4; ++s)
#pragma unroll
        for (int db = 0; db < 2; ++db) {
            const float* wp = P.pool_w + ((size_t)(l * 4 + g) * 64 + 16 * s + 8 * hh) * 64 + 32 * db + r;
            u32x4 a; a.x = pk2(wp[0], wp[64]); a.y = pk2(wp[128], wp[192]); a.z = pk2(wp[256], wp[320]); a.w = pk2(wp[384], wp[448]);
            bw[s][db] = __builtin_bit_cast(bf16x8, a);
        }
    for (int tile = gw >> 2; tile < MTOK / 32; tile += NGW >> 2) {
        const int tok0 = tile * 32, pos0 = tok0 & (SEQ - 1), pos = pos0 + r;
#pragma unroll
        for (int it = 0; it < 6; ++it) {
            const int c = lane + 64 * it, row = c >> 3, dc = c & 7;
            u32x4 v = {0u, 0u, 0u, 0u};
            if (row >= 16 || pos0 != 0) v = *(const u32x4*)(p + (size_t)(tok0 - 16 + row) * NIN + C_A + g * 64 + dc * 8);
            *(LAS u32x4*)(wl + row * PA_PITCH + dc * 16) = v;
        }
        const int cnt = (pos + 1 < win) ? pos + 1 : win;
        const float inv = 1.f / (float)cnt;
        f32x16 acc0, acc1;
#pragma unroll
        for (int i = 0; i < 16; ++i) { acc0[i] = 0.f; acc1[i] = 0.f; }
#pragma unroll
        for (int s = 0; s < 4; ++s) {
            const LAS unsigned char* base = wl + (16 + r) * PA_PITCH + (16 * s + 8 * hh) * 2;
            const u32x4 own = *(const LAS u32x4*)base;
            float sum[8];
            sum[0] = bflo(own.x); sum[1] = bfhi(own.x); sum[2] = bflo(own.y); sum[3] = bfhi(own.y); sum[4] = bflo(own.z); sum[5] = bfhi(own.z); sum[6] = bflo(own.w); sum[7] = bfhi(own.w);
            for (int j = 1; j < win; ++j) {
                const u32x4 v = *(const LAS u32x4*)(base - j * PA_PITCH);
                sum[0] += bflo(v.x); sum[1] += bfhi(v.x); sum[2] += bflo(v.y); sum[3] += bfhi(v.y); sum[4] += bflo(v.z); sum[5] += bfhi(v.z); sum[6] += bflo(v.w); sum[7] += bfhi(v.w);
            }
            u32x4 a;
            a.x = pk2(sum[0] * inv - bflo(own.x), sum[1] * inv - bfhi(own.x)); a.y = pk2(sum[2] * inv - bflo(own.y), sum[3] * inv - bfhi(own.y));
            a.z = pk2(sum[4] * inv - bflo(own.z), sum[5] * inv - bfhi(own.z)); a.w = pk2(sum[6] * inv - bflo(own.w), sum[7] * inv - bfhi(own.w));
            const bf16x8 af = __builtin_bit_cast(bf16x8, a);
            acc0 = MFMA32(af, bw[s][0], acc0);
            acc1 = MFMA32(af, bw[s][1], acc1);
        }
        tile_epilogue(acc0, acc1, ost, lane, p + (size_t)tok0 * NIN + C_GA + g * 64, Y + (size_t)tok0 * D + g * 64, P.pool_scale + l * 256 + g * 64);
    }
}

constexpr int KT_PITCH = 144;
constexpr int VT_OFF = 32 * KT_PITCH;
DI void attn_unit(const Params& P, int unit, int lane, LAS unsigned char* wl) {
    const bf16_t* p = (const bf16_t*)(P.ws + WS_P); bf16_t* Y = (bf16_t*)(P.ws + WS_Y);
    const int qt = unit & 63, h = (unit >> 6) & 7, b = unit >> 9;
    const int r = lane & 31, hh = lane >> 5;
    const size_t tokb = (size_t)b * SEQ;
    LAS float* ost = (LAS float*)wl;
    const size_t rowoff = (tokb + (lane >> 3)) * NIN + h * 64 + (lane & 7) * 8;
    const bf16_t* qp0 = p + rowoff + C_Q; const bf16_t* kp0 = p + rowoff + C_K; const bf16_t* vp0 = p + rowoff + C_V; const bf16_t* gp0 = p + rowoff + C_GC;
    const int klds = (lane >> 3) * KT_PITCH + (lane & 7) * 16;
    const int vlds = VT_OFF + ((lane & 7) >> 2) * 2048 + (lane >> 3) * 64 + (lane & 3) * 16;
    const int frd = r * KT_PITCH + hh * 16;
    const int trbase = VT_OFF + (4 * hh + ((lane & 15) >> 2)) * 64 + ((lane >> 4) & 1) * 32 + (lane & 3) * 8;
    bf16x8 qf[4]; u32x4 gt[4], kn[4], vn[4];
    {
        const size_t o = (size_t)qt * 32 * NIN;
        u32x4 qv[4];
#pragma unroll
        for (int it = 0; it < 4; ++it) qv[it] = *(const u32x4*)(qp0 + o + (size_t)it * 8 * NIN);
#pragma unroll
        for (int it = 0; it < 4; ++it) kn[it] = *(const u32x4*)(kp0 + o + (size_t)it * 8 * NIN);
#pragma unroll
        for (int it = 0; it < 4; ++it) vn[it] = *(const u32x4*)(vp0 + o + (size_t)it * 8 * NIN);
#pragma unroll
        for (int it = 0; it < 4; ++it) gt[it] = *(const u32x4*)(gp0 + o + (size_t)it * 8 * NIN);
#pragma unroll
        for (int it = 0; it < 4; ++it) *(LAS u32x4*)(wl + klds + it * 8 * KT_PITCH) = qv[it];
#pragma unroll
        for (int s = 0; s < 4; ++s) qf[s] = *(const LAS bf16x8*)(wl + frd + s * 32);
    }
    f32x16 o0, o1;
#pragma unroll
    for (int i = 0; i < 16; ++i) { o0[i] = 0.f; o1[i] = 0.f; }
    float carry = 0.f;
    const float CZ = 0.125f * LOG2E;
    for (int kb = qt; kb >= 0; --kb) {
#pragma unroll
        for (int it = 0; it < 4; ++it) *(LAS u32x4*)(wl + klds + it * 8 * KT_PITCH) = kn[it];
#pragma unroll
        for (int it = 0; it < 4; ++it) *(LAS u32x4*)(wl + vlds + it * 512) = vn[it];
        if (kb > 0) {
            const size_t o = (size_t)(kb - 1) * 32 * NIN;
#pragma unroll
            for (int it = 0; it < 4; ++it) kn[it] = *(const u32x4*)(kp0 + o + (size_t)it * 8 * NIN);
#pragma unroll
            for (int it = 0; it < 4; ++it) vn[it] = *(const u32x4*)(vp0 + o + (size_t)it * 8 * NIN);
        }
        f32x16 z;
#pragma unroll
        for (int i = 0; i < 16; ++i) z[i] = 0.f;
#pragma unroll
        for (int s = 0; s < 4; ++s) { const bf16x8 kf = *(const LAS bf16x8*)(wl + frd + s * 32); z = MFMA32(kf, qf[s], z); }
        float l1m[16], lbv[16];
#pragma unroll
        for (int i = 0; i < 16; ++i) {
            const float t = z[i] * CZ;
            const float e = __builtin_amdgcn_exp2f(-fabsf(t));
            const float sp = fmaxf(t, 0.f) + __builtin_amdgcn_logf(1.f + e);
            l1m[i] = -sp; lbv[i] = t - sp;
        }
        if (kb == qt) {
#pragma unroll
            for (int i = 0; i < 16; ++i) if (crow(i, hh) >= r) { l1m[i] = 0.f; lbv[i] = -__builtin_inff(); }
        }
        float gs[4], og[4];
#pragma unroll
        for (int q = 0; q < 4; ++q) { gs[q] = (l1m[4 * q] + l1m[4 * q + 1]) + (l1m[4 * q + 2] + l1m[4 * q + 3]); og[q] = swap32(gs[q], hh); }
        float suf = carry;
        float a[16];
#pragma unroll
        for (int q = 3; q >= 0; --q) {
            float lat = suf + (hh == 0 ? og[q] : 0.f);
            a[4 * q + 3] = __builtin_amdgcn_exp2f(lbv[4 * q + 3] + lat); lat += l1m[4 * q + 3];
            a[4 * q + 2] = __builtin_amdgcn_exp2f(lbv[4 * q + 2] + lat); lat += l1m[4 * q + 2];
            a[4 * q + 1] = __builtin_amdgcn_exp2f(lbv[4 * q + 1] + lat); lat += l1m[4 * q + 1];
            a[4 * q] = __builtin_amdgcn_exp2f(lbv[4 * q] + lat);
            suf += gs[q] + og[q];
        }
        carry = suf;
        u32x4 pa0, pa1;
        pa0.x = pk2(a[0], a[1]); pa0.y = pk2(a[2], a[3]); pa0.z = pk2(a[4], a[5]); pa0.w = pk2(a[6], a[7]);
        pa1.x = pk2(a[8], a[9]); pa1.y = pk2(a[10], a[11]); pa1.z = pk2(a[12], a[13]); pa1.w = pk2(a[14], a[15]);
        bf16x8 vf[2][2];
#pragma unroll
        for (int s = 0; s < 2; ++s)
#pragma unroll
            for (int db = 0; db < 2; ++db) {
                const v4i16_t lo = lds_tr16(wl + trbase + db * 2048 + (16 * s) * 64), hi = lds_tr16(wl + trbase + db * 2048 + (16 * s + 8) * 64);
                vf[s][db] = __builtin_shufflevector(lo, hi, 0, 1, 2, 3, 4, 5, 6, 7);
            }
        o0 = MFMA32(__builtin_bit_cast(bf16x8, pa0), vf[0][0], o0);
        o0 = MFMA32(__builtin_bit_cast(bf16x8, pa1), vf[1][0], o0);
        o1 = MFMA32(__builtin_bit_cast(bf16x8, pa0), vf[0][1], o1);
        o1 = MFMA32(__builtin_bit_cast(bf16x8, pa1), vf[1][1], o1);
        if (__ballot(carry > -160.f) == 0ull) break;
    }
#pragma unroll
    for (int i = 0; i < 16; ++i) { ost[crow(i, hh) * OST_PITCH + r] = o0[i]; ost[crow(i, hh) * OST_PITCH + 32 + r] = o1[i]; }
    bf16_t* yp0 = Y + (tokb + qt * 32 + (lane >> 3)) * D + 512 + h * 64 + (lane & 7) * 8;
#pragma unroll
    for (int it = 0; it < 4; ++it) {
        const LAS float* op = ost + ((lane >> 3) + 8 * it) * OST_PITCH + (lane & 7) * 8;
        const f32x4 a = *(const LAS f32x4*)op, bq = *(const LAS f32x4*)(op + 4);
        const u32x4 g = gt[it];
        u32x4 w;
        w.x = pk2(a[0] * silu_f(bflo(g.x)), a[1] * silu_f(bfhi(g.x)));
        w.y = pk2(a[2] * silu_f(bflo(g.y)), a[3] * silu_f(bfhi(g.y)));
        w.z = pk2(bq[0] * silu_f(bflo(g.z)), bq[1] * silu_f(bfhi(g.z)));
        w.w = pk2(bq[2] * silu_f(bflo(g.w)), bq[3] * silu_f(bfhi(g.w)));
        *(u32x4*)(yp0 + (size_t)it * 8 * D) = w;
    }
}

DI void mixers(const Params& P, int l, LAS unsigned char* lds, int lane, int wave) {
    lane = launder_v(lane); wave = launder_s(wave);
    const int gw = blockIdx.x * NWAVES + wave, NGW = gridDim.x * NWAVES;
#ifndef MXMASK
#define MXMASK 7
#endif
    for (int rep = 0; rep < ((DUP & 4) ? 2 : 1); ++rep)
    if (MXMASK & 1) for (int unit = blockIdx.x; unit < BATCH * 16; unit += gridDim.x) sgu_unit(P, l, unit, lds, launder_v(threadIdx.x), lane, wave);
    for (int rep = 0; rep < ((DUP & 8) ? 2 : 1); ++rep)
    if (MXMASK & 2) pool_wave(P, l, gw, NGW, lane, lds + wave * 16384);
    for (int rep = 0; rep < ((DUP & 16) ? 2 : 1); ++rep)
    if (MXMASK & 4) for (int unit = gw; unit < BATCH * 8 * 64; unit += NGW) attn_unit(P, unit, lane, lds + wave * 16384);
}

__global__ void __launch_bounds__(NTHREADS, 2) fwd_mega(Params P) {
    extern __shared__ __attribute__((aligned(16))) unsigned char lds_raw[];
    LAS unsigned char* lds = (LAS unsigned char*)lds_raw;
    cg::grid_group grid = cg::this_grid();
    const int tid = threadIdx.x, lane = tid & 63, wave = __builtin_amdgcn_readfirstlane(tid >> 6);
    const int lo = P.ph_lo, hi = P.ph_hi;
#ifndef PHMASK
#define PHMASK 0x3ff
#endif
#define IN(k) (((PHMASK >> (k)) & 1) && lo <= (k) && (k) < hi)
#define SEAM(k) do { if (IN(k) && IN((k) + 1)) grid.sync(); } while (0)
    bf16_t* hb = (bf16_t*)(P.ws + WS_HB); bf16_t* pbuf = (bf16_t*)(P.ws + WS_P); bf16_t* ybuf = (bf16_t*)(P.ws + WS_Y);
    const bf16_t* win_t = (const bf16_t*)(P.ws + WS_WIN); const bf16_t* wout_t = (const bf16_t*)(P.ws + WS_WOUT);
    const float* mod = (const float*)(P.ws + WS_MOD);

    if (IN(0)) for (int rep = 0; rep < ((DUP & 64) ? 2 : 1); ++rep) phase0(P, lds, tid, lane, wave);
    SEAM(0);
    if (IN(1)) for (int rep = 0; rep < ((DUP & 32) ? 2 : 1); ++rep) row_pass<0>(P, lane, wave);
    SEAM(1);
#pragma unroll 1
    for (int l = 0; l < DEPTH; ++l) {
        const int pb = 2 + 4 * l;
        if (IN(pb)) for (int rep = 0; rep < ((DUP & 1) ? 2 : 1); ++rep) {
            pg8::Gemm g{hb, win_t + (size_t)l * NIN * D, MTOK, NIN, D}; pg8::StaticOrder S; S.init(MTOK, NIN, (int)gridDim.x, (int)blockIdx.x);
            EpiP E{pbuf};
            pg8::gemm_phase<EpiP, pg8::StaticOrder, true, true>(lds, g, S, E);
        }
        SEAM(pb);
        if (IN(pb + 1)) mixers(P, l, lds, lane, wave);
        SEAM(pb + 1);
        if (IN(pb + 2)) for (int rep = 0; rep < ((DUP & 2) ? 2 : 1); ++rep) {
            pg8::Gemm g{ybuf, wout_t + (size_t)l * D * D, MTOK, D, D}; pg8::StaticOrder S; S.init(MTOK, D, (int)gridDim.x, (int)blockIdx.x);
            EpiRes E{l == 0 ? P.x : (const float*)(P.ws + WS_R0), l == 0 ? nullptr : (const float*)(P.ws + WS_RSTAT), P.ln_g, P.ln_b,
                     mod + (size_t)l * BATCH * 3072 + 2048, l == 0 ? (float*)(P.ws + WS_R0) : P.out, (float*)(P.ws + WS_PSTAT)};
            pg8::gemm_phase<EpiRes, pg8::StaticOrder, true, true>(lds, g, S, E);
        }
        SEAM(pb + 2);
        if (IN(pb + 3)) { if (l == 0) { for (int rep = 0; rep < ((DUP & 32) ? 2 : 1); ++rep) row_pass<1>(P, lane, wave); } else row_pass<2>(P, lane, wave); }
        SEAM(pb + 3);
    }
#undef IN
#undef SEAM
}

#ifndef N_LAUNCH_PER_PHASE
#define N_LAUNCH_PER_PHASE 0
#endif
extern "C" void kernel_launch(void* const* d_in, const int* in_sizes, int n_in, void* d_out, int out_size, void* d_ws, size_t ws_size, hipStream_t stream) {
    static int grid = 0;
    if (grid == 0) {
        if (n_in != 14 || out_size != MTOK * D || ws_size < WS_END) { fprintf(stderr, "kernel_launch: unexpected shapes (n_in %d out %d ws %zu need %zu)\n", n_in, out_size, ws_size, (size_t)WS_END); grid = -1; return; }
        int dev = 0, cus = 0, per_cu = 0;
        hipGetDevice(&dev);
        hipDeviceGetAttribute(&cus, hipDeviceAttributeMultiprocessorCount, dev);
        if (hipFuncSetAttribute((const void*)fwd_mega, hipFuncAttributeMaxDynamicSharedMemorySize, LDS_BYTES) != hipSuccess) { fprintf(stderr, "kernel_launch: hipFuncSetAttribute failed\n"); grid = -1; return; }
        if (hipOccupancyMaxActiveBlocksPerMultiprocessor(&per_cu, (const void*)fwd_mega, NTHREADS, LDS_BYTES) != hipSuccess || per_cu < 1) { fprintf(stderr, "kernel_launch: occupancy query says %d\n", per_cu); per_cu = 1; }
        (void)hipGetLastError();
        grid = cus * 1;
        if (grid != 256) fprintf(stderr, "kernel_launch: note: grid %d\n", grid);
    }
    if (grid < 0) return;
    Params p{};
    p.x = (const float*)d_in[0]; p.c = (const float*)d_in[1]; p.w_in = (const float*)d_in[2]; p.pool_w = (const float*)d_in[3]; p.pool_scale = (const float*)d_in[4];
    p.sgu_ln_g = (const float*)d_in[5]; p.sgu_ln_b = (const float*)d_in[6]; p.sgu_w = (const float*)d_in[7]; p.sgu_b = (const float*)d_in[8]; p.w_out = (const float*)d_in[9];
    p.ada_w = (const float*)d_in[10]; p.ada_b = (const float*)d_in[11]; p.ln_g = (const float*)d_in[12]; p.ln_b = (const float*)d_in[13];
    p.out = (float*)d_out; p.ws = (unsigned char*)d_ws;
#if N_LAUNCH_PER_PHASE
    for (int ph = 0; ph < 10; ++ph) {
        p.ph_lo = ph; p.ph_hi = ph + 1;
        hipLaunchKernelGGL(fwd_mega, dim3(grid), dim3(NTHREADS), LDS_BYTES, stream, p);
    }
#else
    p.ph_lo = 0; p.ph_hi = 10;
    void* args[] = {&p};
    hipError_t e = hipLaunchCooperativeKernel((const void*)fwd_mega, dim3(grid), dim3(NTHREADS), args, LDS_BYTES, stream);
    if (e != hipSuccess) fprintf(stderr, "kernel_launch: cooperative launch failed: %s (grid %d)\n", hipGetErrorString(e), grid);
#endif
}
```

```cpp
#include <hip/hip_runtime.h>
#include <hip/hip_cooperative_groups.h>
#include <cstdio>
#include <cstdint>
namespace cg = cooperative_groups;
__device__ __forceinline__ int launder_v(int x) { asm volatile("" : "+v"(x)); return x; }
__device__ __forceinline__ int launder_s(int x) { asm volatile("" : "+s"(x)); return x; }
namespace pg8 {
#define PG8_LAS __attribute__((address_space(3)))
typedef unsigned short bf16_t;
typedef short bf16x8 __attribute__((ext_vector_type(8)));
typedef float f32x4 __attribute__((ext_vector_type(4)));
typedef unsigned u32x4 __attribute__((ext_vector_type(4)));
constexpr int BM = 256, BK = 64, HALF = 128, HTB = HALF * BK * 2  , STAGE_BYTES = 8 * HTB, NXCD = 8, WGM = 8;

__host__ __device__ __forceinline__ int lds_byte(int r, int c) { const int st = (r >> 4) * 2 + (c >> 5), rr = r & 15, cc = c & 31, ob = rr * 64 + cc * 2; return st * 1024 + (ob ^ (((ob >> 9) & 1) << 5)); }
__host__ __device__ __forceinline__ void stage_rc(int b, int& R, int& C) { const int st = b / 1024, sb = b % 1024, swz = sb ^ (((sb >> 9) & 1) << 5); R = (st >> 1) * 16 + swz / 64; C = (st & 1) * 32 + (swz % 64) / 2; }
__host__ __device__ __forceinline__ int perm32(int rho) { const int n = rho >> 4, i = rho & 15; return 8 * (i >> 2) + 4 * n + (i & 3); }

struct Unit { int pm, pn; };
struct Gemm { const bf16_t* A; const bf16_t* Bt; int M, N, K; };

struct StaticOrder {
    int nM, nN, nwg, G, c;
    __host__ __device__ void init(int M, int N, int G_, int c_) { nM = M / BM; nN = N / BM; nwg = nM * nN; G = G_; c = c_; }
    __host__ __device__ bool next(int i, Unit& u) const {
        const long L = (long)i * G + c; if (L >= nwg) return false;
        int wgid = (int)L; { const int q = nwg / NXCD, r = nwg % NXCD, xcd = wgid % NXCD, off = wgid / NXCD; wgid = (xcd < r ? xcd * (q + 1) : r * (q + 1) + (xcd - r) * q) + off; }
        const int nig = WGM * nN, gid = wgid / nig, fm = gid * WGM, gsz = (nM - fm) < WGM ? (nM - fm) : WGM;
        u.pm = fm + ((wgid % nig) % gsz); u.pn = (wgid % nig) / gsz; return true;
    }
    __device__ __forceinline__ void a_ready(const Unit&) const {}
    __device__ __forceinline__ void done(const Unit&) const {}
};

__device__ __forceinline__ unsigned cvt_pk_bf16(float lo, float hi) { unsigned r; asm volatile("v_cvt_pk_bf16_f32 %0, %1, %2" : "=v"(r) : "v"(lo), "v"(hi)); return r; }
template <class Epi, class Sched, bool ALIGN_EPI = false, bool SP2 = false>
__device__ __forceinline__ void gemm_phase(PG8_LAS unsigned char* lds, const Gemm g, const Sched& S, const Epi& E) {
    const int tid = launder_v(threadIdx.x), wid = __builtin_amdgcn_readfirstlane(tid >> 6), lane = tid & 63, wr = wid >> 2, wc = wid & 3, fr = lane & 15, fq = lane >> 4;
    const int K = g.K, nt = K / BK;
    unsigned voffA[2], voffB[2];
#pragma unroll
    for (int i = 0; i < 2; ++i) { int R, C; stage_rc(tid * 16 + i * 8192, R, C); const int Rb = Epi::PERM ? ((R & ~31) + perm32(R & 31)) : R;
        voffA[i] = (unsigned)(R * K + C) * 2u; voffB[i] = (unsigned)(Rb * K + C) * 2u; }
    const size_t kstep = (size_t)(BK * 2);
    const size_t hstep = (size_t)HALF * K * 2;
    const size_t tstep = 2 * hstep;
    const unsigned ldsw = (unsigned)wid * 1024u;
    const int aoff = lds_byte(wr * 64 + fr, fq * 8), boff = lds_byte(wc * 32 + fr, fq * 8);
#define PG8_SA(b, h) (((b) * 2 + (h)) * HTB)
#define PG8_SB(b, h) ((4 + (b) * 2 + (h)) * HTB)
#define PG8_STAGE(bufoff, gbase, voff) do { _Pragma("unroll") for (int _i = 0; _i < 2; ++_i) \
        __builtin_amdgcn_global_load_lds((const unsigned*)((const char*)(gbase) + (voff)[_i]), (PG8_LAS unsigned*)(lds + (bufoff) + ldsw + _i * 8192), 16, 0, 0); } while (0)
#define PG8_LDA(dst, b, h) do { _Pragma("unroll") for (int m = 0; m < 4; ++m) _Pragma("unroll") for (int k = 0; k < 2; ++k) dst[m][k] = *(const PG8_LAS bf16x8*)(lds + PG8_SA(b, h) + aoff + m * 2048 + k * 1024); } while (0)
#define PG8_LDB(dst, b, h) do { _Pragma("unroll") for (int n = 0; n < 2; ++n) _Pragma("unroll") for (int k = 0; k < 2; ++k) dst[n][k] = *(const PG8_LAS bf16x8*)(lds + PG8_SB(b, h) + boff + n * 2048 + k * 1024); } while (0)
#define PG8_MMA(ai, bj, At, Bt) do { __builtin_amdgcn_s_setprio(1); _Pragma("unroll") for (int m = 0; m < 4; ++m) _Pragma("unroll") for (int n = 0; n < 2; ++n) _Pragma("unroll") for (int k = 0; k < 2; ++k) \
        acc[ai][bj][m][n] = __builtin_amdgcn_mfma_f32_16x16x32_bf16(Bt[n][k], At[m][k], acc[ai][bj][m][n], 0, 0, 0); __builtin_amdgcn_s_setprio(0); } while (0)
#define PG8_WAIT_V(n) asm volatile("s_waitcnt vmcnt(" #n ")" ::: "memory")
#define PG8_WAIT_L(n) asm volatile("s_waitcnt lgkmcnt(" #n ")" ::: "memory")
#define PG8_BAR __builtin_amdgcn_s_barrier()
#define PG8_SCHED __builtin_amdgcn_sched_barrier(0)
    Unit cur, nxt; int ui = 0;
    if (!S.next(0, cur)) return;
    f32x4 acc[2][2][4][2];
#pragma unroll
    for (int a = 0; a < 2; ++a)
#pragma unroll
        for (int b = 0; b < 2; ++b)
#pragma unroll
            for (int m = 0; m < 4; ++m)
#pragma unroll
                for (int n = 0; n < 2; ++n) acc[a][b][m][n] = (f32x4){0.f, 0.f, 0.f, 0.f};
    bf16x8 At[4][2], B0[2][2], B1[2][2];
    const char* cA = (const char*)g.A + (size_t)cur.pm * tstep; const char* cB = (const char*)g.Bt + (size_t)cur.pn * tstep;
    S.a_ready(cur);
    if constexpr (SP2) {
        PG8_STAGE(PG8_SB(0, 0), cB, voffB); PG8_STAGE(PG8_SB(0, 1), cB + hstep, voffB); PG8_STAGE(PG8_SA(0, 0), cA, voffA); PG8_STAGE(PG8_SA(0, 1), cA + hstep, voffA);
        if (wr == 1) PG8_BAR;
        PG8_WAIT_V(2); PG8_BAR;
        PG8_STAGE(PG8_SB(1, 0), cB + kstep, voffB); PG8_STAGE(PG8_SA(1, 0), cA + kstep, voffA); PG8_STAGE(PG8_SB(1, 1), cB + hstep + kstep, voffB);
        PG8_WAIT_V(6); PG8_BAR;
    } else {
        PG8_STAGE(PG8_SB(0, 0), cB, voffB); PG8_STAGE(PG8_SA(0, 0), cA, voffA); PG8_STAGE(PG8_SB(0, 1), cB + hstep, voffB); PG8_STAGE(PG8_SA(0, 1), cA + hstep, voffA);
        if (wr == 1) PG8_BAR;
        PG8_WAIT_V(4); PG8_BAR;
        PG8_STAGE(PG8_SB(1, 0), cB + kstep, voffB); PG8_STAGE(PG8_SA(1, 0), cA + kstep, voffA); PG8_STAGE(PG8_SB(1, 1), cB + hstep + kstep, voffB);
        PG8_WAIT_V(6); PG8_BAR;
    }
    for (;;) {
        const bool has_next = S.next(ui + 1, nxt);
        const char* nA = has_next ? (const char*)g.A + (size_t)nxt.pm * tstep : cA; const char* nB = has_next ? (const char*)g.Bt + (size_t)nxt.pn * tstep : cB;
        for (int t = 0; t < nt; t += 2) {
            const bool last = (t == nt - 2);
            const char* a1 = cA + (size_t)(t + 1) * kstep;
            const char* a2 = last ? nA : cA + (size_t)(t + 2) * kstep; const char* b2 = last ? nB : cB + (size_t)(t + 2) * kstep;
            const char* a3 = a2 + kstep; const char* b3 = b2 + kstep;
            if (last && has_next) S.a_ready(nxt);
            if constexpr (SP2) {
            PG8_LDB(B0, 0, 0); PG8_LDB(B1, 0, 1); PG8_SCHED; PG8_LDA(At, 0, 0); PG8_STAGE(PG8_SA(1, 1), a1 + hstep, voffA);
            PG8_WAIT_V(8); PG8_WAIT_L(0); PG8_BAR; PG8_MMA(0, 0, At, B0); PG8_MMA(0, 1, At, B1); PG8_BAR; PG8_SCHED;
            PG8_LDA(At, 0, 1); PG8_STAGE(PG8_SB(0, 0), b2, voffB); PG8_STAGE(PG8_SB(0, 1), b2 + hstep, voffB); PG8_STAGE(PG8_SA(0, 0), a2, voffA);
            PG8_WAIT_V(8); PG8_WAIT_L(0); PG8_BAR; PG8_MMA(1, 0, At, B0); PG8_MMA(1, 1, At, B1); PG8_BAR; PG8_SCHED;
            PG8_LDB(B0, 1, 0); PG8_LDB(B1, 1, 1); PG8_SCHED; PG8_LDA(At, 1, 0); PG8_STAGE(PG8_SA(0, 1), a2 + hstep, voffA);
            PG8_WAIT_V(8); PG8_WAIT_L(0); PG8_BAR; PG8_MMA(0, 0, At, B0); PG8_MMA(0, 1, At, B1); PG8_BAR; PG8_SCHED;
            PG8_LDA(At, 1, 1); PG8_STAGE(PG8_SB(1, 0), b3, voffB); PG8_STAGE(PG8_SB(1, 1), b3 + hstep, voffB); PG8_STAGE(PG8_SA(1, 0), a3, voffA);
            PG8_WAIT_V(8); PG8_WAIT_L(0); PG8_BAR; PG8_MMA(1, 0, At, B0); PG8_MMA(1, 1, At, B1); PG8_BAR; PG8_SCHED;
            } else {
            PG8_LDB(B0, 0, 0); PG8_SCHED; PG8_LDA(At, 0, 0); PG8_STAGE(PG8_SA(1, 1), a1 + hstep, voffA);
            PG8_WAIT_L(8); PG8_BAR; PG8_WAIT_L(0); PG8_MMA(0, 0, At, B0); PG8_BAR; PG8_SCHED;
            PG8_LDB(B1, 0, 1); PG8_STAGE(PG8_SB(0, 0), b2, voffB);
            PG8_BAR; PG8_WAIT_L(0); PG8_MMA(0, 1, At, B1); PG8_BAR;
            PG8_LDA(At, 0, 1); PG8_STAGE(PG8_SA(0, 0), a2, voffA);
            PG8_BAR; PG8_WAIT_L(0); PG8_MMA(1, 0, At, B0); PG8_BAR; PG8_SCHED;
            PG8_STAGE(PG8_SB(0, 1), b2 + hstep, voffB);
            PG8_WAIT_V(6); PG8_BAR; PG8_MMA(1, 1, At, B1); PG8_BAR;
            PG8_LDB(B0, 1, 0); PG8_SCHED; PG8_LDA(At, 1, 0); PG8_STAGE(PG8_SA(0, 1), a2 + hstep, voffA);
            PG8_WAIT_L(8); PG8_BAR; PG8_WAIT_L(0); PG8_MMA(0, 0, At, B0); PG8_BAR; PG8_SCHED;
            PG8_LDB(B1, 1, 1); PG8_STAGE(PG8_SB(1, 0), b3, voffB);
            PG8_BAR; PG8_WAIT_L(0); PG8_MMA(0, 1, At, B1); PG8_BAR;
            PG8_LDA(At, 1, 1); PG8_STAGE(PG8_SA(1, 0), a3, voffA);
            PG8_BAR; PG8_WAIT_L(0); PG8_MMA(1, 0, At, B0); PG8_BAR; PG8_SCHED;
            PG8_STAGE(PG8_SB(1, 1), b3 + hstep, voffB);
            PG8_WAIT_V(6); PG8_BAR; PG8_MMA(1, 1, At, B1); PG8_BAR;
            }
        }
        if constexpr (ALIGN_EPI) { if (wr == 0) PG8_BAR; }
        if constexpr (!Epi::AFTER_DRAIN) { E(acc, cur, wr, wc, fr, fq); S.done(cur); }
        if (!has_next) break;
#pragma unroll
        for (int a = 0; a < 2; ++a)
#pragma unroll
            for (int b = 0; b < 2; ++b)
#pragma unroll
                for (int m = 0; m < 4; ++m)
#pragma unroll
                    for (int n = 0; n < 2; ++n) acc[a][b][m][n] = (f32x4){0.f, 0.f, 0.f, 0.f};
        cur = nxt; cA = nA; cB = nB; ++ui;
        if constexpr (ALIGN_EPI) { if (wr == 1) PG8_BAR; }
    }
    PG8_WAIT_V(0);
    if constexpr (!ALIGN_EPI) { if (wr == 0) PG8_BAR; }
    PG8_BAR;
    if constexpr (Epi::AFTER_DRAIN) { E.fused(acc, cur, wr, wc, fr, fq, lds, wid, lane); S.done(cur); }
#undef PG8_SA
#undef PG8_SB
#undef PG8_STAGE
#undef PG8_LDA
#undef PG8_LDB
#undef PG8_MMA
#undef PG8_WAIT_V
#undef PG8_WAIT_L
#undef PG8_BAR
#undef PG8_SCHED
}
}

#define DI __device__ __forceinline__
#define LAS __attribute__((address_space(3)))
typedef unsigned short bf16_t;
typedef short bf16x8 __attribute__((ext_vector_type(8)));
typedef float f32x4 __attribute__((ext_vector_type(4)));
typedef float f32x16 __attribute__((ext_vector_type(16)));
typedef unsigned u32x4 __attribute__((ext_vector_type(4)));
typedef unsigned u32x2 __attribute__((ext_vector_type(2)));
typedef __bf16 bf16x2_t __attribute__((ext_vector_type(2)));
typedef float f32x2_t __attribute__((ext_vector_type(2)));

constexpr int D = 1024, BATCH = 32, SEQ = 2048, MTOK = BATCH * SEQ, NIN = 3328, DEPTH = 2;
constexpr int C_A = 0, C_GA = 256, C_U = 512, C_VS = 768, C_GB = 1024, C_Q = 1280, C_K = 1792, C_V = 2304, C_GC = 2816;
constexpr float DN_ALPHA = 1.41421356237309515f;
constexpr float LN_EPS = 1e-5f;
constexpr float LOG2E = 1.44269504088896341f;

constexpr size_t WS_WIN = 0;
constexpr size_t WS_WOUT = WS_WIN + (size_t)DEPTH * NIN * D * 2;
constexpr size_t WS_MOD = WS_WOUT + (size_t)DEPTH * D * D * 2;
constexpr size_t WS_HB = WS_MOD + (size_t)DEPTH * BATCH * 3 * D * 4;
constexpr size_t WS_P = WS_HB + (size_t)MTOK * D * 2;
constexpr size_t WS_Y = WS_P + (size_t)MTOK * NIN * 2;
constexpr size_t WS_R0 = WS_Y + (size_t)MTOK * D * 2;
constexpr size_t WS_R1 = WS_R0 + (size_t)MTOK * D * 2;
constexpr size_t WS_PSTAT = WS_R1 + (size_t)MTOK * D * 2;
constexpr size_t WS_RSTAT = WS_PSTAT + (size_t)MTOK * 16 * 2 * 4;
constexpr size_t WS_SGW = WS_RSTAT + (size_t)MTOK * 2 * 4;
constexpr size_t WS_END = WS_SGW + (size_t)DEPTH * 4 * 128 * 128 * 2;

constexpr int LDS_BYTES = 139264;
constexpr int NTHREADS = 512, NWAVES = 8;
#ifndef DUP
#define DUP 0
#endif

struct Params {
    const float *x, *c, *w_in, *pool_w, *pool_scale, *sgu_ln_g, *sgu_ln_b, *sgu_w, *sgu_b, *w_out, *ada_w, *ada_b, *ln_g, *ln_b;
    float* out; unsigned char* ws;
    int ph_lo, ph_hi;
};

DI unsigned pk2(float lo, float hi) { f32x2_t v = {lo, hi}; bf16x2_t b = __builtin_convertvector(v, bf16x2_t); return __builtin_bit_cast(unsigned, b); }
DI float bf2f(unsigned short u) { return __builtin_bit_cast(float, (unsigned)u << 16); }
DI float bflo(unsigned u) { return __builtin_bit_cast(float, u << 16); }
DI float bfhi(unsigned u) { return __builtin_bit_cast(float, u & 0xffff0000u); }
DI float silu_f(float v) { return v * __builtin_amdgcn_rcpf(1.f + __builtin_amdgcn_exp2f(-v * LOG2E)); }
DI float wave_sum(float v) {
#pragma unroll
    for (int o = 1; o < 64; o <<= 1) v += __shfl_xor(v, o);
    return v;
}
DI float swap32(float v, int hh) {
    const unsigned u = __builtin_bit_cast(unsigned, v);
    const auto rr = __builtin_amdgcn_permlane32_swap(u, u, false, false);
    return __builtin_bit_cast(float, hh ? rr[0] : rr[1]);
}
DI int crow(int i, int hh) { return (i & 3) + 8 * (i >> 2) + 4 * hh; }
#define MFMA32(a, b, c) __builtin_amdgcn_mfma_f32_32x32x16_bf16((a), (b), (c), 0, 0, 0)
#define LDS_WAIT() asm volatile("s_waitcnt lgkmcnt(0)" ::: "memory")

struct EpiP {
    static constexpr bool PERM = true, AFTER_DRAIN = false;
    bf16_t* O;
    DI void operator()(const pg8::f32x4 (&acc)[2][2][4][2], const pg8::Unit& u, int wr, int wc, int fr, int fq) const {
        const int row0 = u.pm * 256 + wr * 64 + fr, col0 = u.pn * 256 + wc * 32 + 8 * fq;
#pragma unroll
        for (int ai = 0; ai < 2; ++ai)
#pragma unroll
            for (int m = 0; m < 4; ++m) {
                bf16_t* rowp = O + (size_t)(row0 + ai * 128 + m * 16) * NIN + col0;
#pragma unroll
                for (int bj = 0; bj < 2; ++bj) {
                    const pg8::f32x4 v0 = acc[ai][bj][m][0], v1 = acc[ai][bj][m][1];
                    u32x4 w; w.x = pk2(v0[0], v0[1]); w.y = pk2(v0[2], v0[3]); w.z = pk2(v1[0], v1[1]); w.w = pk2(v1[2], v1[3]);
                    *(u32x4*)(rowp + bj * 128) = w;
                }
            }
    }
};
struct EpiRes {
    static constexpr bool PERM = true, AFTER_DRAIN = false;
    const float* xsrc;
    const bf16_t* rsrc;
    const float* rstat;
    const float* lng; const float* lnb;
    const float* gate;
    bf16_t* R; float* pstat;
    DI void operator()(const pg8::f32x4 (&acc)[2][2][4][2], const pg8::Unit& u, int wr, int wc, int fr, int fq) const {
        const int row0 = u.pm * 256 + wr * 64 + fr, col0 = u.pn * 256 + wc * 32 + 8 * fq;
        const int b = (u.pm * 256) >> 11;
        f32x4 ga[2][2];
#pragma unroll
        for (int bj = 0; bj < 2; ++bj)
#pragma unroll
            for (int n = 0; n < 2; ++n) ga[bj][n] = *(const f32x4*)(gate + (size_t)b * 3072 + col0 + bj * 128 + 4 * n);
#pragma unroll
        for (int ai = 0; ai < 2; ++ai)
#pragma unroll
            for (int m = 0; m < 4; ++m) {
                const int row = row0 + ai * 128 + m * 16;
                float mean = 0.f, rstd = 1.f;
                if (rsrc) { const f32x2_t st = *(const f32x2_t*)(rstat + (size_t)row * 2); mean = st.x; rstd = st.y; }
                float s = 0.f, ss = 0.f;
#pragma unroll
                for (int bj = 0; bj < 2; ++bj) {
                    const int col = col0 + bj * 128;
                    f32x4 x0, x1;
                    if (rsrc) {
                        const u32x4 rv = *(const u32x4*)(rsrc + (size_t)row * D + col);
                        x0 = (f32x4){bflo(rv.x), bfhi(rv.x), bflo(rv.y), bfhi(rv.y)}; x1 = (f32x4){bflo(rv.z), bfhi(rv.z), bflo(rv.w), bfhi(rv.w)};
                        x0 = (x0 - mean) * rstd * *(const f32x4*)(lng + col) + *(const f32x4*)(lnb + col);
                        x1 = (x1 - mean) * rstd * *(const f32x4*)(lng + col + 4) + *(const f32x4*)(lnb + col + 4);
                    } else { x0 = *(const f32x4*)(xsrc + (size_t)row * D + col); x1 = *(const f32x4*)(xsrc + (size_t)row * D + col + 4); }
                    const f32x4 v0 = x0 * DN_ALPHA + ga[bj][0] * acc[ai][bj][m][0], v1 = x1 * DN_ALPHA + ga[bj][1] * acc[ai][bj][m][1];
                    u32x4 w; w.x = pk2(v0[0], v0[1]); w.y = pk2(v0[2], v0[3]); w.z = pk2(v1[0], v1[1]); w.w = pk2(v1[2], v1[3]);
                    *(u32x4*)(R + (size_t)row * D + col) = w;
                    const float r0 = bflo(w.x), r1 = bfhi(w.x), r2 = bflo(w.y), r3 = bfhi(w.y), r4 = bflo(w.z), r5 = bfhi(w.z), r6 = bflo(w.w), r7 = bfhi(w.w);
                    s += ((r0 + r1) + (r2 + r3)) + ((r4 + r5) + (r6 + r7));
                    ss += ((r0 * r0 + r1 * r1) + (r2 * r2 + r3 * r3)) + ((r4 * r4 + r5 * r5) + (r6 * r6 + r7 * r7));
                }
                s += __shfl_xor(s, 16); ss += __shfl_xor(ss, 16);
                s += __shfl_xor(s, 32); ss += __shfl_xor(ss, 32);
                if (fq == 0) { f32x2_t o = {s, ss}; *(f32x2_t*)(pstat + ((size_t)row * 16 + u.pn * 4 + wc) * 2) = o; }
            }
    }
};

DI void transpose_item(const float* W, int K, int N, bf16_t* WT, LAS float* scr, int item, int lane) {
    const int nblk = N / 32, kb = item / nblk, nb = item % nblk, k0 = 64 * kb, n0 = 32 * nb;
#pragma unroll 8
    for (int i = 0; i < 32; ++i) { const int kk = 2 * i + (lane >> 5); scr[kk * 33 + (lane & 31)] = W[(size_t)(k0 + kk) * N + n0 + (lane & 31)]; }
    LDS_WAIT();
    const int c = lane & 7;
#pragma unroll
    for (int j = 0; j < 4; ++j) {
        const int n = (lane >> 3) + 8 * j; const LAS float* s = scr + (8 * c) * 33 + n;
        u32x4 o; o.x = pk2(s[0 * 33], s[1 * 33]); o.y = pk2(s[2 * 33], s[3 * 33]); o.z = pk2(s[4 * 33], s[5 * 33]); o.w = pk2(s[6 * 33], s[7 * 33]);
        *(u32x4*)(WT + (size_t)(n0 + n) * K + k0 + 8 * c) = o;
    }
    LDS_WAIT();
}

DI void phase0(const Params& P, LAS unsigned char* lds, int tid, int lane, int wave) {
    tid = launder_v(tid); lane = launder_v(lane); wave = launder_s(wave);
    bf16_t* win_t = (bf16_t*)(P.ws + WS_WIN); bf16_t* wout_t = (bf16_t*)(P.ws + WS_WOUT); float* mod = (float*)(P.ws + WS_MOD);
    for (int i = blockIdx.x * NTHREADS + tid; i < DEPTH * 4 * 128 * 128 / 8; i += gridDim.x * NTHREADS) {
        const f32x4 w0 = *(const f32x4*)(P.sgu_w + (size_t)i * 8), w1 = *(const f32x4*)(P.sgu_w + (size_t)i * 8 + 4);
        u32x4 o; o.x = pk2(w0[0], w0[1]); o.y = pk2(w0[2], w0[3]); o.z = pk2(w1[0], w1[1]); o.w = pk2(w1[2], w1[3]);
        *(u32x4*)(P.ws + WS_SGW + (size_t)i * 16) = o;
    }
    {
        LAS float* scr = (LAS float*)(lds + wave * 16384);
        const int gw = blockIdx.x * NWAVES + wave, NGW = gridDim.x * NWAVES;
        constexpr int I_IN = (D / 64) * (NIN / 32), I_OUT = (D / 64) * (D / 32);
        for (int it = gw; it < DEPTH * (I_IN + I_OUT); it += NGW) {
            const int l = it / (I_IN + I_OUT); int r = it % (I_IN + I_OUT);
            if (r < I_IN) transpose_item(P.w_in + (size_t)l * D * NIN, D, NIN, win_t + (size_t)l * NIN * D, scr, r, lane);
            else transpose_item(P.w_out + (size_t)l * D * D, D, D, wout_t + (size_t)l * D * D, scr, r - I_IN, lane);
        }
    }
    __syncthreads();
    LAS float* sc = (LAS float*)lds;
    for (int item = blockIdx.x; item < DEPTH * 96; item += gridDim.x) {
        const int l = item / 96, j0 = (item % 96) * 32;
        for (int e = tid; e < BATCH * D; e += NTHREADS) { const int b = e >> 10, k = e & 1023; sc[k * 32 + b] = silu_f(P.c[e]); }
        __syncthreads();
        const int j = tid & 31, ks = tid >> 5;
        float acc[32];
#pragma unroll
        for (int b = 0; b < 32; ++b) acc[b] = 0.f;
        const float* wp = P.ada_w + ((size_t)l * D + ks * 64) * 3072 + j0 + j;
#pragma unroll 2
        for (int kk = 0; kk < 64; ++kk) {
            const float w = wp[(size_t)kk * 3072];
            const LAS f32x4* s4 = (const LAS f32x4*)(sc + (ks * 64 + kk) * 32);
#pragma unroll
            for (int q = 0; q < 8; ++q) { const f32x4 v = s4[q]; acc[4 * q] += v[0] * w; acc[4 * q + 1] += v[1] * w; acc[4 * q + 2] += v[2] * w; acc[4 * q + 3] += v[3] * w; }
        }
        __syncthreads();
        LAS float* red = (LAS float*)lds;
#pragma unroll
        for (int b = 0; b < 32; ++b) red[(ks * 32 + b) * 32 + j] = acc[b];
        __syncthreads();
#pragma unroll
        for (int o2 = 0; o2 < 2; ++o2) {
            const int o = tid + o2 * NTHREADS, b = o >> 5, jj = o & 31;
            float s = P.ada_b[l * 3072 + j0 + jj];
#pragma unroll
            for (int q = 0; q < 16; ++q) s += red[(q * 32 + b) * 32 + jj];
            mod[((size_t)l * BATCH + b) * 3072 + j0 + jj] = s;
        }
        __syncthreads();
    }
}

template <int MODE>
DI void row_pass(const Params& P, int lane, int wave) {
    lane = launder_v(lane); wave = launder_s(wave);
    const int gw = blockIdx.x * NWAVES + wave, NGW = gridDim.x * NWAVES;
    const float* mod = (const float*)(P.ws + WS_MOD) + (MODE == 1 ? (size_t)BATCH * 3072 : 0);
    const float* pstat = (const float*)(P.ws + WS_PSTAT);
    float* rstat = (float*)(P.ws + WS_RSTAT);
    bf16_t* hb = (bf16_t*)(P.ws + WS_HB);
    const bf16_t* rsrc = (const bf16_t*)(P.ws + (MODE == 1 ? WS_R0 : WS_R1));
    const float* lg = P.ln_g + (MODE == 2 ? D : 0); const float* lb = P.ln_b + (MODE == 2 ? D : 0);
    constexpr int RU = 4;
    for (int row0 = gw * RU; row0 < MTOK; row0 += NGW * RU) {
        f32x4 v[RU][2][2];
        if (MODE == 0) {
#pragma unroll
            for (int u = 0; u < RU; ++u)
#pragma unroll
                for (int j = 0; j < 2; ++j) { const float* xp = P.x + (size_t)(row0 + u) * D + 8 * lane + 512 * j; v[u][j][0] = *(const f32x4*)xp; v[u][j][1] = *(const f32x4*)(xp + 4); }
        } else {
            u32x4 raw[RU][2];
#pragma unroll
            for (int u = 0; u < RU; ++u)
#pragma unroll
                for (int j = 0; j < 2; ++j) raw[u][j] = *(const u32x4*)(rsrc + (size_t)(row0 + u) * D + 8 * lane + 512 * j);
#pragma unroll
            for (int u = 0; u < RU; ++u)
#pragma unroll
                for (int j = 0; j < 2; ++j) {
                    v[u][j][0] = (f32x4){bflo(raw[u][j].x), bfhi(raw[u][j].x), bflo(raw[u][j].y), bfhi(raw[u][j].y)};
                    v[u][j][1] = (f32x4){bflo(raw[u][j].z), bfhi(raw[u][j].z), bflo(raw[u][j].w), bfhi(raw[u][j].w)};
                }
        }
        float mean[RU], rstd[RU];
#pragma unroll
        for (int u = 0; u < RU; ++u) { mean[u] = 0.f; rstd[u] = 1.f; }
        if (MODE != 0) {
            const f32x2_t st = *(const f32x2_t*)(pstat + ((size_t)(row0 + (lane >> 4)) * 16 + (lane & 15)) * 2);
            float s = st.x, ss = st.y;
#pragma unroll
            for (int o = 1; o < 16; o <<= 1) { s += __shfl_xor(s, o); ss += __shfl_xor(ss, o); }
            const float m = s * (1.f / D); const float var = fmaxf(ss * (1.f / D) - m * m, 0.f); const float rs = 1.f / sqrtf(var + LN_EPS);
            if (MODE == 1 && (lane & 15) == 0) { f32x2_t o = {m, rs}; *(f32x2_t*)(rstat + (size_t)(row0 + (lane >> 4)) * 2) = o; }
#pragma unroll
            for (int u = 0; u < RU; ++u) { mean[u] = __shfl(m, 16 * u); rstd[u] = __shfl(rs, 16 * u); }
        }
        const int b = row0 >> 11;
#pragma unroll
        for (int j = 0; j < 2; ++j)
#pragma unroll
            for (int q = 0; q < 2; ++q) {
                const int col = 8 * lane + 512 * j + 4 * q;
                f32x4 g = {1.f, 1.f, 1.f, 1.f}, bb = {0.f, 0.f, 0.f, 0.f}, sh = bb, scl = bb;
                if (MODE != 0) { g = *(const f32x4*)(lg + col); bb = *(const f32x4*)(lb + col); }
                if (MODE != 2) { sh = *(const f32x4*)(mod + (size_t)b * 3072 + col); scl = *(const f32x4*)(mod + (size_t)b * 3072 + 1024 + col); }
#pragma unroll
                for (int u = 0; u < RU; ++u) {
                    f32x4 w = v[u][j][q];
                    if (MODE != 0) w = (w - mean[u]) * rstd[u] * g + bb;
                    if (MODE == 2) *(f32x4*)(P.out + (size_t)(row0 + u) * D + col) = w;
                    else v[u][j][q] = w * (scl + 1.f) + sh;
                }
            }
        if (MODE != 2) {
#pragma unroll
            for (int u = 0; u < RU; ++u)
#pragma unroll
                for (int j = 0; j < 2; ++j) {
                    const f32x4 a = v[u][j][0], c = v[u][j][1];
                    u32x4 o; o.x = pk2(a[0], a[1]); o.y = pk2(a[2], a[3]); o.z = pk2(c[0], c[1]); o.w = pk2(c[2], c[3]);
                    *(u32x4*)(hb + (size_t)(row0 + u) * D + 8 * lane + 512 * j) = o;
                }
        }
    }
}

constexpr int VT_PITCH = 272;
constexpr int SG_OST = 36;
DI int vt_off(int ch) { return ch * VT_PITCH + (ch >> 6) * 32; }
DI void sgu_unit(const Params& P, int l, int unit, LAS unsigned char* lds, int tid, int lane, int wave) {
    const bf16_t* p = (const bf16_t*)(P.ws + WS_P); bf16_t* Y = (bf16_t*)(P.ws + WS_Y);
    const int tok0 = unit * 128;
    {
        const int s = tid >> 2, qd = tid & 3;
        const bf16_t* vp = p + (size_t)(tok0 + s) * NIN + C_VS + qd * 64;
        u32x4 raw[8];
#pragma unroll
        for (int c = 0; c < 8; ++c) raw[c] = *(const u32x4*)(vp + 8 * c);
        float sm = 0.f, sq = 0.f;
#pragma unroll
        for (int c = 0; c < 8; ++c) {
            const float a0 = bflo(raw[c].x), a1 = bfhi(raw[c].x), a2 = bflo(raw[c].y), a3 = bfhi(raw[c].y), a4 = bflo(raw[c].z), a5 = bfhi(raw[c].z), a6 = bflo(raw[c].w), a7 = bfhi(raw[c].w);
            sm += ((a0 + a1) + (a2 + a3)) + ((a4 + a5) + (a6 + a7));
            sq += ((a0 * a0 + a1 * a1) + (a2 * a2 + a3 * a3)) + ((a4 * a4 + a5 * a5) + (a6 * a6 + a7 * a7));
        }
        sm += __shfl_xor(sm, 1); sq += __shfl_xor(sq, 1);
        sm += __shfl_xor(sm, 2); sq += __shfl_xor(sq, 2);
        const float mean = sm * (1.f / 256.f);
        const float var = fmaxf(sq * (1.f / 256.f) - mean * mean, 0.f);
        const float rstd = 1.f / sqrtf(var + LN_EPS);
        const float* gp = P.sgu_ln_g + l * 256 + qd * 64; const float* bp = P.sgu_ln_b + l * 256 + qd * 64;
        LAS bf16_t* vt = (LAS bf16_t*)(lds + vt_off(qd * 64) + s * 2);
#pragma unroll
        for (int c = 0; c < 8; ++c) {
            const f32x4 g0 = *(const f32x4*)(gp + 8 * c), g1 = *(const f32x4*)(gp + 8 * c + 4), b0 = *(const f32x4*)(bp + 8 * c), b1 = *(const f32x4*)(bp + 8 * c + 4);
            const float a[8] = {bflo(raw[c].x), bfhi(raw[c].x), bflo(raw[c].y), bfhi(raw[c].y), bflo(raw[c].z), bfhi(raw[c].z), bflo(raw[c].w), bfhi(raw[c].w)};
#pragma unroll
            for (int e = 0; e < 8; ++e) {
                const float gg = e < 4 ? g0[e & 3] : g1[e & 3], bb = e < 4 ? b0[e & 3] : b1[e & 3];
                vt[(8 * c + e) * (VT_PITCH / 2)] = (bf16_t)(pk2((a[e] - mean) * rstd * gg + bb, 0.f) & 0xffffu);
            }
        }
    }
    const int h = wave & 3, dblk = wave >> 2, r = lane & 31, hh = lane >> 5;
    const int ch = h * 64 + 32 * dblk + r;
    const bf16_t* wb = (const bf16_t*)(P.ws + WS_SGW) + ((size_t)(l * 4 + h) * 128 + r) * 128 + 8 * hh;
    bf16x8 af[24];
#pragma unroll
    for (int ks = 0; ks < 4; ++ks)
#pragma unroll
        for (int tb = 0; tb < 4; ++tb) af[ks * 4 + tb] = *(const bf16x8*)(wb + (size_t)(32 * tb) * 128 + 16 * ks);
#pragma unroll
    for (int ks = 4; ks < 8; ++ks)
#pragma unroll
        for (int tb = 2; tb < 4; ++tb) af[16 + (ks - 4) * 2 + (tb - 2)] = *(const bf16x8*)(wb + (size_t)(32 * tb) * 128 + 16 * ks);
    __syncthreads();
    f32x16 acc[4];
#pragma unroll
    for (int tb = 0; tb < 4; ++tb)
#pragma unroll
        for (int i = 0; i < 16; ++i) acc[tb][i] = 0.f;
#pragma unroll
    for (int ks = 0; ks < 8; ++ks) {
        const bf16x8 bfrag = *(const LAS bf16x8*)(lds + vt_off(ch) + (16 * ks + 8 * hh) * 2);
#pragma unroll
        for (int tb = (ks < 4 ? 0 : 2); tb < 4; ++tb)
            acc[tb] = MFMA32(ks < 4 ? af[ks * 4 + tb] : af[16 + (ks - 4) * 2 + (tb - 2)], bfrag, acc[tb]);
    }
    const int erow = lane >> 2, edc = lane & 3;
    const size_t ecol = (size_t)h * 64 + 32 * dblk + edc * 8;
    u32x4 uu[8], gg[8];
#pragma unroll
    for (int k = 0; k < 8; ++k) {
        const size_t tok = (size_t)(tok0 + erow + 16 * k);
        uu[k] = *(const u32x4*)(p + tok * NIN + C_U + ecol); gg[k] = *(const u32x4*)(p + tok * NIN + C_GB + ecol);
    }
    __syncthreads();
    LAS float* ost = (LAS float*)(lds + wave * (64 * SG_OST * 4));
    const float* sb = P.sgu_b + (l * 4 + h) * 128;
#pragma unroll
    for (int half = 0; half < 2; ++half) {
#pragma unroll
        for (int tb2 = 0; tb2 < 2; ++tb2)
#pragma unroll
            for (int i = 0; i < 16; ++i) ost[(32 * tb2 + crow(i, hh)) * SG_OST + r] = acc[2 * half + tb2][i];
#pragma unroll
        for (int it = 0; it < 4; ++it) {
            const int k = 4 * half + it, t = erow + 16 * k;
            const LAS float* op = ost + (erow + 16 * it) * SG_OST + edc * 8;
            const f32x4 a = *(const LAS f32x4*)op, b = *(const LAS f32x4*)(op + 4);
            const float bias = sb[t];
            const u32x4 u = uu[k], g = gg[k];
            u32x4 w;
            w.x = pk2(bflo(u.x) * (a[0] + bias) * silu_f(bflo(g.x)), bfhi(u.x) * (a[1] + bias) * silu_f(bfhi(g.x)));
            w.y = pk2(bflo(u.y) * (a[2] + bias) * silu_f(bflo(g.y)), bfhi(u.y) * (a[3] + bias) * silu_f(bfhi(g.y)));
            w.z = pk2(bflo(u.z) * (b[0] + bias) * silu_f(bflo(g.z)), bfhi(u.z) * (b[1] + bias) * silu_f(bfhi(g.z)));
            w.w = pk2(bflo(u.w) * (b[2] + bias) * silu_f(bflo(g.w)), bfhi(u.w) * (b[3] + bias) * silu_f(bfhi(g.w)));
            *(u32x4*)(Y + (size_t)(tok0 + t) * D + 256 + ecol) = w;
        }
    }
    __syncthreads();
}

typedef short v4i16_t __attribute__((ext_vector_type(4)));
DI v4i16_t lds_tr16(const LAS unsigned char* p) { return __builtin_amdgcn_ds_read_tr16_b64_v4i16((LAS v4i16_t*)p); }
constexpr int OST_PITCH = 68;
DI void tile_epilogue(const f32x16& o0, const f32x16& o1, LAS float* ost, int lane, const bf16_t* grow  , bf16_t* yrow, const float* colscale) {
    const int r = lane & 31, hh = lane >> 5;
#pragma unroll
    for (int i = 0; i < 16; ++i) { ost[crow(i, hh) * OST_PITCH + r] = o0[i]; ost[crow(i, hh) * OST_PITCH + 32 + r] = o1[i]; }
#pragma unroll
    for (int it = 0; it < 4; ++it) {
        const int c = lane + 64 * it, q = c >> 3, dc = c & 7;
        const u32x4 g = *(const u32x4*)(grow + (size_t)q * NIN + dc * 8);
        const f32x4 a = *(const LAS f32x4*)(ost + q * OST_PITCH + dc * 8), b = *(const LAS f32x4*)(ost + q * OST_PITCH + dc * 8 + 4);
        f32x4 s0 = {1.f, 1.f, 1.f, 1.f}, s1 = s0;
        if (colscale) { s0 = *(const f32x4*)(colscale + dc * 8); s1 = *(const f32x4*)(colscale + dc * 8 + 4); }
        u32x4 w;
        w.x = pk2(a[0] * s0[0] * silu_f(bflo(g.x)), a[1] * s0[1] * silu_f(bfhi(g.x)));
        w.y = pk2(a[2] * s0[2] * silu_f(bflo(g.y)), a[3] * s0[3] * silu_f(bfhi(g.y)));
        w.z = pk2(b[0] * s1[0] * silu_f(bflo(g.z)), b[1] * s1[1] * silu_f(bfhi(g.z)));
        w.w = pk2(b[2] * s1[2] * silu_f(bflo(g.w)), b[3] * s1[3] * silu_f(bfhi(g.w)));
        *(u32x4*)(yrow + (size_t)q * D + dc * 8) = w;
    }
}

constexpr int PA_PITCH = 144;
DI void pool_wave(const Params& P, int l, int gw, int NGW, int lane, LAS unsigned char* wl) {
    const bf16_t* p = (const bf16_t*)(P.ws + WS_P); bf16_t* Y = (bf16_t*)(P.ws + WS_Y);
    const int g = gw & 3, r = lane & 31, hh = lane >> 5;
    const int win = 2 << g;
    LAS float* ost = (LAS float*)(wl + 7168);
    bf16x8 bw[4][2];
#pragma unroll
    for (int s = 0; s < 4; ++s)
#pragma unroll
        for (int db = 0; db < 2; ++db) {
            const float* wp = P.pool_w + ((size_t)(l * 4 + g) * 64 + 16 * s + 8 * hh) * 64 + 32 * db + r;
            u32x4 a; a.x = pk2(wp[0], wp[64]); a.y = pk2(wp[128], wp[192]); a.z = pk2(wp[256], wp[320]); a.w = pk2(wp[384], wp[448]);
            bw[s][db] = __builtin_bit_cast(bf16x8, a);
        }
    for (int tile = gw >> 2; tile < MTOK / 32; tile += NGW >> 2) {
        const int tok0 = tile * 32, pos0 = tok0 & (SEQ - 1), pos = pos0 + r;
#pragma unroll
        for (int it = 0; it < 6; ++it) {
            const int c = lane + 64 * it, row = c >> 3, dc = c & 7;
            u32x4 v = {0u, 0u, 0u, 0u};
            if (row >= 16 || pos0 != 0) v = *(const u32x4*)(p + (size_t)(tok0 - 16 + row) * NIN + C_A + g * 64 + dc * 8);
            *(LAS u32x4*)(wl + row * PA_PITCH + dc * 16) = v;
        }
        const int cnt = (pos + 1 < win) ? pos + 1 : win;
        const float inv = 1.f / (float)cnt;
        f32x16 acc0, acc1;
#pragma unroll
        for (int i = 0; i < 16; ++i) { acc0[i] = 0.f; acc1[i] = 0.f; }
#pragma unroll
        for (int s = 0; s < 4; ++s) {
            const LAS unsigned char* base = wl + (16 + r) * PA_PITCH + (16 * s + 8 * hh) * 2;
            const u32x4 own = *(const LAS u32x4*)base;
            float sum[8];
            sum[0] = bflo(own.x); sum[1] = bfhi(own.x); sum[2] = bflo(own.y); sum[3] = bfhi(own.y); sum[4] = bflo(own.z); sum[5] = bfhi(own.z); sum[6] = bflo(own.w); sum[7] = bfhi(own.w);
            for (int j = 1; j < win; ++j) {
                const u32x4 v = *(const LAS u32x4*)(base - j * PA_PITCH);
                sum[0] += bflo(v.x); sum[1] += bfhi(v.x); sum[2] += bflo(v.y); sum[3] += bfhi(v.y); sum[4] += bflo(v.z); sum[5] += bfhi(v.z); sum[6] += bflo(v.w); sum[7] += bfhi(v.w);
            }
            u32x4 a;
            a.x = pk2(sum[0] * inv - bflo(own.x), sum[1] * inv - bfhi(own.x)); a.y = pk2(sum[2] * inv - bflo(own.y), sum[3] * inv - bfhi(own.y));
            a.z = pk2(sum[4] * inv - bflo(own.z), sum[5] * inv - bfhi(own.z)); a.w = pk2(sum[6] * inv - bflo(own.w), sum[7] * inv - bfhi(own.w));
            const bf16x8 af = __builtin_bit_cast(bf16x8, a);
            acc0 = MFMA32(af, bw[s][0], acc0);
            acc1 = MFMA32(af, bw[s][1], acc1);
        }
        tile_epilogue(acc0, acc1, ost, lane, p + (size_t)tok0 * NIN + C_GA + g * 64, Y + (size_t)tok0 * D + g * 64, P.pool_scale + l * 256 + g * 64);
    }
}

constexpr int KT_PITCH = 144;
constexpr int VT_OFF = 32 * KT_PITCH;
DI void attn_unit(const Params& P, int unit, int lane, LAS unsigned char* wl) {
    const bf16_t* p = (const bf16_t*)(P.ws + WS_P); bf16_t* Y = (bf16_t*)(P.ws + WS_Y);
    const int qt = unit & 63, h = (unit >> 6) & 7, b = unit >> 9;
    const int r = lane & 31, hh = lane >> 5;
    const size_t tokb = (size_t)b * SEQ;
    LAS float* ost = (LAS float*)wl;
    const size_t rowoff = (tokb + (lane >> 3)) * NIN + h * 64 + (lane & 7) * 8;
    const bf16_t* qp0 = p + rowoff + C_Q; const bf16_t* kp0 = p + rowoff + C_K; const bf16_t* vp0 = p + rowoff + C_V; const bf16_t* gp0 = p + rowoff + C_GC;
    const int klds = (lane >> 3) * KT_PITCH + (lane & 7) * 16;
    const int vlds = VT_OFF + ((lane & 7) >> 2) * 2048 + (lane >> 3) * 64 + (lane & 3) * 16;
    const int frd = r * KT_PITCH + hh * 16;
    const int trbase = VT_OFF + (4 * hh + ((lane & 15) >> 2)) * 64 + ((lane >> 4) & 1) * 32 + (lane & 3) * 8;
    bf16x8 qf[4]; u32x4 gt[4], kn[4], vn[4];
    {
        const size_t o = (size_t)qt * 32 * NIN;
        u32x4 qv[4];
#pragma unroll
        for (int it = 0; it < 4; ++it) qv[it] = *(const u32x4*)(qp0 + o + (size_t)it * 8 * NIN);
#pragma unroll
        for (int it = 0; it < 4; ++it) kn[it] = *(const u32x4*)(kp0 + o + (size_t)it * 8 * NIN);
#pragma unroll
        for (int it = 0; it < 4; ++it) vn[it] = *(const u32x4*)(vp0 + o + (size_t)it * 8 * NIN);
#pragma unroll
        for (int it = 0; it < 4; ++it) gt[it] = *(const u32x4*)(gp0 + o + (size_t)it * 8 * NIN);
#pragma unroll
        for (int it = 0; it < 4; ++it) *(LAS u32x4*)(wl + klds + it * 8 * KT_PITCH) = qv[it];
#pragma unroll
        for (int s = 0; s < 4; ++s) qf[s] = *(const LAS bf16x8*)(wl + frd + s * 32);
    }
    f32x16 o0, o1;
#pragma unroll
    for (int i = 0; i < 16; ++i) { o0[i] = 0.f; o1[i] = 0.f; }
    float carry = 0.f;
    const float CZ = 0.125f * LOG2E;
    for (int kb = qt; kb >= 0; --kb) {
#pragma unroll
        for (int it = 0; it < 4; ++it) *(LAS u32x4*)(wl + klds + it * 8 * KT_PITCH) = kn[it];
#pragma unroll
        for (int it = 0; it < 4; ++it) *(LAS u32x4*)(wl + vlds + it * 512) = vn[it];
        if (kb > 0) {
            const size_t o = (size_t)(kb - 1) * 32 * NIN;
#pragma unroll
            for (int it = 0; it < 4; ++it) kn[it] = *(const u32x4*)(kp0 + o + (size_t)it * 8 * NIN);
#pragma unroll
            for (int it = 0; it < 4; ++it) vn[it] = *(const u32x4*)(vp0 + o + (size_t)it * 8 * NIN);
        }
        f32x16 z;
#pragma unroll
        for (int i = 0; i < 16; ++i) z[i] = 0.f;
#pragma unroll
        for (int s = 0; s < 4; ++s) { const bf16x8 kf = *(const LAS bf16x8*)(wl + frd + s * 32); z = MFMA32(kf, qf[s], z); }
        float l1m[16], lbv[16];
#pragma unroll
        for (int i = 0; i < 16; ++i) {
            const float t = z[i] * CZ;
            const float e = __builtin_amdgcn_exp2f(-fabsf(t));
            const float sp = fmaxf(t, 0.f) + __builtin_amdgcn_logf(1.f + e);
            l1m[i] = -sp; lbv[i] = t - sp;
        }
        if (kb == qt) {
#pragma unroll
            for (int i = 0; i < 16; ++i) if (crow(i, hh) >= r) { l1m[i] = 0.f; lbv[i] = -__builtin_inff(); }
        }
        float gs[4], og[4];
#pragma unroll
        for (int q = 0; q < 4; ++q) { gs[q] = (l1m[4 * q] + l1m[4 * q + 1]) + (l1m[4 * q + 2] + l1m[4 * q + 3]); og[q] = swap32(gs[q], hh); }
        float suf = carry;
        float a[16];
#pragma unroll
        for (int q = 3; q >= 0; --q) {
            float lat = suf + (hh == 0 ? og[q] : 0.f);
            a[4 * q + 3] = __builtin_amdgcn_exp2f(lbv[4 * q + 3] + lat); lat += l1m[4 * q + 3];
            a[4 * q + 2] = __builtin_amdgcn_exp2f(lbv[4 * q + 2] + lat); lat += l1m[4 * q + 2];
            a[4 * q + 1] = __builtin_amdgcn_exp2f(lbv[4 * q + 1] + lat); lat += l1m[4 * q + 1];
            a[4 * q] = __builtin_amdgcn_exp2f(lbv[4 * q] + lat);
            suf += gs[q] + og[q];
        }
        carry = suf;
        u32x4 pa0, pa1;
        pa0.x = pk2(a[0], a[1]); pa0.y = pk2(a[2], a[3]); pa0.z = pk2(a[4], a[5]); pa0.w = pk2(a[6], a[7]);
        pa1.x = pk2(a[8], a[9]); pa1.y = pk2(a[10], a[11]); pa1.z = pk2(a[12], a[13]); pa1.w = pk2(a[14], a[15]);
        bf16x8 vf[2][2];
#pragma unroll
        for (int s = 0; s < 2; ++s)
#pragma unroll
            for (int db = 0; db < 2; ++db) {
                const v4i16_t lo = lds_tr16(wl + trbase + db * 2048 + (16 * s) * 64), hi = lds_tr16(wl + trbase + db * 2048 + (16 * s + 8) * 64);
                vf[s][db] = __builtin_shufflevector(lo, hi, 0, 1, 2, 3, 4, 5, 6, 7);
            }
        o0 = MFMA32(__builtin_bit_cast(bf16x8, pa0), vf[0][0], o0);
        o0 = MFMA32(__builtin_bit_cast(bf16x8, pa1), vf[1][0], o0);
        o1 = MFMA32(__builtin_bit_cast(bf16x8, pa0), vf[0][1], o1);
        o1 = MFMA32(__builtin_bit_cast(bf16x8, pa1), vf[1][1], o1);
        if (__ballot(carry > -160.f) == 0ull) break;
    }
#pragma unroll
    for (int i = 0; i < 16; ++i) { ost[crow(i, hh) * OST_PITCH + r] = o0[i]; ost[crow(i, hh) * OST_PITCH + 32 + r] = o1[i]; }
    bf16_t* yp0 = Y + (tokb + qt * 32 + (lane >> 3)) * D + 512 + h * 64 + (lane & 7) * 8;
#pragma unroll
    for (int it = 0; it < 4; ++it) {
        const LAS float* op = ost + ((lane >> 3) + 8 * it) * OST_PITCH + (lane & 7) * 8;
        const f32x4 a = *(const LAS f32x4*)op, bq = *(const LAS f32x4*)(op + 4);
        const u32x4 g = gt[it];
        u32x4 w;
        w.x = pk2(a[0] * silu_f(bflo(g.x)), a[1] * silu_f(bfhi(g.x)));
        w.y = pk2(a[2] * silu_f(bflo(g.y)), a[3] * silu_f(bfhi(g.y)));
        w.z = pk2(bq[0] * silu_f(bflo(g.z)), bq[1] * silu_f(bfhi(g.z)));
        w.w = pk2(bq[2] * silu_f(bflo(g.w)), bq[3] * silu_f(bfhi(g.w)));
        *(u32x4*)(yp0 + (size_t)it * 8 * D) = w;
    }
}

DI void mixers(const Params& P, int l, LAS unsigned char* lds, int lane, int wave) {
    lane = launder_v(lane); wave = launder_s(wave);
    const int gw = blockIdx.x * NWAVES + wave, NGW = gridDim.x * NWAVES;
#ifndef MXMASK
#define MXMASK 7
#endif
    for (int rep = 0; rep < ((DUP & 4) ? 2 : 1); ++rep)
    if (MXMASK & 1) for (int unit = blockIdx.x; unit < BATCH * 16; unit += gridDim.x) sgu_unit(P, l, unit, lds, launder_v(threadIdx.x), lane, wave);
    for (int rep = 0; rep < ((DUP & 8) ? 2 : 1); ++rep)
    if (MXMASK & 2) pool_wave(P, l, gw, NGW, lane, lds + wave * 16384);
    for (int rep = 0; rep < ((DUP & 16) ? 2 : 1); ++rep)
    if (MXMASK & 4) for (int unit = gw; unit < BATCH * 8 * 64; unit += NGW) attn_unit(P, unit, lane, lds + wave * 16384);
}

__global__ void __launch_bounds__(NTHREADS, 2) fwd_mega(Params P) {
    extern __shared__ __attribute__((aligned(16))) unsigned char lds_raw[];
    LAS unsigned char* lds = (LAS unsigned char*)lds_raw;
    cg::grid_group grid = cg::this_grid();
    const int tid = threadIdx.x, lane = tid & 63, wave = __builtin_amdgcn_readfirstlane(tid >> 6);
    const int lo = P.ph_lo, hi = P.ph_hi;
#ifndef PHMASK
#define PHMASK 0x3ff
#endif
#define IN(k) (((PHMASK >> (k)) & 1) && lo <= (k) && (k) < hi)
#define SEAM(k) do { if (IN(k) && IN((k) + 1)) grid.sync(); } while (0)
    bf16_t* hb = (bf16_t*)(P.ws + WS_HB); bf16_t* pbuf = (bf16_t*)(P.ws + WS_P); bf16_t* ybuf = (bf16_t*)(P.ws + WS_Y);
    const bf16_t* win_t = (const bf16_t*)(P.ws + WS_WIN); const bf16_t* wout_t = (const bf16_t*)(P.ws + WS_WOUT);
    const float* mod = (const float*)(P.ws + WS_MOD);

    if (IN(0)) for (int rep = 0; rep < ((DUP & 64) ? 2 : 1); ++rep) phase0(P, lds, tid, lane, wave);
    SEAM(0);
    if (IN(1)) for (int rep = 0; rep < ((DUP & 32) ? 2 : 1); ++rep) row_pass<0>(P, lane, wave);
    SEAM(1);
#pragma unroll 1
    for (int l = 0; l < DEPTH; ++l) {
        const int pb = 2 + 4 * l;
        if (IN(pb)) for (int rep = 0; rep < ((DUP & 1) ? 2 : 1); ++rep) {
            pg8::Gemm g{hb, win_t + (size_t)l * NIN * D, MTOK, NIN, D}; pg8::StaticOrder S; S.init(MTOK, NIN, (int)gridDim.x, (int)blockIdx.x);
            EpiP E{pbuf};
            pg8::gemm_phase<EpiP, pg8::StaticOrder, true, true>(lds, g, S, E);
        }
        SEAM(pb);
        if (IN(pb + 1)) mixers(P, l, lds, lane, wave);
        SEAM(pb + 1);
        if (IN(pb + 2)) for (int rep = 0; rep < ((DUP & 2) ? 2 : 1); ++rep) {
            pg8::Gemm g{ybuf, wout_t + (size_t)l * D * D, MTOK, D, D}; pg8::StaticOrder S; S.init(MTOK, D, (int)gridDim.x, (int)blockIdx.x);
            EpiRes E{P.x, l == 0 ? nullptr : (const bf16_t*)(P.ws + WS_R0), (const float*)(P.ws + WS_RSTAT), P.ln_g, P.ln_b,
                     mod + (size_t)l * BATCH * 3072 + 2048, (bf16_t*)(P.ws + (l == 0 ? WS_R0 : WS_R1)), (float*)(P.ws + WS_PSTAT)};
            pg8::gemm_phase<EpiRes, pg8::StaticOrder, true, true>(lds, g, S, E);
        }
        SEAM(pb + 2);
        if (IN(pb + 3)) { if (l == 0) { for (int rep = 0; rep < ((DUP & 32) ? 2 : 1); ++rep) row_pass<1>(P, lane, wave); } else row_pass<2>(P, lane, wave); }
        SEAM(pb + 3);
    }
#undef IN
#undef SEAM
}

#ifndef N_LAUNCH_PER_PHASE
#define N_LAUNCH_PER_PHASE 0
#endif
extern "C" void kernel_launch(void* const* d_in, const int* in_sizes, int n_in, void* d_out, int out_size, void* d_ws, size_t ws_size, hipStream_t stream) {
    static int grid = 0;
    if (grid == 0) {
        if (n_in != 14 || out_size != MTOK * D || ws_size < WS_END) { fprintf(stderr, "kernel_launch: unexpected shapes (n_in %d out %d ws %zu need %zu)\n", n_in, out_size, ws_size, (size_t)WS_END); grid = -1; return; }
        int dev = 0, cus = 0, per_cu = 0;
        hipGetDevice(&dev);
        hipDeviceGetAttribute(&cus, hipDeviceAttributeMultiprocessorCount, dev);
        if (hipFuncSetAttribute((const void*)fwd_mega, hipFuncAttributeMaxDynamicSharedMemorySize, LDS_BYTES) != hipSuccess) { fprintf(stderr, "kernel_launch: hipFuncSetAttribute failed\n"); grid = -1; return; }
        if (hipOccupancyMaxActiveBlocksPerMultiprocessor(&per_cu, (const void*)fwd_mega, NTHREADS, LDS_BYTES) != hipSuccess || per_cu < 1) { fprintf(stderr, "kernel_launch: occupancy query says %d\n", per_cu); per_cu = 1; }
        (void)hipGetLastError();
        grid = cus * 1;
        if (grid != 256) fprintf(stderr, "kernel_launch: note: grid %d\n", grid);
    }
    if (grid < 0) return;
    Params p{};
    p.x = (const float*)d_in[0]; p.c = (const float*)d_in[1]; p.w_in = (const float*)d_in[2]; p.pool_w = (const float*)d_in[3]; p.pool_scale = (const float*)d_in[4];
    p.sgu_ln_g = (const float*)d_in[5]; p.sgu_ln_b = (const float*)d_in[6]; p.sgu_w = (const float*)d_in[7]; p.sgu_b = (const float*)d_in[8]; p.w_out = (const float*)d_in[9];
    p.ada_w = (const float*)d_in[10]; p.ada_b = (const float*)d_in[11]; p.ln_g = (const float*)d_in[12]; p.ln_b = (const float*)d_in[13];
    p.out = (float*)d_out; p.ws = (unsigned char*)d_ws;
#if N_LAUNCH_PER_PHASE
    for (int ph = 0; ph < 10; ++ph) {
        p.ph_lo = ph; p.ph_hi = ph + 1;
        hipLaunchKernelGGL(fwd_mega, dim3(grid), dim3(NTHREADS), LDS_BYTES, stream, p);
    }
#else
    p.ph_lo = 0; p.ph_hi = 10;
    void* args[] = {&p};
    hipError_t e = hipLaunchCooperativeKernel((const void*)fwd_mega, dim3(grid), dim3(NTHREADS), args, LDS_BYTES, stream);
    if (e != hipSuccess) fprintf(stderr, "kernel_launch: cooperative launch failed: %s (grid %d)\n", hipGetErrorString(e), grid);
#endif
}
```

```cpp
#include <hip/hip_runtime.h>
#include <hip/hip_cooperative_groups.h>
#include <cstdio>
#include <cstdint>
namespace cg = cooperative_groups;
__device__ __forceinline__ int launder_v(int x) { asm volatile("" : "+v"(x)); return x; }
__device__ __forceinline__ int launder_s(int x) { asm volatile("" : "+s"(x)); return x; }
namespace pg8 {
#define PG8_LAS __attribute__((address_space(3)))
typedef unsigned short bf16_t;
typedef short bf16x8 __attribute__((ext_vector_type(8)));
typedef float f32x4 __attribute__((ext_vector_type(4)));
typedef unsigned u32x4 __attribute__((ext_vector_type(4)));
constexpr int BM = 256, BK = 64, HALF = 128, HTB = HALF * BK * 2  , STAGE_BYTES = 8 * HTB, NXCD = 8, WGM = 8;

__host__ __device__ __forceinline__ int lds_byte(int r, int c) { const int st = (r >> 4) * 2 + (c >> 5), rr = r & 15, cc = c & 31, ob = rr * 64 + cc * 2; return st * 1024 + (ob ^ (((ob >> 9) & 1) << 5)); }
__host__ __device__ __forceinline__ void stage_rc(int b, int& R, int& C) { const int st = b / 1024, sb = b % 1024, swz = sb ^ (((sb >> 9) & 1) << 5); R = (st >> 1) * 16 + swz / 64; C = (st & 1) * 32 + (swz % 64) / 2; }
__host__ __device__ __forceinline__ int perm32(int rho) { const int n = rho >> 4, i = rho & 15; return 8 * (i >> 2) + 4 * n + (i & 3); }

struct Unit { int pm, pn; };
struct Gemm { const bf16_t* A; const bf16_t* Bt; int M, N, K; };

struct StaticOrder {
    int nM, nN, nwg, G, c;
    __host__ __device__ void init(int M, int N, int G_, int c_) { nM = M / BM; nN = N / BM; nwg = nM * nN; G = G_; c = c_; }
    __host__ __device__ bool next(int i, Unit& u) const {
        const long L = (long)i * G + c; if (L >= nwg) return false;
        int wgid = (int)L; { const int q = nwg / NXCD, r = nwg % NXCD, xcd = wgid % NXCD, off = wgid / NXCD; wgid = (xcd < r ? xcd * (q + 1) : r * (q + 1) + (xcd - r) * q) + off; }
        const int nig = WGM * nN, gid = wgid / nig, fm = gid * WGM, gsz = (nM - fm) < WGM ? (nM - fm) : WGM;
        u.pm = fm + ((wgid % nig) % gsz); u.pn = (wgid % nig) / gsz; return true;
    }
    __device__ __forceinline__ void a_ready(const Unit&) const {}
    __device__ __forceinline__ void done(const Unit&) const {}
};

__device__ __forceinline__ unsigned cvt_pk_bf16(float lo, float hi) { unsigned r; asm volatile("v_cvt_pk_bf16_f32 %0, %1, %2" : "=v"(r) : "v"(lo), "v"(hi)); return r; }
template <class Epi, class Sched, bool ALIGN_EPI = false, bool SP2 = false>
__device__ __forceinline__ void gemm_phase(PG8_LAS unsigned char* lds, const Gemm g, const Sched& S, const Epi& E) {
    const int tid = launder_v(threadIdx.x), wid = __builtin_amdgcn_readfirstlane(tid >> 6), lane = tid & 63, wr = wid >> 2, wc = wid & 3, fr = lane & 15, fq = lane >> 4;
    const int K = g.K, nt = K / BK;
    unsigned voffA[2], voffB[2];
#pragma unroll
    for (int i = 0; i < 2; ++i) { int R, C; stage_rc(tid * 16 + i * 8192, R, C); const int Rb = Epi::PERM ? ((R & ~31) + perm32(R & 31)) : R;
        voffA[i] = (unsigned)(R * K + C) * 2u; voffB[i] = (unsigned)(Rb * K + C) * 2u; }
    const size_t kstep = (size_t)(BK * 2);
    const size_t hstep = (size_t)HALF * K * 2;
    const size_t tstep = 2 * hstep;
    const unsigned ldsw = (unsigned)wid * 1024u;
    const int aoff = lds_byte(wr * 64 + fr, fq * 8), boff = lds_byte(wc * 32 + fr, fq * 8);
#define PG8_SA(b, h) (((b) * 2 + (h)) * HTB)
#define PG8_SB(b, h) ((4 + (b) * 2 + (h)) * HTB)
#define PG8_STAGE(bufoff, gbase, voff) do { _Pragma("unroll") for (int _i = 0; _i < 2; ++_i) \
        __builtin_amdgcn_global_load_lds((const unsigned*)((const char*)(gbase) + (voff)[_i]), (PG8_LAS unsigned*)(lds + (bufoff) + ldsw + _i * 8192), 16, 0, 0); } while (0)
#define PG8_LDA(dst, b, h) do { _Pragma("unroll") for (int m = 0; m < 4; ++m) _Pragma("unroll") for (int k = 0; k < 2; ++k) dst[m][k] = *(const PG8_LAS bf16x8*)(lds + PG8_SA(b, h) + aoff + m * 2048 + k * 1024); } while (0)
#define PG8_LDB(dst, b, h) do { _Pragma("unroll") for (int n = 0; n < 2; ++n) _Pragma("unroll") for (int k = 0; k < 2; ++k) dst[n][k] = *(const PG8_LAS bf16x8*)(lds + PG8_SB(b, h) + boff + n * 2048 + k * 1024); } while (0)
#define PG8_MMA(ai, bj, At, Bt) do { __builtin_amdgcn_s_setprio(1); _Pragma("unroll") for (int m = 0; m < 4; ++m) _Pragma("unroll") for (int n = 0; n < 2; ++n) _Pragma("unroll") for (int k = 0; k < 2; ++k) \
        acc[ai][bj][m][n] = __builtin_amdgcn_mfma_f32_16x16x32_bf16(Bt[n][k], At[m][k], acc[ai][bj][m][n], 0, 0, 0); __builtin_amdgcn_s_setprio(0); } while (0)
#define PG8_WAIT_V(n) asm volatile("s_waitcnt vmcnt(" #n ")" ::: "memory")
#define PG8_WAIT_L(n) asm volatile("s_waitcnt lgkmcnt(" #n ")" ::: "memory")
#define PG8_BAR __builtin_amdgcn_s_barrier()
#define PG8_SCHED __builtin_amdgcn_sched_barrier(0)
    Unit cur, nxt; int ui = 0;
    if (!S.next(0, cur)) return;
    f32x4 acc[2][2][4][2];
#pragma unroll
    for (int a = 0; a < 2; ++a)
#pragma unroll
        for (int b = 0; b < 2; ++b)
#pragma unroll
            for (int m = 0; m < 4; ++m)
#pragma unroll
                for (int n = 0; n < 2; ++n) acc[a][b][m][n] = (f32x4){0.f, 0.f, 0.f, 0.f};
    bf16x8 At[4][2], B0[2][2], B1[2][2];
    const char* cA = (const char*)g.A + (size_t)cur.pm * tstep; const char* cB = (const char*)g.Bt + (size_t)cur.pn * tstep;
    S.a_ready(cur);
    if constexpr (SP2) {
        PG8_STAGE(PG8_SB(0, 0), cB, voffB); PG8_STAGE(PG8_SB(0, 1), cB + hstep, voffB); PG8_STAGE(PG8_SA(0, 0), cA, voffA); PG8_STAGE(PG8_SA(0, 1), cA + hstep, voffA);
        if (wr == 1) PG8_BAR;
        PG8_WAIT_V(2); PG8_BAR;
        PG8_STAGE(PG8_SB(1, 0), cB + kstep, voffB); PG8_STAGE(PG8_SA(1, 0), cA + kstep, voffA); PG8_STAGE(PG8_SB(1, 1), cB + hstep + kstep, voffB);
        PG8_WAIT_V(6); PG8_BAR;
    } else {
        PG8_STAGE(PG8_SB(0, 0), cB, voffB); PG8_STAGE(PG8_SA(0, 0), cA, voffA); PG8_STAGE(PG8_SB(0, 1), cB + hstep, voffB); PG8_STAGE(PG8_SA(0, 1), cA + hstep, voffA);
        if (wr == 1) PG8_BAR;
        PG8_WAIT_V(4); PG8_BAR;
        PG8_STAGE(PG8_SB(1, 0), cB + kstep, voffB); PG8_STAGE(PG8_SA(1, 0), cA + kstep, voffA); PG8_STAGE(PG8_SB(1, 1), cB + hstep + kstep, voffB);
        PG8_WAIT_V(6); PG8_BAR;
    }
    for (;;) {
        const bool has_next = S.next(ui + 1, nxt);
        const char* nA = has_next ? (const char*)g.A + (size_t)nxt.pm * tstep : cA; const char* nB = has_next ? (const char*)g.Bt + (size_t)nxt.pn * tstep : cB;
        for (int t = 0; t < nt; t += 2) {
            const bool last = (t == nt - 2);
            const char* a1 = cA + (size_t)(t + 1) * kstep;
            const char* a2 = last ? nA : cA + (size_t)(t + 2) * kstep; const char* b2 = last ? nB : cB + (size_t)(t + 2) * kstep;
            const char* a3 = a2 + kstep; const char* b3 = b2 + kstep;
            if (last && has_next) S.a_ready(nxt);
            if constexpr (SP2) {
            PG8_LDB(B0, 0, 0); PG8_LDB(B1, 0, 1); PG8_SCHED; PG8_LDA(At, 0, 0); PG8_STAGE(PG8_SA(1, 1), a1 + hstep, voffA);
            PG8_WAIT_V(8); PG8_WAIT_L(0); PG8_BAR; PG8_MMA(0, 0, At, B0); PG8_MMA(0, 1, At, B1); PG8_BAR; PG8_SCHED;
            PG8_LDA(At, 0, 1); PG8_STAGE(PG8_SB(0, 0), b2, voffB); PG8_STAGE(PG8_SB(0, 1), b2 + hstep, voffB); PG8_STAGE(PG8_SA(0, 0), a2, voffA);
            PG8_WAIT_V(8); PG8_WAIT_L(0); PG8_BAR; PG8_MMA(1, 0, At, B0); PG8_MMA(1, 1, At, B1); PG8_BAR; PG8_SCHED;
            PG8_LDB(B0, 1, 0); PG8_LDB(B1, 1, 1); PG8_SCHED; PG8_LDA(At, 1, 0); PG8_STAGE(PG8_SA(0, 1), a2 + hstep, voffA);
            PG8_WAIT_V(8); PG8_WAIT_L(0); PG8_BAR; PG8_MMA(0, 0, At, B0); PG8_MMA(0, 1, At, B1); PG8_BAR; PG8_SCHED;
            PG8_LDA(At, 1, 1); PG8_STAGE(PG8_SB(1, 0), b3, voffB); PG8_STAGE(PG8_SB(1, 1), b3 + hstep, voffB); PG8_STAGE(PG8_SA(1, 0), a3, voffA);
            PG8_WAIT_V(8); PG8_WAIT_L(0); PG8_BAR; PG8_MMA(1, 0, At, B0); PG8_MMA(1, 1, At, B1); PG8_BAR; PG8_SCHED;
            } else {
            PG8_LDB(B0, 0, 0); PG8_SCHED; PG8_LDA(At, 0, 0); PG8_STAGE(PG8_SA(1, 1), a1 + hstep, voffA);
            PG8_WAIT_L(8); PG8_BAR; PG8_WAIT_L(0); PG8_MMA(0, 0, At, B0); PG8_BAR; PG8_SCHED;
            PG8_LDB(B1, 0, 1); PG8_STAGE(PG8_SB(0, 0), b2, voffB);
            PG8_BAR; PG8_WAIT_L(0); PG8_MMA(0, 1, At, B1); PG8_BAR;
            PG8_LDA(At, 0, 1); PG8_STAGE(PG8_SA(0, 0), a2, voffA);
            PG8_BAR; PG8_WAIT_L(0); PG8_MMA(1, 0, At, B0); PG8_BAR; PG8_SCHED;
            PG8_STAGE(PG8_SB(0, 1), b2 + hstep, voffB);
            PG8_WAIT_V(6); PG8_BAR; PG8_MMA(1, 1, At, B1); PG8_BAR;
            PG8_LDB(B0, 1, 0); PG8_SCHED; PG8_LDA(At, 1, 0); PG8_STAGE(PG8_SA(0, 1), a2 + hstep, voffA);
            PG8_WAIT_L(8); PG8_BAR; PG8_WAIT_L(0); PG8_MMA(0, 0, At, B0); PG8_BAR; PG8_SCHED;
            PG8_LDB(B1, 1, 1); PG8_STAGE(PG8_SB(1, 0), b3, voffB);
            PG8_BAR; PG8_WAIT_L(0); PG8_MMA(0, 1, At, B1); PG8_BAR;
            PG8_LDA(At, 1, 1); PG8_STAGE(PG8_SA(1, 0), a3, voffA);
            PG8_BAR; PG8_WAIT_L(0); PG8_MMA(1, 0, At, B0); PG8_BAR; PG8_SCHED;
            PG8_STAGE(PG8_SB(1, 1), b3 + hstep, voffB);
            PG8_WAIT_V(6); PG8_BAR; PG8_MMA(1, 1, At, B1); PG8_BAR;
            }
        }
        if constexpr (ALIGN_EPI) { if (wr == 0) PG8_BAR; }
        if constexpr (!Epi::AFTER_DRAIN) { E(acc, cur, wr, wc, fr, fq); S.done(cur); }
        if (!has_next) break;
#pragma unroll
        for (int a = 0; a < 2; ++a)
#pragma unroll
            for (int b = 0; b < 2; ++b)
#pragma unroll
                for (int m = 0; m < 4; ++m)
#pragma unroll
                    for (int n = 0; n < 2; ++n) acc[a][b][m][n] = (f32x4){0.f, 0.f, 0.f, 0.f};
        cur = nxt; cA = nA; cB = nB; ++ui;
        if constexpr (ALIGN_EPI) { if (wr == 1) PG8_BAR; }
    }
    PG8_WAIT_V(0);
    if constexpr (!ALIGN_EPI) { if (wr == 0) PG8_BAR; }
    PG8_BAR;
    if constexpr (Epi::AFTER_DRAIN) { E.fused(acc, cur, wr, wc, fr, fq, lds, wid, lane); S.done(cur); }
#undef PG8_SA
#undef PG8_SB
#undef PG8_STAGE
#undef PG8_LDA
#undef PG8_LDB
#undef PG8_MMA
#undef PG8_WAIT_V
#undef PG8_WAIT_L
#undef PG8_BAR
#undef PG8_SCHED
}
}

#define DI __device__ __forceinline__
#define LAS __attribute__((address_space(3)))
typedef unsigned short bf16_t;
typedef short bf16x8 __attribute__((ext_vector_type(8)));
typedef float f32x4 __attribute__((ext_vector_type(4)));
typedef float f32x16 __attribute__((ext_vector_type(16)));
typedef unsigned u32x4 __attribute__((ext_vector_type(4)));
typedef unsigned u32x2 __attribute__((ext_vector_type(2)));
typedef __bf16 bf16x2_t __attribute__((ext_vector_type(2)));
typedef float f32x2_t __attribute__((ext_vector_type(2)));

constexpr int D = 1024, BATCH = 32, SEQ = 2048, MTOK = BATCH * SEQ, NIN = 3328, DEPTH = 2;
constexpr int NP = 1792;
constexpr int C_A = 0, C_GA = 256, C_U = 512, C_VS = 768, C_GB = 1024, C_GC = 1280;
constexpr size_t QKV_PAIR = (size_t)SEQ * 64;
constexpr size_t QKV_ONE = (size_t)BATCH * 8 * QKV_PAIR;
constexpr float DN_ALPHA = 1.41421356237309515f;
constexpr float LN_EPS = 1e-5f;
constexpr float LOG2E = 1.44269504088896341f;

constexpr size_t WS_WIN = 0;
constexpr size_t WS_WOUT = WS_WIN + (size_t)DEPTH * NIN * D * 2;
constexpr size_t WS_MOD = WS_WOUT + (size_t)DEPTH * D * D * 2;
constexpr size_t WS_HB = WS_MOD + (size_t)DEPTH * BATCH * 3 * D * 4;
constexpr size_t WS_P = WS_HB + (size_t)MTOK * D * 2;
constexpr size_t WS_QKV = WS_P + (size_t)MTOK * NP * 2;
constexpr size_t WS_Y = WS_QKV + 3 * QKV_ONE * 2;
constexpr size_t WS_R0 = WS_Y + (size_t)MTOK * D * 2;
constexpr size_t WS_R1 = WS_R0 + (size_t)MTOK * D * 2;
constexpr size_t WS_PSTAT = WS_R1 + (size_t)MTOK * D * 2;
constexpr size_t WS_RSTAT = WS_PSTAT + (size_t)MTOK * 16 * 2 * 4;
constexpr size_t WS_SGW = WS_RSTAT + (size_t)MTOK * 2 * 4;
constexpr size_t WS_END = WS_SGW + (size_t)DEPTH * 4 * 128 * 128 * 2;

constexpr int LDS_BYTES = 139264;
constexpr int NTHREADS = 512, NWAVES = 8;
#ifndef DUP
#define DUP 0
#endif

struct Params {
    const float *x, *c, *w_in, *pool_w, *pool_scale, *sgu_ln_g, *sgu_ln_b, *sgu_w, *sgu_b, *w_out, *ada_w, *ada_b, *ln_g, *ln_b;
    float* out; unsigned char* ws;
    int ph_lo, ph_hi;
};

DI unsigned pk2(float lo, float hi) { f32x2_t v = {lo, hi}; bf16x2_t b = __builtin_convertvector(v, bf16x2_t); return __builtin_bit_cast(unsigned, b); }
DI float bf2f(unsigned short u) { return __builtin_bit_cast(float, (unsigned)u << 16); }
DI float bflo(unsigned u) { return __builtin_bit_cast(float, u << 16); }
DI float bfhi(unsigned u) { return __builtin_bit_cast(float, u & 0xffff0000u); }
DI float silu_f(float v) { return v * __builtin_amdgcn_rcpf(1.f + __builtin_amdgcn_exp2f(-v * LOG2E)); }
DI float wave_sum(float v) {
#pragma unroll
    for (int o = 1; o < 64; o <<= 1) v += __shfl_xor(v, o);
    return v;
}
DI float swap32(float v, int hh) {
    const unsigned u = __builtin_bit_cast(unsigned, v);
    const auto rr = __builtin_amdgcn_permlane32_swap(u, u, false, false);
    return __builtin_bit_cast(float, hh ? rr[0] : rr[1]);
}
DI int crow(int i, int hh) { return (i & 3) + 8 * (i >> 2) + 4 * hh; }
#define MFMA32(a, b, c) __builtin_amdgcn_mfma_f32_32x32x16_bf16((a), (b), (c), 0, 0, 0)
#define LDS_WAIT() asm volatile("s_waitcnt lgkmcnt(0)" ::: "memory")

struct EpiP {
    static constexpr bool PERM = true, AFTER_DRAIN = false;
    bf16_t* O; bf16_t* QKV;
    DI void operator()(const pg8::f32x4 (&acc)[2][2][4][2], const pg8::Unit& u, int wr, int wc, int fr, int fq) const {
        const int row0 = u.pm * 256 + wr * 64 + fr;
        const bool qkv = (u.pn >= 5 && u.pn < 11);
        bf16_t* base; size_t rstride; int bjstride;
        if (qkv) {
            const int which = (u.pn - 5) >> 1, b = (u.pm * 256) >> 11, s0 = (u.pm * 256) & (SEQ - 1);
            base = QKV + (size_t)which * QKV_ONE + ((size_t)b * 8 + ((u.pn - 5) & 1) * 4 + (wc >> 1)) * QKV_PAIR + (size_t)(s0 + wr * 64 + fr) * 64 + (wc & 1) * 32 + 8 * fq;
            rstride = 64; bjstride = 2 * (int)QKV_PAIR;
        } else {
            const int pcol = (u.pn < 5 ? u.pn * 256 : u.pn * 256 - 1536) + wc * 32 + 8 * fq;
            base = O + (size_t)row0 * NP + pcol; rstride = NP; bjstride = 128;
        }
#pragma unroll
        for (int ai = 0; ai < 2; ++ai)
#pragma unroll
            for (int m = 0; m < 4; ++m) {
                bf16_t* rowp = base + (size_t)(ai * 128 + m * 16) * rstride;
#pragma unroll
                for (int bj = 0; bj < 2; ++bj) {
                    const pg8::f32x4 v0 = acc[ai][bj][m][0], v1 = acc[ai][bj][m][1];
                    u32x4 w; w.x = pk2(v0[0], v0[1]); w.y = pk2(v0[2], v0[3]); w.z = pk2(v1[0], v1[1]); w.w = pk2(v1[2], v1[3]);
                    *(u32x4*)(rowp + (size_t)bj * bjstride) = w;
                }
            }
    }
};
struct EpiRes {
    static constexpr bool PERM = true, AFTER_DRAIN = false;
    const float* xsrc;
    const bf16_t* rsrc;
    const float* rstat;
    const float* lng; const float* lnb;
    const float* gate;
    bf16_t* R; float* pstat;
    DI void operator()(const pg8::f32x4 (&acc)[2][2][4][2], const pg8::Unit& u, int wr, int wc, int fr, int fq) const {
        const int row0 = u.pm * 256 + wr * 64 + fr, col0 = u.pn * 256 + wc * 32 + 8 * fq;
        const int b = (u.pm * 256) >> 11;
        f32x4 ga[2][2];
#pragma unroll
        for (int bj = 0; bj < 2; ++bj)
#pragma unroll
            for (int n = 0; n < 2; ++n) ga[bj][n] = *(const f32x4*)(gate + (size_t)b * 3072 + col0 + bj * 128 + 4 * n);
#pragma unroll
        for (int ai = 0; ai < 2; ++ai)
#pragma unroll
            for (int m = 0; m < 4; ++m) {
                const int row = row0 + ai * 128 + m * 16;
                float mean = 0.f, rstd = 1.f;
                if (rsrc) { const f32x2_t st = *(const f32x2_t*)(rstat + (size_t)row * 2); mean = st.x; rstd = st.y; }
                float s = 0.f, ss = 0.f;
#pragma unroll
                for (int bj = 0; bj < 2; ++bj) {
                    const int col = col0 + bj * 128;
                    f32x4 x0, x1;
                    if (rsrc) {
                        const u32x4 rv = *(const u32x4*)(rsrc + (size_t)row * D + col);
                        x0 = (f32x4){bflo(rv.x), bfhi(rv.x), bflo(rv.y), bfhi(rv.y)}; x1 = (f32x4){bflo(rv.z), bfhi(rv.z), bflo(rv.w), bfhi(rv.w)};
                        x0 = (x0 - mean) * rstd * *(const f32x4*)(lng + col) + *(const f32x4*)(lnb + col);
                        x1 = (x1 - mean) * rstd * *(const f32x4*)(lng + col + 4) + *(const f32x4*)(lnb + col + 4);
                    } else { x0 = *(const f32x4*)(xsrc + (size_t)row * D + col); x1 = *(const f32x4*)(xsrc + (size_t)row * D + col + 4); }
                    const f32x4 v0 = x0 * DN_ALPHA + ga[bj][0] * acc[ai][bj][m][0], v1 = x1 * DN_ALPHA + ga[bj][1] * acc[ai][bj][m][1];
                    u32x4 w; w.x = pk2(v0[0], v0[1]); w.y = pk2(v0[2], v0[3]); w.z = pk2(v1[0], v1[1]); w.w = pk2(v1[2], v1[3]);
                    *(u32x4*)(R + (size_t)row * D + col) = w;
                    const float r0 = bflo(w.x), r1 = bfhi(w.x), r2 = bflo(w.y), r3 = bfhi(w.y), r4 = bflo(w.z), r5 = bfhi(w.z), r6 = bflo(w.w), r7 = bfhi(w.w);
                    s += ((r0 + r1) + (r2 + r3)) + ((r4 + r5) + (r6 + r7));
                    ss += ((r0 * r0 + r1 * r1) + (r2 * r2 + r3 * r3)) + ((r4 * r4 + r5 * r5) + (r6 * r6 + r7 * r7));
                }
                s += __shfl_xor(s, 16); ss += __shfl_xor(ss, 16);
                s += __shfl_xor(s, 32); ss += __shfl_xor(ss, 32);
                if (fq == 0) { f32x2_t o = {s, ss}; *(f32x2_t*)(pstat + ((size_t)row * 16 + u.pn * 4 + wc) * 2) = o; }
            }
    }
};

DI void transpose_item(const float* W, int K, int N, bf16_t* WT, LAS float* scr, int item, int lane) {
    const int nblk = N / 32, kb = item / nblk, nb = item % nblk, k0 = 64 * kb, n0 = 32 * nb;
#pragma unroll 8
    for (int i = 0; i < 32; ++i) { const int kk = 2 * i + (lane >> 5); scr[kk * 33 + (lane & 31)] = W[(size_t)(k0 + kk) * N + n0 + (lane & 31)]; }
    LDS_WAIT();
    const int c = lane & 7;
#pragma unroll
    for (int j = 0; j < 4; ++j) {
        const int n = (lane >> 3) + 8 * j; const LAS float* s = scr + (8 * c) * 33 + n;
        u32x4 o; o.x = pk2(s[0 * 33], s[1 * 33]); o.y = pk2(s[2 * 33], s[3 * 33]); o.z = pk2(s[4 * 33], s[5 * 33]); o.w = pk2(s[6 * 33], s[7 * 33]);
        *(u32x4*)(WT + (size_t)(n0 + n) * K + k0 + 8 * c) = o;
    }
    LDS_WAIT();
}

DI void phase0(const Params& P, LAS unsigned char* lds, int tid, int lane, int wave) {
    tid = launder_v(tid); lane = launder_v(lane); wave = launder_s(wave);
    bf16_t* win_t = (bf16_t*)(P.ws + WS_WIN); bf16_t* wout_t = (bf16_t*)(P.ws + WS_WOUT); float* mod = (float*)(P.ws + WS_MOD);
    for (int i = blockIdx.x * NTHREADS + tid; i < DEPTH * 4 * 128 * 128 / 8; i += gridDim.x * NTHREADS) {
        const f32x4 w0 = *(const f32x4*)(P.sgu_w + (size_t)i * 8), w1 = *(const f32x4*)(P.sgu_w + (size_t)i * 8 + 4);
        u32x4 o; o.x = pk2(w0[0], w0[1]); o.y = pk2(w0[2], w0[3]); o.z = pk2(w1[0], w1[1]); o.w = pk2(w1[2], w1[3]);
        *(u32x4*)(P.ws + WS_SGW + (size_t)i * 16) = o;
    }
    {
        LAS float* scr = (LAS float*)(lds + wave * 16384);
        const int gw = blockIdx.x * NWAVES + wave, NGW = gridDim.x * NWAVES;
        constexpr int I_IN = (D / 64) * (NIN / 32), I_OUT = (D / 64) * (D / 32);
        for (int it = gw; it < DEPTH * (I_IN + I_OUT); it += NGW) {
            const int l = it / (I_IN + I_OUT); int r = it % (I_IN + I_OUT);
            if (r < I_IN) transpose_item(P.w_in + (size_t)l * D * NIN, D, NIN, win_t + (size_t)l * NIN * D, scr, r, lane);
            else transpose_item(P.w_out + (size_t)l * D * D, D, D, wout_t + (size_t)l * D * D, scr, r - I_IN, lane);
        }
    }
    __syncthreads();
    LAS float* sc = (LAS float*)lds;
    for (int item = blockIdx.x; item < DEPTH * 96; item += gridDim.x) {
        const int l = item / 96, j0 = (item % 96) * 32;
        for (int e = tid; e < BATCH * D; e += NTHREADS) { const int b = e >> 10, k = e & 1023; sc[k * 32 + b] = silu_f(P.c[e]); }
        __syncthreads();
        const int j = tid & 31, ks = tid >> 5;
        float acc[32];
#pragma unroll
        for (int b = 0; b < 32; ++b) acc[b] = 0.f;
        const float* wp = P.ada_w + ((size_t)l * D + ks * 64) * 3072 + j0 + j;
#pragma unroll 2
        for (int kk = 0; kk < 64; ++kk) {
            const float w = wp[(size_t)kk * 3072];
            const LAS f32x4* s4 = (const LAS f32x4*)(sc + (ks * 64 + kk) * 32);
#pragma unroll
            for (int q = 0; q < 8; ++q) { const f32x4 v = s4[q]; acc[4 * q] += v[0] * w; acc[4 * q + 1] += v[1] * w; acc[4 * q + 2] += v[2] * w; acc[4 * q + 3] += v[3] * w; }
        }
        __syncthreads();
        LAS float* red = (LAS float*)lds;
#pragma unroll
        for (int b = 0; b < 32; ++b) red[(ks * 32 + b) * 32 + j] = acc[b];
        __syncthreads();
#pragma unroll
        for (int o2 = 0; o2 < 2; ++o2) {
            const int o = tid + o2 * NTHREADS, b = o >> 5, jj = o & 31;
            float s = P.ada_b[l * 3072 + j0 + jj];
#pragma unroll
            for (int q = 0; q < 16; ++q) s += red[(q * 32 + b) * 32 + jj];
            mod[((size_t)l * BATCH + b) * 3072 + j0 + jj] = s;
        }
        __syncthreads();
    }
}

template <int MODE>
DI void row_pass(const Params& P, int lane, int wave) {
    lane = launder_v(lane); wave = launder_s(wave);
    const int gw = blockIdx.x * NWAVES + wave, NGW = gridDim.x * NWAVES;
    const float* mod = (const float*)(P.ws + WS_MOD) + (MODE == 1 ? (size_t)BATCH * 3072 : 0);
    const float* pstat = (const float*)(P.ws + WS_PSTAT);
    float* rstat = (float*)(P.ws + WS_RSTAT);
    bf16_t* hb = (bf16_t*)(P.ws + WS_HB);
    const bf16_t* rsrc = (const bf16_t*)(P.ws + (MODE == 1 ? WS_R0 : WS_R1));
    const float* lg = P.ln_g + (MODE == 2 ? D : 0); const float* lb = P.ln_b + (MODE == 2 ? D : 0);
    constexpr int RU = 4;
    for (int row0 = gw * RU; row0 < MTOK; row0 += NGW * RU) {
        f32x4 v[RU][2][2];
        if (MODE == 0) {
#pragma unroll
            for (int u = 0; u < RU; ++u)
#pragma unroll
                for (int j = 0; j < 2; ++j) { const float* xp = P.x + (size_t)(row0 + u) * D + 8 * lane + 512 * j; v[u][j][0] = *(const f32x4*)xp; v[u][j][1] = *(const f32x4*)(xp + 4); }
        } else {
            u32x4 raw[RU][2];
#pragma unroll
            for (int u = 0; u < RU; ++u)
#pragma unroll
                for (int j = 0; j < 2; ++j) raw[u][j] = *(const u32x4*)(rsrc + (size_t)(row0 + u) * D + 8 * lane + 512 * j);
#pragma unroll
            for (int u = 0; u < RU; ++u)
#pragma unroll
                for (int j = 0; j < 2; ++j) {
                    v[u][j][0] = (f32x4){bflo(raw[u][j].x), bfhi(raw[u][j].x), bflo(raw[u][j].y), bfhi(raw[u][j].y)};
                    v[u][j][1] = (f32x4){bflo(raw[u][j].z), bfhi(raw[u][j].z), bflo(raw[u][j].w), bfhi(raw[u][j].w)};
                }
        }
        float mean[RU], rstd[RU];
#pragma unroll
        for (int u = 0; u < RU; ++u) { mean[u] = 0.f; rstd[u] = 1.f; }
        if (MODE != 0) {
            const f32x2_t st = *(const f32x2_t*)(pstat + ((size_t)(row0 + (lane >> 4)) * 16 + (lane & 15)) * 2);
            float s = st.x, ss = st.y;
#pragma unroll
            for (int o = 1; o < 16; o <<= 1) { s += __shfl_xor(s, o); ss += __shfl_xor(ss, o); }
            const float m = s * (1.f / D); const float var = fmaxf(ss * (1.f / D) - m * m, 0.f); const float rs = 1.f / sqrtf(var + LN_EPS);
            if (MODE == 1 && (lane & 15) == 0) { f32x2_t o = {m, rs}; *(f32x2_t*)(rstat + (size_t)(row0 + (lane >> 4)) * 2) = o; }
#pragma unroll
            for (int u = 0; u < RU; ++u) { mean[u] = __shfl(m, 16 * u); rstd[u] = __shfl(rs, 16 * u); }
        }
        const int b = row0 >> 11;
#pragma unroll
        for (int j = 0; j < 2; ++j)
#pragma unroll
            for (int q = 0; q < 2; ++q) {
                const int col = 8 * lane + 512 * j + 4 * q;
                f32x4 g = {1.f, 1.f, 1.f, 1.f}, bb = {0.f, 0.f, 0.f, 0.f}, sh = bb, scl = bb;
                if (MODE != 0) { g = *(const f32x4*)(lg + col); bb = *(const f32x4*)(lb + col); }
                if (MODE != 2) { sh = *(const f32x4*)(mod + (size_t)b * 3072 + col); scl = *(const f32x4*)(mod + (size_t)b * 3072 + 1024 + col); }
#pragma unroll
                for (int u = 0; u < RU; ++u) {
                    f32x4 w = v[u][j][q];
                    if (MODE != 0) w = (w - mean[u]) * rstd[u] * g + bb;
                    if (MODE == 2) *(f32x4*)(P.out + (size_t)(row0 + u) * D + col) = w;
                    else v[u][j][q] = w * (scl + 1.f) + sh;
                }
            }
        if (MODE != 2) {
#pragma unroll
            for (int u = 0; u < RU; ++u)
#pragma unroll
                for (int j = 0; j < 2; ++j) {
                    const f32x4 a = v[u][j][0], c = v[u][j][1];
                    u32x4 o; o.x = pk2(a[0], a[1]); o.y = pk2(a[2], a[3]); o.z = pk2(c[0], c[1]); o.w = pk2(c[2], c[3]);
                    *(u32x4*)(hb + (size_t)(row0 + u) * D + 8 * lane + 512 * j) = o;
                }
        }
    }
}

constexpr int VT_PITCH = 272;
constexpr int SG_OST = 36;
DI int vt_off(int ch) { return ch * VT_PITCH + (ch >> 6) * 32; }
DI void sgu_unit(const Params& P, int l, int unit, LAS unsigned char* lds, int tid, int lane, int wave) {
    const bf16_t* p = (const bf16_t*)(P.ws + WS_P); bf16_t* Y = (bf16_t*)(P.ws + WS_Y);
    const int tok0 = unit * 128;
    {
        const int s = tid >> 2, qd = tid & 3;
        const bf16_t* vp = p + (size_t)(tok0 + s) * NP + C_VS + qd * 64;
        u32x4 raw[8];
#pragma unroll
        for (int c = 0; c < 8; ++c) raw[c] = *(const u32x4*)(vp + 8 * c);
        float sm = 0.f, sq = 0.f;
#pragma unroll
        for (int c = 0; c < 8; ++c) {
            const float a0 = bflo(raw[c].x), a1 = bfhi(raw[c].x), a2 = bflo(raw[c].y), a3 = bfhi(raw[c].y), a4 = bflo(raw[c].z), a5 = bfhi(raw[c].z), a6 = bflo(raw[c].w), a7 = bfhi(raw[c].w);
            sm += ((a0 + a1) + (a2 + a3)) + ((a4 + a5) + (a6 + a7));
            sq += ((a0 * a0 + a1 * a1) + (a2 * a2 + a3 * a3)) + ((a4 * a4 + a5 * a5) + (a6 * a6 + a7 * a7));
        }
        sm += __shfl_xor(sm, 1); sq += __shfl_xor(sq, 1);
        sm += __shfl_xor(sm, 2); sq += __shfl_xor(sq, 2);
        const float mean = sm * (1.f / 256.f);
        const float var = fmaxf(sq * (1.f / 256.f) - mean * mean, 0.f);
        const float rstd = 1.f / sqrtf(var + LN_EPS);
        const float* gp = P.sgu_ln_g + l * 256 + qd * 64; const float* bp = P.sgu_ln_b + l * 256 + qd * 64;
        LAS bf16_t* vt = (LAS bf16_t*)(lds + vt_off(qd * 64) + s * 2);
#pragma unroll
        for (int c = 0; c < 8; ++c) {
            const f32x4 g0 = *(const f32x4*)(gp + 8 * c), g1 = *(const f32x4*)(gp + 8 * c + 4), b0 = *(const f32x4*)(bp + 8 * c), b1 = *(const f32x4*)(bp + 8 * c + 4);
            const float a[8] = {bflo(raw[c].x), bfhi(raw[c].x), bflo(raw[c].y), bfhi(raw[c].y), bflo(raw[c].z), bfhi(raw[c].z), bflo(raw[c].w), bfhi(raw[c].w)};
#pragma unroll
            for (int e = 0; e < 8; ++e) {
                const float gg = e < 4 ? g0[e & 3] : g1[e & 3], bb = e < 4 ? b0[e & 3] : b1[e & 3];
                vt[(8 * c + e) * (VT_PITCH / 2)] = (bf16_t)(pk2((a[e] - mean) * rstd * gg + bb, 0.f) & 0xffffu);
            }
        }
    }
    const int h = wave & 3, dblk = wave >> 2, r = lane & 31, hh = lane >> 5;
    const int ch = h * 64 + 32 * dblk + r;
    const bf16_t* wb = (const bf16_t*)(P.ws + WS_SGW) + ((size_t)(l * 4 + h) * 128 + r) * 128 + 8 * hh;
    bf16x8 af[24];
#pragma unroll
    for (int ks = 0; ks < 4; ++ks)
#pragma unroll
        for (int tb = 0; tb < 4; ++tb) af[ks * 4 + tb] = *(const bf16x8*)(wb + (size_t)(32 * tb) * 128 + 16 * ks);
#pragma unroll
    for (int ks = 4; ks < 8; ++ks)
#pragma unroll
        for (int tb = 2; tb < 4; ++tb) af[16 + (ks - 4) * 2 + (tb - 2)] = *(const bf16x8*)(wb + (size_t)(32 * tb) * 128 + 16 * ks);
    __syncthreads();
    f32x16 acc[4];
#pragma unroll
    for (int tb = 0; tb < 4; ++tb)
#pragma unroll
        for (int i = 0; i < 16; ++i) acc[tb][i] = 0.f;
#pragma unroll
    for (int ks = 0; ks < 8; ++ks) {
        const bf16x8 bfrag = *(const LAS bf16x8*)(lds + vt_off(ch) + (16 * ks + 8 * hh) * 2);
#pragma unroll
        for (int tb = (ks < 4 ? 0 : 2); tb < 4; ++tb)
            acc[tb] = MFMA32(ks < 4 ? af[ks * 4 + tb] : af[16 + (ks - 4) * 2 + (tb - 2)], bfrag, acc[tb]);
    }
    const int erow = lane >> 2, edc = lane & 3;
    const size_t ecol = (size_t)h * 64 + 32 * dblk + edc * 8;
    u32x4 uu[8], gg[8];
#pragma unroll
    for (int k = 0; k < 8; ++k) {
        const size_t tok = (size_t)(tok0 + erow + 16 * k);
        uu[k] = *(const u32x4*)(p + tok * NP + C_U + ecol); gg[k] = *(const u32x4*)(p + tok * NP + C_GB + ecol);
    }
    __syncthreads();
    LAS float* ost = (LAS float*)(lds + wave * (64 * SG_OST * 4));
    const float* sb = P.sgu_b + (l * 4 + h) * 128;
#pragma unroll
    for (int half = 0; half < 2; ++half) {
#pragma unroll
        for (int tb2 = 0; tb2 < 2; ++tb2)
#pragma unroll
            for (int i = 0; i < 16; ++i) ost[(32 * tb2 + crow(i, hh)) * SG_OST + r] = acc[2 * half + tb2][i];
#pragma unroll
        for (int it = 0; it < 4; ++it) {
            const int k = 4 * half + it, t = erow + 16 * k;
            const LAS float* op = ost + (erow + 16 * it) * SG_OST + edc * 8;
            const f32x4 a = *(const LAS f32x4*)op, b = *(const LAS f32x4*)(op + 4);
            const float bias = sb[t];
            const u32x4 u = uu[k], g = gg[k];
            u32x4 w;
            w.x = pk2(bflo(u.x) * (a[0] + bias) * silu_f(bflo(g.x)), bfhi(u.x) * (a[1] + bias) * silu_f(bfhi(g.x)));
            w.y = pk2(bflo(u.y) * (a[2] + bias) * silu_f(bflo(g.y)), bfhi(u.y) * (a[3] + bias) * silu_f(bfhi(g.y)));
            w.z = pk2(bflo(u.z) * (b[0] + bias) * silu_f(bflo(g.z)), bfhi(u.z) * (b[1] + bias) * silu_f(bfhi(g.z)));
            w.w = pk2(bflo(u.w) * (b[2] + bias) * silu_f(bflo(g.w)), bfhi(u.w) * (b[3] + bias) * silu_f(bfhi(g.w)));
            *(u32x4*)(Y + (size_t)(tok0 + t) * D + 256 + ecol) = w;
        }
    }
    __syncthreads();
}

typedef short v4i16_t __attribute__((ext_vector_type(4)));
DI v4i16_t lds_tr16(const LAS unsigned char* p) { return __builtin_amdgcn_ds_read_tr16_b64_v4i16((LAS v4i16_t*)p); }
constexpr int OST_PITCH = 68;
DI void tile_epilogue(const f32x16& o0, const f32x16& o1, LAS float* ost, int lane, const bf16_t* grow  , bf16_t* yrow, const float* colscale) {
    const int r = lane & 31, hh = lane >> 5;
#pragma unroll
    for (int i = 0; i < 16; ++i) { ost[crow(i, hh) * OST_PITCH + r] = o0[i]; ost[crow(i, hh) * OST_PITCH + 32 + r] = o1[i]; }
#pragma unroll
    for (int it = 0; it < 4; ++it) {
        const int c = lane + 64 * it, q = c >> 3, dc = c & 7;
        const u32x4 g = *(const u32x4*)(grow + (size_t)q * NP + dc * 8);
        const f32x4 a = *(const LAS f32x4*)(ost + q * OST_PITCH + dc * 8), b = *(const LAS f32x4*)(ost + q * OST_PITCH + dc * 8 + 4);
        f32x4 s0 = {1.f, 1.f, 1.f, 1.f}, s1 = s0;
        if (colscale) { s0 = *(const f32x4*)(colscale + dc * 8); s1 = *(const f32x4*)(colscale + dc * 8 + 4); }
        u32x4 w;
        w.x = pk2(a[0] * s0[0] * silu_f(bflo(g.x)), a[1] * s0[1] * silu_f(bfhi(g.x)));
        w.y = pk2(a[2] * s0[2] * silu_f(bflo(g.y)), a[3] * s0[3] * silu_f(bfhi(g.y)));
        w.z = pk2(b[0] * s1[0] * silu_f(bflo(g.z)), b[1] * s1[1] * silu_f(bfhi(g.z)));
        w.w = pk2(b[2] * s1[2] * silu_f(bflo(g.w)), b[3] * s1[3] * silu_f(bfhi(g.w)));
        *(u32x4*)(yrow + (size_t)q * D + dc * 8) = w;
    }
}

constexpr int PA_PITCH = 144;
DI void pool_wave(const Params& P, int l, int gw, int NGW, int lane, LAS unsigned char* wl) {
    const bf16_t* p = (const bf16_t*)(P.ws + WS_P); bf16_t* Y = (bf16_t*)(P.ws + WS_Y);
    const int g = gw & 3, r = lane & 31, hh = lane >> 5;
    const int win = 2 << g;
    LAS float* ost = (LAS float*)(wl + 7168);
    bf16x8 bw[4][2];
#pragma unroll
    for (int s = 0; s < 4; ++s)
#pragma unroll
        for (int db = 0; db < 2; ++db) {
            const float* wp = P.pool_w + ((size_t)(l * 4 + g) * 64 + 16 * s + 8 * hh) * 64 + 32 * db + r;
            u32x4 a; a.x = pk2(wp[0], wp[64]); a.y = pk2(wp[128], wp[192]); a.z = pk2(wp[256], wp[320]); a.w = pk2(wp[384], wp[448]);
            bw[s][db] = __builtin_bit_cast(bf16x8, a);
        }
    for (int tile = gw >> 2; tile < MTOK / 32; tile += NGW >> 2) {
        const int tok0 = tile * 32, pos0 = tok0 & (SEQ - 1), pos = pos0 + r;
#pragma unroll
        for (int it = 0; it < 6; ++it) {
            const int c = lane + 64 * it, row = c >> 3, dc = c & 7;
            u32x4 v = {0u, 0u, 0u, 0u};
            if (row >= 16 || pos0 != 0) v = *(const u32x4*)(p + (size_t)(tok0 - 16 + row) * NP + C_A + g * 64 + dc * 8);
            *(LAS u32x4*)(wl + row * PA_PITCH + dc * 16) = v;
        }
        const int cnt = (pos + 1 < win) ? pos + 1 : win;
        const float inv = 1.f / (float)cnt;
        f32x16 acc0, acc1;
#pragma unroll
        for (int i = 0; i < 16; ++i) { acc0[i] = 0.f; acc1[i] = 0.f; }
#pragma unroll
        for (int s = 0; s < 4; ++s) {
            const LAS unsigned char* base = wl + (16 + r) * PA_PITCH + (16 * s + 8 * hh) * 2;
            const u32x4 own = *(const LAS u32x4*)base;
            float sum[8];
            sum[0] = bflo(own.x); sum[1] = bfhi(own.x); sum[2] = bflo(own.y); sum[3] = bfhi(own.y); sum[4] = bflo(own.z); sum[5] = bfhi(own.z); sum[6] = bflo(own.w); sum[7] = bfhi(own.w);
            for (int j = 1; j < win; ++j) {
                const u32x4 v = *(const LAS u32x4*)(base - j * PA_PITCH);
                sum[0] += bflo(v.x); sum[1] += bfhi(v.x); sum[2] += bflo(v.y); sum[3] += bfhi(v.y); sum[4] += bflo(v.z); sum[5] += bfhi(v.z); sum[6] += bflo(v.w); sum[7] += bfhi(v.w);
            }
            u32x4 a;
            a.x = pk2(sum[0] * inv - bflo(own.x), sum[1] * inv - bfhi(own.x)); a.y = pk2(sum[2] * inv - bflo(own.y), sum[3] * inv - bfhi(own.y));
            a.z = pk2(sum[4] * inv - bflo(own.z), sum[5] * inv - bfhi(own.z)); a.w = pk2(sum[6] * inv - bflo(own.w), sum[7] * inv - bfhi(own.w));
            const bf16x8 af = __builtin_bit_cast(bf16x8, a);
            acc0 = MFMA32(af, bw[s][0], acc0);
            acc1 = MFMA32(af, bw[s][1], acc1);
        }
        tile_epilogue(acc0, acc1, ost, lane, p + (size_t)tok0 * NP + C_GA + g * 64, Y + (size_t)tok0 * D + g * 64, P.pool_scale + l * 256 + g * 64);
    }
}

constexpr int KT_PITCH = 144;
constexpr int VT_OFF = 32 * KT_PITCH;
DI void attn_wave(const Params& P, int gw, int NGW, int lane, LAS unsigned char* wl) {
    const bf16_t* p = (const bf16_t*)(P.ws + WS_P); bf16_t* Y = (bf16_t*)(P.ws + WS_Y);
    constexpr int NU = BATCH * 8 * 64;
    const int r = lane & 31, hh = lane >> 5;
    LAS float* ost = (LAS float*)wl;
    const int klds = (lane >> 3) * KT_PITCH + (lane & 7) * 16;
    const int vlds = VT_OFF + ((lane & 7) >> 2) * 2048 + (lane >> 3) * 64 + (lane & 3) * 16;
    const int frd = r * KT_PITCH + hh * 16;
    const int trbase = VT_OFF + (4 * hh + ((lane & 15) >> 2)) * 64 + ((lane >> 4) & 1) * 32 + (lane & 3) * 8;
    const float CZ = 0.125f * LOG2E;
    const bool xmap = (gridDim.x == 256);
    const int xlw = (int)(blockIdx.x >> 3) * 8 + (gw & 7), xbase = (int)(blockIdx.x & 7) * 32 + (xlw >> 6);
    int round = 0;
    int unit = xmap ? ((xbase << 6) | (xlw & 63)) : gw;
    if (unit >= NU) return;
    const bf16_t* qb = (const bf16_t*)(P.ws + WS_QKV); const bf16_t* kbuf = qb + QKV_ONE; const bf16_t* vbuf = qb + 2 * QKV_ONE;
    size_t pairoff = (size_t)(unit >> 6) * QKV_PAIR + (size_t)lane * 8;
    size_t goff = ((size_t)(unit >> 9) * SEQ + (lane >> 3)) * NP + C_GC + ((unit >> 6) & 7) * 64 + (lane & 7) * 8;
    u32x4 qv[4], gt[4], kn[4], vn[4];
    {
        const size_t o = pairoff + (size_t)(unit & 63) * 2048;
#pragma unroll
        for (int it = 0; it < 4; ++it) qv[it] = *(const u32x4*)(qb + o + it * 512);
#pragma unroll
        for (int it = 0; it < 4; ++it) kn[it] = *(const u32x4*)(kbuf + o + it * 512);
#pragma unroll
        for (int it = 0; it < 4; ++it) vn[it] = *(const u32x4*)(vbuf + o + it * 512);
#pragma unroll
        for (int it = 0; it < 4; ++it) gt[it] = *(const u32x4*)(p + goff + (size_t)((unit & 63) * 32 + it * 8) * NP);
    }
    for (;;) {
        const int qt = unit & 63, h = (unit >> 6) & 7, b = unit >> 9;
        const size_t tokb = (size_t)b * SEQ;
        const bf16_t* kp0 = kbuf + pairoff; const bf16_t* vp0 = vbuf + pairoff;
        bf16x8 qf[4];
#pragma unroll
        for (int it = 0; it < 4; ++it) *(LAS u32x4*)(wl + klds + it * 8 * KT_PITCH) = qv[it];
#pragma unroll
        for (int s = 0; s < 4; ++s) qf[s] = *(const LAS bf16x8*)(wl + frd + s * 32);
        f32x16 o0, o1;
#pragma unroll
        for (int i = 0; i < 16; ++i) { o0[i] = 0.f; o1[i] = 0.f; }
        float carry = 0.f;
        for (int kb = qt; kb >= 0; --kb) {
#pragma unroll
            for (int it = 0; it < 4; ++it) *(LAS u32x4*)(wl + klds + it * 8 * KT_PITCH) = kn[it];
#pragma unroll
            for (int it = 0; it < 4; ++it) *(LAS u32x4*)(wl + vlds + it * 512) = vn[it];
            if (kb > 0) {
                const size_t o = (size_t)(kb - 1) * 2048;
#pragma unroll
                for (int it = 0; it < 4; ++it) kn[it] = *(const u32x4*)(kp0 + o + it * 512);
#pragma unroll
                for (int it = 0; it < 4; ++it) vn[it] = *(const u32x4*)(vp0 + o + it * 512);
            }
            f32x16 z;
#pragma unroll
            for (int i = 0; i < 16; ++i) z[i] = 0.f;
#pragma unroll
            for (int s = 0; s < 4; ++s) { const bf16x8 kf = *(const LAS bf16x8*)(wl + frd + s * 32); z = MFMA32(kf, qf[s], z); }
            float l1m[16], lbv[16];
#pragma unroll
            for (int i = 0; i < 16; ++i) {
                const float t = z[i] * CZ;
                const float e = __builtin_amdgcn_exp2f(-fabsf(t));
                const float sp = fmaxf(t, 0.f) + __builtin_amdgcn_logf(1.f + e);
                l1m[i] = -sp; lbv[i] = t - sp;
            }
            if (kb == qt) {
#pragma unroll
                for (int i = 0; i < 16; ++i) if (crow(i, hh) >= r) { l1m[i] = 0.f; lbv[i] = -__builtin_inff(); }
            }
            float gs[4], og[4];
#pragma unroll
            for (int q = 0; q < 4; ++q) { gs[q] = (l1m[4 * q] + l1m[4 * q + 1]) + (l1m[4 * q + 2] + l1m[4 * q + 3]); og[q] = swap32(gs[q], hh); }
            float suf = carry;
            float a[16];
#pragma unroll
            for (int q = 3; q >= 0; --q) {
                float lat = suf + (hh == 0 ? og[q] : 0.f);
                a[4 * q + 3] = __builtin_amdgcn_exp2f(lbv[4 * q + 3] + lat); lat += l1m[4 * q + 3];
                a[4 * q + 2] = __builtin_amdgcn_exp2f(lbv[4 * q + 2] + lat); lat += l1m[4 * q + 2];
                a[4 * q + 1] = __builtin_amdgcn_exp2f(lbv[4 * q + 1] + lat); lat += l1m[4 * q + 1];
                a[4 * q] = __builtin_amdgcn_exp2f(lbv[4 * q] + lat);
                suf += gs[q] + og[q];
            }
            carry = suf;
            u32x4 pa0, pa1;
            pa0.x = pk2(a[0], a[1]); pa0.y = pk2(a[2], a[3]); pa0.z = pk2(a[4], a[5]); pa0.w = pk2(a[6], a[7]);
            pa1.x = pk2(a[8], a[9]); pa1.y = pk2(a[10], a[11]); pa1.z = pk2(a[12], a[13]); pa1.w = pk2(a[14], a[15]);
            bf16x8 vf[2][2];
#pragma unroll
            for (int s = 0; s < 2; ++s)
#pragma unroll
                for (int db = 0; db < 2; ++db) {
                    const v4i16_t lo = lds_tr16(wl + trbase + db * 2048 + (16 * s) * 64), hi = lds_tr16(wl + trbase + db * 2048 + (16 * s + 8) * 64);
                    vf[s][db] = __builtin_shufflevector(lo, hi, 0, 1, 2, 3, 4, 5, 6, 7);
                }
            o0 = MFMA32(__builtin_bit_cast(bf16x8, pa0), vf[0][0], o0);
            o0 = MFMA32(__builtin_bit_cast(bf16x8, pa1), vf[1][0], o0);
            o1 = MFMA32(__builtin_bit_cast(bf16x8, pa0), vf[0][1], o1);
            o1 = MFMA32(__builtin_bit_cast(bf16x8, pa1), vf[1][1], o1);
            if (__ballot(carry > -160.f) == 0ull) break;
        }
        ++round;
        const int nxt = xmap ? (((xbase + 4 * round) << 6) | (xlw & 63)) : unit + NGW;
        const bool has_next = xmap ? (round < 8) : (nxt < NU);
        size_t pairoff_n = pairoff, goff_n = goff;
        if (has_next) {
            pairoff_n = (size_t)(nxt >> 6) * QKV_PAIR + (size_t)lane * 8;
            goff_n = ((size_t)(nxt >> 9) * SEQ + (lane >> 3)) * NP + C_GC + ((nxt >> 6) & 7) * 64 + (lane & 7) * 8;
            const size_t o = pairoff_n + (size_t)(nxt & 63) * 2048;
#pragma unroll
            for (int it = 0; it < 4; ++it) qv[it] = *(const u32x4*)(qb + o + it * 512);
#pragma unroll
            for (int it = 0; it < 4; ++it) kn[it] = *(const u32x4*)(kbuf + o + it * 512);
#pragma unroll
            for (int it = 0; it < 4; ++it) vn[it] = *(const u32x4*)(vbuf + o + it * 512);
        }
#pragma unroll
        for (int i = 0; i < 16; ++i) { ost[crow(i, hh) * OST_PITCH + r] = o0[i]; ost[crow(i, hh) * OST_PITCH + 32 + r] = o1[i]; }
        bf16_t* yp0 = Y + (tokb + qt * 32 + (lane >> 3)) * D + 512 + h * 64 + (lane & 7) * 8;
#pragma unroll
        for (int it = 0; it < 4; ++it) {
            const LAS float* op = ost + ((lane >> 3) + 8 * it) * OST_PITCH + (lane & 7) * 8;
            const f32x4 a = *(const LAS f32x4*)op, bq = *(const LAS f32x4*)(op + 4);
            const u32x4 g = gt[it];
            u32x4 w;
            w.x = pk2(a[0] * silu_f(bflo(g.x)), a[1] * silu_f(bfhi(g.x)));
            w.y = pk2(a[2] * silu_f(bflo(g.y)), a[3] * silu_f(bfhi(g.y)));
            w.z = pk2(bq[0] * silu_f(bflo(g.z)), bq[1] * silu_f(bfhi(g.z)));
            w.w = pk2(bq[2] * silu_f(bflo(g.w)), bq[3] * silu_f(bfhi(g.w)));
            *(u32x4*)(yp0 + (size_t)it * 8 * D) = w;
        }
        if (!has_next) break;
        {
#pragma unroll
            for (int it = 0; it < 4; ++it) gt[it] = *(const u32x4*)(p + goff_n + (size_t)((nxt & 63) * 32 + it * 8) * NP);
        }
        unit = nxt; pairoff = pairoff_n; goff = goff_n;
    }
}

DI void mixers(const Params& P, int l, LAS unsigned char* lds, int lane, int wave) {
    lane = launder_v(lane); wave = launder_s(wave);
    const int gw = blockIdx.x * NWAVES + wave, NGW = gridDim.x * NWAVES;
#ifndef MXMASK
#define MXMASK 7
#endif
    for (int rep = 0; rep < ((DUP & 4) ? 2 : 1); ++rep)
    if (MXMASK & 1) for (int unit = blockIdx.x; unit < BATCH * 16; unit += gridDim.x) sgu_unit(P, l, unit, lds, launder_v(threadIdx.x), lane, wave);
    for (int rep = 0; rep < ((DUP & 8) ? 2 : 1); ++rep)
    if (MXMASK & 2) pool_wave(P, l, gw, NGW, lane, lds + wave * 16384);
    for (int rep = 0; rep < ((DUP & 16) ? 2 : 1); ++rep)
    if (MXMASK & 4) attn_wave(P, gw, NGW, lane, lds + wave * 16384);
}

__global__ void __launch_bounds__(NTHREADS, 2) fwd_mega(Params P) {
    extern __shared__ __attribute__((aligned(16))) unsigned char lds_raw[];
    LAS unsigned char* lds = (LAS unsigned char*)lds_raw;
    cg::grid_group grid = cg::this_grid();
    const int tid = threadIdx.x, lane = tid & 63, wave = __builtin_amdgcn_readfirstlane(tid >> 6);
    const int lo = P.ph_lo, hi = P.ph_hi;
#ifndef PHMASK
#define PHMASK 0x3ff
#endif
#define IN(k) (((PHMASK >> (k)) & 1) && lo <= (k) && (k) < hi)
#define SEAM(k) do { if (IN(k) && IN((k) + 1)) grid.sync(); } while (0)
    bf16_t* hb = (bf16_t*)(P.ws + WS_HB); bf16_t* pbuf = (bf16_t*)(P.ws + WS_P); bf16_t* ybuf = (bf16_t*)(P.ws + WS_Y);
    const bf16_t* win_t = (const bf16_t*)(P.ws + WS_WIN); const bf16_t* wout_t = (const bf16_t*)(P.ws + WS_WOUT);
    const float* mod = (const float*)(P.ws + WS_MOD);

    if (IN(0)) for (int rep = 0; rep < ((DUP & 64) ? 2 : 1); ++rep) phase0(P, lds, tid, lane, wave);
    SEAM(0);
    if (IN(1)) for (int rep = 0; rep < ((DUP & 32) ? 2 : 1); ++rep) row_pass<0>(P, lane, wave);
    SEAM(1);
#pragma unroll 1
    for (int l = 0; l < DEPTH; ++l) {
        const int pb = 2 + 4 * l;
        if (IN(pb)) for (int rep = 0; rep < ((DUP & 1) ? 2 : 1); ++rep) {
            pg8::Gemm g{hb, win_t + (size_t)l * NIN * D, MTOK, NIN, D}; pg8::StaticOrder S; S.init(MTOK, NIN, (int)gridDim.x, (int)blockIdx.x);
            EpiP E{pbuf, (bf16_t*)(P.ws + WS_QKV)};
            pg8::gemm_phase<EpiP, pg8::StaticOrder, true, true>(lds, g, S, E);
        }
        SEAM(pb);
        if (IN(pb + 1)) mixers(P, l, lds, lane, wave);
        SEAM(pb + 1);
        if (IN(pb + 2)) for (int rep = 0; rep < ((DUP & 2) ? 2 : 1); ++rep) {
            pg8::Gemm g{ybuf, wout_t + (size_t)l * D * D, MTOK, D, D}; pg8::StaticOrder S; S.init(MTOK, D, (int)gridDim.x, (int)blockIdx.x);
            EpiRes E{P.x, l == 0 ? nullptr : (const bf16_t*)(P.ws + WS_R0), (const float*)(P.ws + WS_RSTAT), P.ln_g, P.ln_b,
                     mod + (size_t)l * BATCH * 3072 + 2048, (bf16_t*)(P.ws + (l == 0 ? WS_R0 : WS_R1)), (float*)(P.ws + WS_PSTAT)};
            pg8::gemm_phase<EpiRes, pg8::StaticOrder, true, true>(lds, g, S, E);
        }
        SEAM(pb + 2);
        if (IN(pb + 3)) { if (l == 0) { for (int rep = 0; rep < ((DUP & 32) ? 2 : 1); ++rep) row_pass<1>(P, lane, wave); } else row_pass<2>(P, lane, wave); }
        SEAM(pb + 3);
    }
#undef IN
#undef SEAM
}

#ifndef N_LAUNCH_PER_PHASE
#define N_LAUNCH_PER_PHASE 0
#endif
extern "C" void kernel_launch(void* const* d_in, const int* in_sizes, int n_in, void* d_out, int out_size, void* d_ws, size_t ws_size, hipStream_t stream) {
    static int grid = 0;
    if (grid == 0) {
        if (n_in != 14 || out_size != MTOK * D || ws_size < WS_END) { fprintf(stderr, "kernel_launch: unexpected shapes (n_in %d out %d ws %zu need %zu)\n", n_in, out_size, ws_size, (size_t)WS_END); grid = -1; return; }
        int dev = 0, cus = 0, per_cu = 0;
        hipGetDevice(&dev);
        hipDeviceGetAttribute(&cus, hipDeviceAttributeMultiprocessorCount, dev);
        if (hipFuncSetAttribute((const void*)fwd_mega, hipFuncAttributeMaxDynamicSharedMemorySize, LDS_BYTES) != hipSuccess) { fprintf(stderr, "kernel_launch: hipFuncSetAttribute failed\n"); grid = -1; return; }
        if (hipOccupancyMaxActiveBlocksPerMultiprocessor(&per_cu, (const void*)fwd_mega, NTHREADS, LDS_BYTES) != hipSuccess || per_cu < 1) { fprintf(stderr, "kernel_launch: occupancy query says %d\n", per_cu); per_cu = 1; }
        (void)hipGetLastError();
        grid = cus * 1;
        if (grid != 256) fprintf(stderr, "kernel_launch: note: grid %d\n", grid);
    }
    if (grid < 0) return;
    Params p{};
    p.x = (const float*)d_in[0]; p.c = (const float*)d_in[1]; p.w_in = (const float*)d_in[2]; p.pool_w = (const float*)d_in[3]; p.pool_scale = (const float*)d_in[4];
    p.sgu_ln_g = (const float*)d_in[5]; p.sgu_ln_b = (const float*)d_in[6]; p.sgu_w = (const float*)d_in[7]; p.sgu_b = (const float*)d_in[8]; p.w_out = (const float*)d_in[9];
    p.ada_w = (const float*)d_in[10]; p.ada_b = (const float*)d_in[11]; p.ln_g = (const float*)d_in[12]; p.ln_b = (const float*)d_in[13];
    p.out = (float*)d_out; p.ws = (unsigned char*)d_ws;
#if N_LAUNCH_PER_PHASE
    for (int ph = 0; ph < 10; ++ph) {
        p.ph_lo = ph; p.ph_hi = ph + 1;
        hipLaunchKernelGGL(fwd_mega, dim3(grid), dim3(NTHREADS), LDS_BYTES, stream, p);
    }
#else
    p.ph_lo = 0; p.ph_hi = 10;
    void* args[] = {&p};
    hipError_t e = hipLaunchCooperativeKernel((const void*)fwd_mega, dim3(grid), dim3(NTHREADS), args, LDS_BYTES, stream);
    if (e != hipSuccess) fprintf(stderr, "kernel_launch: cooperative launch failed: %s (grid %d)\n", hipGetErrorString(e), grid);
#endif
}
```

```cpp
#include <hip/hip_runtime.h>
#include <hip/hip_cooperative_groups.h>
#include <cstdio>
#include <cstdint>
namespace cg = cooperative_groups;
__device__ __forceinline__ int launder_v(int x) { asm volatile("" : "+v"(x)); return x; }
__device__ __forceinline__ int launder_s(int x) { asm volatile("" : "+s"(x)); return x; }
namespace pg8 {
#define PG8_LAS __attribute__((address_space(3)))
typedef unsigned short bf16_t;
typedef short bf16x8 __attribute__((ext_vector_type(8)));
typedef float f32x4 __attribute__((ext_vector_type(4)));
typedef unsigned u32x4 __attribute__((ext_vector_type(4)));
constexpr int BM = 256, BK = 64, HALF = 128, HTB = HALF * BK * 2  , STAGE_BYTES = 8 * HTB, NXCD = 8, WGM = 8;

__host__ __device__ __forceinline__ int lds_byte(int r, int c) { const int st = (r >> 4) * 2 + (c >> 5), rr = r & 15, cc = c & 31, ob = rr * 64 + cc * 2; return st * 1024 + (ob ^ (((ob >> 9) & 1) << 5)); }
__host__ __device__ __forceinline__ void stage_rc(int b, int& R, int& C) { const int st = b / 1024, sb = b % 1024, swz = sb ^ (((sb >> 9) & 1) << 5); R = (st >> 1) * 16 + swz / 64; C = (st & 1) * 32 + (swz % 64) / 2; }
__host__ __device__ __forceinline__ int perm32(int rho) { const int n = rho >> 4, i = rho & 15; return 8 * (i >> 2) + 4 * n + (i & 3); }

struct Unit { int pm, pn; };
struct Gemm { const bf16_t* A; const bf16_t* Bt; int M, N, K; };

struct StaticOrder {
    int nM, nN, nwg, G, c;
    __host__ __device__ void init(int M, int N, int G_, int c_) { nM = M / BM; nN = N / BM; nwg = nM * nN; G = G_; c = c_; }
    __host__ __device__ bool next(int i, Unit& u) const {
        const long L = (long)i * G + c; if (L >= nwg) return false;
        int wgid = (int)L; { const int q = nwg / NXCD, r = nwg % NXCD, xcd = wgid % NXCD, off = wgid / NXCD; wgid = (xcd < r ? xcd * (q + 1) : r * (q + 1) + (xcd - r) * q) + off; }
        const int nig = WGM * nN, gid = wgid / nig, fm = gid * WGM, gsz = (nM - fm) < WGM ? (nM - fm) : WGM;
        u.pm = fm + ((wgid % nig) % gsz); u.pn = (wgid % nig) / gsz; return true;
    }
    __device__ __forceinline__ void a_ready(const Unit&) const {}
    __device__ __forceinline__ void done(const Unit&) const {}
};

__device__ __forceinline__ unsigned cvt_pk_bf16(float lo, float hi) { unsigned r; asm volatile("v_cvt_pk_bf16_f32 %0, %1, %2" : "=v"(r) : "v"(lo), "v"(hi)); return r; }
template <class Epi, class Sched, bool ALIGN_EPI = false, bool SP2 = false>
__device__ __forceinline__ void gemm_phase(PG8_LAS unsigned char* lds, const Gemm g, const Sched& S, const Epi& E) {
    const int tid = launder_v(threadIdx.x), wid = __builtin_amdgcn_readfirstlane(tid >> 6), lane = tid & 63, wr = wid >> 2, wc = wid & 3, fr = lane & 15, fq = lane >> 4;
    const int K = g.K, nt = K / BK;
    unsigned voffA[2], voffB[2];
#pragma unroll
    for (int i = 0; i < 2; ++i) { int R, C; stage_rc(tid * 16 + i * 8192, R, C); const int Rb = Epi::PERM ? ((R & ~31) + perm32(R & 31)) : R;
        voffA[i] = (unsigned)(R * K + C) * 2u; voffB[i] = (unsigned)(Rb * K + C) * 2u; }
    const size_t kstep = (size_t)(BK * 2);
    const size_t hstep = (size_t)HALF * K * 2;
    const size_t tstep = 2 * hstep;
    const unsigned ldsw = (unsigned)wid * 1024u;
    const int aoff = lds_byte(wr * 64 + fr, fq * 8), boff = lds_byte(wc * 32 + fr, fq * 8);
#define PG8_SA(b, h) (((b) * 2 + (h)) * HTB)
#define PG8_SB(b, h) ((4 + (b) * 2 + (h)) * HTB)
#define PG8_STAGE(bufoff, gbase, voff) do { _Pragma("unroll") for (int _i = 0; _i < 2; ++_i) \
        __builtin_amdgcn_global_load_lds((const unsigned*)((const char*)(gbase) + (voff)[_i]), (PG8_LAS unsigned*)(lds + (bufoff) + ldsw + _i * 8192), 16, 0, 0); } while (0)
#define PG8_LDA(dst, b, h) do { _Pragma("unroll") for (int m = 0; m < 4; ++m) _Pragma("unroll") for (int k = 0; k < 2; ++k) dst[m][k] = *(const PG8_LAS bf16x8*)(lds + PG8_SA(b, h) + aoff + m * 2048 + k * 1024); } while (0)
#define PG8_LDB(dst, b, h) do { _Pragma("unroll") for (int n = 0; n < 2; ++n) _Pragma("unroll") for (int k = 0; k < 2; ++k) dst[n][k] = *(const PG8_LAS bf16x8*)(lds + PG8_SB(b, h) + boff + n * 2048 + k * 1024); } while (0)
#define PG8_MMA(ai, bj, At, Bt) do { __builtin_amdgcn_s_setprio(1); _Pragma("unroll") for (int m = 0; m < 4; ++m) _Pragma("unroll") for (int n = 0; n < 2; ++n) _Pragma("unroll") for (int k = 0; k < 2; ++k) \
        acc[ai][bj][m][n] = __builtin_amdgcn_mfma_f32_16x16x32_bf16(Bt[n][k], At[m][k], acc[ai][bj][m][n], 0, 0, 0); __builtin_amdgcn_s_setprio(0); } while (0)
#define PG8_WAIT_V(n) asm volatile("s_waitcnt vmcnt(" #n ")" ::: "memory")
#define PG8_WAIT_L(n) asm volatile("s_waitcnt lgkmcnt(" #n ")" ::: "memory")
#define PG8_BAR __builtin_amdgcn_s_barrier()
#define PG8_SCHED __builtin_amdgcn_sched_barrier(0)
    Unit cur, nxt; int ui = 0;
    if (!S.next(0, cur)) return;
    f32x4 acc[2][2][4][2];
#pragma unroll
    for (int a = 0; a < 2; ++a)
#pragma unroll
        for (int b = 0; b < 2; ++b)
#pragma unroll
            for (int m = 0; m < 4; ++m)
#pragma unroll
                for (int n = 0; n < 2; ++n) acc[a][b][m][n] = (f32x4){0.f, 0.f, 0.f, 0.f};
    bf16x8 At[4][2], B0[2][2], B1[2][2];
    const char* cA = (const char*)g.A + (size_t)cur.pm * tstep; const char* cB = (const char*)g.Bt + (size_t)cur.pn * tstep;
    S.a_ready(cur);
    if constexpr (SP2) {
        PG8_STAGE(PG8_SB(0, 0), cB, voffB); PG8_STAGE(PG8_SB(0, 1), cB + hstep, voffB); PG8_STAGE(PG8_SA(0, 0), cA, voffA); PG8_STAGE(PG8_SA(0, 1), cA + hstep, voffA);
        if (wr == 1) PG8_BAR;
        PG8_WAIT_V(2); PG8_BAR;
        PG8_STAGE(PG8_SB(1, 0), cB + kstep, voffB); PG8_STAGE(PG8_SA(1, 0), cA + kstep, voffA); PG8_STAGE(PG8_SB(1, 1), cB + hstep + kstep, voffB);
        PG8_WAIT_V(6); PG8_BAR;
    } else {
        PG8_STAGE(PG8_SB(0, 0), cB, voffB); PG8_STAGE(PG8_SA(0, 0), cA, voffA); PG8_STAGE(PG8_SB(0, 1), cB + hstep, voffB); PG8_STAGE(PG8_SA(0, 1), cA + hstep, voffA);
        if (wr == 1) PG8_BAR;
        PG8_WAIT_V(4); PG8_BAR;
        PG8_STAGE(PG8_SB(1, 0), cB + kstep, voffB); PG8_STAGE(PG8_SA(1, 0), cA + kstep, voffA); PG8_STAGE(PG8_SB(1, 1), cB + hstep + kstep, voffB);
        PG8_WAIT_V(6); PG8_BAR;
    }
    for (;;) {
        const bool has_next = S.next(ui + 1, nxt);
        const char* nA = has_next ? (const char*)g.A + (size_t)nxt.pm * tstep : cA; const char* nB = has_next ? (const char*)g.Bt + (size_t)nxt.pn * tstep : cB;
        for (int t = 0; t < nt; t += 2) {
            const bool last = (t == nt - 2);
            const char* a1 = cA + (size_t)(t + 1) * kstep;
            const char* a2 = last ? nA : cA + (size_t)(t + 2) * kstep; const char* b2 = last ? nB : cB + (size_t)(t + 2) * kstep;
            const char* a3 = a2 + kstep; const char* b3 = b2 + kstep;
            if (last && has_next) S.a_ready(nxt);
            if constexpr (SP2) {
            PG8_LDB(B0, 0, 0); PG8_LDB(B1, 0, 1); PG8_SCHED; PG8_LDA(At, 0, 0); PG8_STAGE(PG8_SA(1, 1), a1 + hstep, voffA);
            PG8_WAIT_V(8); PG8_WAIT_L(0); PG8_BAR; PG8_MMA(0, 0, At, B0); PG8_MMA(0, 1, At, B1); PG8_BAR; PG8_SCHED;
            PG8_LDA(At, 0, 1); PG8_STAGE(PG8_SB(0, 0), b2, voffB); PG8_STAGE(PG8_SB(0, 1), b2 + hstep, voffB); PG8_STAGE(PG8_SA(0, 0), a2, voffA);
            PG8_WAIT_V(8); PG8_WAIT_L(0); PG8_BAR; PG8_MMA(1, 0, At, B0); PG8_MMA(1, 1, At, B1); PG8_BAR; PG8_SCHED;
            PG8_LDB(B0, 1, 0); PG8_LDB(B1, 1, 1); PG8_SCHED; PG8_LDA(At, 1, 0); PG8_STAGE(PG8_SA(0, 1), a2 + hstep, voffA);
            PG8_WAIT_V(8); PG8_WAIT_L(0); PG8_BAR; PG8_MMA(0, 0, At, B0); PG8_MMA(0, 1, At, B1); PG8_BAR; PG8_SCHED;
            PG8_LDA(At, 1, 1); PG8_STAGE(PG8_SB(1, 0), b3, voffB); PG8_STAGE(PG8_SB(1, 1), b3 + hstep, voffB); PG8_STAGE(PG8_SA(1, 0), a3, voffA);
            PG8_WAIT_V(8); PG8_WAIT_L(0); PG8_BAR; PG8_MMA(1, 0, At, B0); PG8_MMA(1, 1, At, B1); PG8_BAR; PG8_SCHED;
            } else {
            PG8_LDB(B0, 0, 0); PG8_SCHED; PG8_LDA(At, 0, 0); PG8_STAGE(PG8_SA(1, 1), a1 + hstep, voffA);
            PG8_WAIT_L(8); PG8_BAR; PG8_WAIT_L(0); PG8_MMA(0, 0, At, B0); PG8_BAR; PG8_SCHED;
            PG8_LDB(B1, 0, 1); PG8_STAGE(PG8_SB(0, 0), b2, voffB);
            PG8_BAR; PG8_WAIT_L(0); PG8_MMA(0, 1, At, B1); PG8_BAR;
            PG8_LDA(At, 0, 1); PG8_STAGE(PG8_SA(0, 0), a2, voffA);
            PG8_BAR; PG8_WAIT_L(0); PG8_MMA(1, 0, At, B0); PG8_BAR; PG8_SCHED;
            PG8_STAGE(PG8_SB(0, 1), b2 + hstep, voffB);
            PG8_WAIT_V(6); PG8_BAR; PG8_MMA(1, 1, At, B1); PG8_BAR;
            PG8_LDB(B0, 1, 0); PG8_SCHED; PG8_LDA(At, 1, 0); PG8_STAGE(PG8_SA(0, 1), a2 + hstep, voffA);
            PG8_WAIT_L(8); PG8_BAR; PG8_WAIT_L(0); PG8_MMA(0, 0, At, B0); PG8_BAR; PG8_SCHED;
            PG8_LDB(B1, 1, 1); PG8_STAGE(PG8_SB(1, 0), b3, voffB);
            PG8_BAR; PG8_WAIT_L(0); PG8_MMA(0, 1, At, B1); PG8_BAR;
            PG8_LDA(At, 1, 1); PG8_STAGE(PG8_SA(1, 0), a3, voffA);
            PG8_BAR; PG8_WAIT_L(0); PG8_MMA(1, 0, At, B0); PG8_BAR; PG8_SCHED;
            PG8_STAGE(PG8_SB(1, 1), b3 + hstep, voffB);
            PG8_WAIT_V(6); PG8_BAR; PG8_MMA(1, 1, At, B1); PG8_BAR;
            }
        }
        if constexpr (ALIGN_EPI) { if (wr == 0) PG8_BAR; }
        if constexpr (!Epi::AFTER_DRAIN) { E(acc, cur, wr, wc, fr, fq); S.done(cur); }
        if (!has_next) break;
#pragma unroll
        for (int a = 0; a < 2; ++a)
#pragma unroll
            for (int b = 0; b < 2; ++b)
#pragma unroll
                for (int m = 0; m < 4; ++m)
#pragma unroll
                    for (int n = 0; n < 2; ++n) acc[a][b][m][n] = (f32x4){0.f, 0.f, 0.f, 0.f};
        cur = nxt; cA = nA; cB = nB; ++ui;
        if constexpr (ALIGN_EPI) { if (wr == 1) PG8_BAR; }
    }
    PG8_WAIT_V(0);
    if constexpr (!ALIGN_EPI) { if (wr == 0) PG8_BAR; }
    PG8_BAR;
    if constexpr (Epi::AFTER_DRAIN) { E.fused(acc, cur, wr, wc, fr, fq, lds, wid, lane); S.done(cur); }
#undef PG8_SA
#undef PG8_SB
#undef PG8_STAGE
#undef PG8_LDA
#undef PG8_LDB
#undef PG8_MMA
#undef PG8_WAIT_V
#undef PG8_WAIT_L
#undef PG8_BAR
#undef PG8_SCHED
}
}

#define DI __device__ __forceinline__
#define LAS __attribute__((address_space(3)))
typedef unsigned short bf16_t;
typedef short bf16x8 __attribute__((ext_vector_type(8)));
typedef float f32x4 __attribute__((ext_vector_type(4)));
typedef float f32x16 __attribute__((ext_vector_type(16)));
typedef unsigned u32x4 __attribute__((ext_vector_type(4)));
typedef unsigned u32x2 __attribute__((ext_vector_type(2)));
typedef __bf16 bf16x2_t __attribute__((ext_vector_type(2)));
typedef float f32x2_t __attribute__((ext_vector_type(2)));

constexpr int D = 1024, BATCH = 32, SEQ = 2048, MTOK = BATCH * SEQ, NIN = 3328, DEPTH = 2;
constexpr int NP = 1792;
constexpr int C_A = 0, C_GA = 256, C_U = 512, C_VS = 768, C_GB = 1024, C_GC = 1280;
constexpr size_t QKV_PAIR = (size_t)SEQ * 64;
constexpr size_t QKV_ONE = (size_t)BATCH * 8 * QKV_PAIR;
constexpr float DN_ALPHA = 1.41421356237309515f;
constexpr float LN_EPS = 1e-5f;
constexpr float LOG2E = 1.44269504088896341f;

constexpr size_t WS_WIN = 0;
constexpr size_t WS_WOUT = WS_WIN + (size_t)DEPTH * NIN * D * 2;
constexpr size_t WS_MOD = WS_WOUT + (size_t)DEPTH * D * D * 2;
constexpr size_t WS_HB = WS_MOD + (size_t)DEPTH * BATCH * 3 * D * 4;
constexpr size_t WS_P = WS_HB + (size_t)MTOK * D * 2;
constexpr size_t WS_QKV = WS_P + (size_t)MTOK * NP * 2;
constexpr size_t WS_Y = WS_QKV + 3 * QKV_ONE * 2;
constexpr size_t WS_R0 = WS_Y + (size_t)MTOK * D * 2;
constexpr size_t WS_R1 = WS_R0 + (size_t)MTOK * D * 2;
constexpr size_t WS_PSTAT = WS_R1 + (size_t)MTOK * D * 2;
constexpr size_t WS_RSTAT = WS_PSTAT + (size_t)MTOK * 16 * 2 * 4;
constexpr size_t WS_SGW = WS_RSTAT + (size_t)MTOK * 2 * 4;
constexpr size_t WS_END = WS_SGW + (size_t)DEPTH * 4 * 128 * 128 * 2;

constexpr int LDS_BYTES = 139264;
constexpr int NTHREADS = 512, NWAVES = 8;
#ifndef DUP
#define DUP 0
#endif

struct Params {
    const float *x, *c, *w_in, *pool_w, *pool_scale, *sgu_ln_g, *sgu_ln_b, *sgu_w, *sgu_b, *w_out, *ada_w, *ada_b, *ln_g, *ln_b;
    float* out; unsigned char* ws;
    int ph_lo, ph_hi;
};

DI unsigned pk2(float lo, float hi) { f32x2_t v = {lo, hi}; bf16x2_t b = __builtin_convertvector(v, bf16x2_t); return __builtin_bit_cast(unsigned, b); }
DI float bf2f(unsigned short u) { return __builtin_bit_cast(float, (unsigned)u << 16); }
DI float bflo(unsigned u) { return __builtin_bit_cast(float, u << 16); }
DI float bfhi(unsigned u) { return __builtin_bit_cast(float, u & 0xffff0000u); }
DI float silu_f(float v) { return v * __builtin_amdgcn_rcpf(1.f + __builtin_amdgcn_exp2f(-v * LOG2E)); }
DI float wave_sum(float v) {
#pragma unroll
    for (int o = 1; o < 64; o <<= 1) v += __shfl_xor(v, o);
    return v;
}
DI float swap32(float v, int hh) {
    const unsigned u = __builtin_bit_cast(unsigned, v);
    const auto rr = __builtin_amdgcn_permlane32_swap(u, u, false, false);
    return __builtin_bit_cast(float, hh ? rr[0] : rr[1]);
}
DI int crow(int i, int hh) { return (i & 3) + 8 * (i >> 2) + 4 * hh; }
#define MFMA32(a, b, c) __builtin_amdgcn_mfma_f32_32x32x16_bf16((a), (b), (c), 0, 0, 0)
#define LDS_WAIT() asm volatile("s_waitcnt lgkmcnt(0)" ::: "memory")

struct EpiP {
    static constexpr bool PERM = true, AFTER_DRAIN = false;
    bf16_t* O; bf16_t* QKV;
    DI void operator()(const pg8::f32x4 (&acc)[2][2][4][2], const pg8::Unit& u, int wr, int wc, int fr, int fq) const {
        const int row0 = u.pm * 256 + wr * 64 + fr;
        const bool qkv = (u.pn >= 5 && u.pn < 11);
        bf16_t* base; size_t rstride; int bjstride;
        if (qkv) {
            const int which = (u.pn - 5) >> 1, b = (u.pm * 256) >> 11, s0 = (u.pm * 256) & (SEQ - 1);
            base = QKV + (size_t)which * QKV_ONE + ((size_t)b * 8 + ((u.pn - 5) & 1) * 4 + (wc >> 1)) * QKV_PAIR + (size_t)(s0 + wr * 64 + fr) * 64 + (wc & 1) * 32 + 8 * fq;
            rstride = 64; bjstride = 2 * (int)QKV_PAIR;
        } else {
            const int pcol = (u.pn < 5 ? u.pn * 256 : u.pn * 256 - 1536) + wc * 32 + 8 * fq;
            base = O + (size_t)row0 * NP + pcol; rstride = NP; bjstride = 128;
        }
#pragma unroll
        for (int ai = 0; ai < 2; ++ai)
#pragma unroll
            for (int m = 0; m < 4; ++m) {
                bf16_t* rowp = base + (size_t)(ai * 128 + m * 16) * rstride;
#pragma unroll
                for (int bj = 0; bj < 2; ++bj) {
                    const pg8::f32x4 v0 = acc[ai][bj][m][0], v1 = acc[ai][bj][m][1];
                    u32x4 w; w.x = pk2(v0[0], v0[1]); w.y = pk2(v0[2], v0[3]); w.z = pk2(v1[0], v1[1]); w.w = pk2(v1[2], v1[3]);
                    *(u32x4*)(rowp + (size_t)bj * bjstride) = w;
                }
            }
    }
};
struct EpiRes {
    static constexpr bool PERM = true, AFTER_DRAIN = false;
    const float* xsrc;
    const bf16_t* rsrc;
    const float* rstat;
    const float* lng; const float* lnb;
    const float* gate;
    bf16_t* R; float* pstat;
    DI void operator()(const pg8::f32x4 (&acc)[2][2][4][2], const pg8::Unit& u, int wr, int wc, int fr, int fq) const {
        const int row0 = u.pm * 256 + wr * 64 + fr, col0 = u.pn * 256 + wc * 32 + 8 * fq;
        const int b = (u.pm * 256) >> 11;
        f32x4 ga[2][2];
#pragma unroll
        for (int bj = 0; bj < 2; ++bj)
#pragma unroll
            for (int n = 0; n < 2; ++n) ga[bj][n] = *(const f32x4*)(gate + (size_t)b * 3072 + col0 + bj * 128 + 4 * n);
#pragma unroll
        for (int ai = 0; ai < 2; ++ai)
#pragma unroll
            for (int m = 0; m < 4; ++m) {
                const int row = row0 + ai * 128 + m * 16;
                float mean = 0.f, rstd = 1.f;
                if (rsrc) { const f32x2_t st = *(const f32x2_t*)(rstat + (size_t)row * 2); mean = st.x; rstd = st.y; }
                float s = 0.f, ss = 0.f;
#pragma unroll
                for (int bj = 0; bj < 2; ++bj) {
                    const int col = col0 + bj * 128;
                    f32x4 x0, x1;
                    if (rsrc) {
                        const u32x4 rv = *(const u32x4*)(rsrc + (size_t)row * D + col);
                        x0 = (f32x4){bflo(rv.x), bfhi(rv.x), bflo(rv.y), bfhi(rv.y)}; x1 = (f32x4){bflo(rv.z), bfhi(rv.z), bflo(rv.w), bfhi(rv.w)};
                        x0 = (x0 - mean) * rstd * *(const f32x4*)(lng + col) + *(const f32x4*)(lnb + col);
                        x1 = (x1 - mean) * rstd * *(const f32x4*)(lng + col + 4) + *(const f32x4*)(lnb + col + 4);
                    } else { x0 = *(const f32x4*)(xsrc + (size_t)row * D + col); x1 = *(const f32x4*)(xsrc + (size_t)row * D + col + 4); }
                    const f32x4 v0 = x0 * DN_ALPHA + ga[bj][0] * acc[ai][bj][m][0], v1 = x1 * DN_ALPHA + ga[bj][1] * acc[ai][bj][m][1];
                    u32x4 w; w.x = pk2(v0[0], v0[1]); w.y = pk2(v0[2], v0[3]); w.z = pk2(v1[0], v1[1]); w.w = pk2(v1[2], v1[3]);
                    *(u32x4*)(R + (size_t)row * D + col) = w;
                    const float r0 = bflo(w.x), r1 = bfhi(w.x), r2 = bflo(w.y), r3 = bfhi(w.y), r4 = bflo(w.z), r5 = bfhi(w.z), r6 = bflo(w.w), r7 = bfhi(w.w);
                    s += ((r0 + r1) + (r2 + r3)) + ((r4 + r5) + (r6 + r7));
                    ss += ((r0 * r0 + r1 * r1) + (r2 * r2 + r3 * r3)) + ((r4 * r4 + r5 * r5) + (r6 * r6 + r7 * r7));
                }
                s += __shfl_xor(s, 16); ss += __shfl_xor(ss, 16);
                s += __shfl_xor(s, 32); ss += __shfl_xor(ss, 32);
                if (fq == 0) { f32x2_t o = {s, ss}; *(f32x2_t*)(pstat + ((size_t)row * 16 + u.pn * 4 + wc) * 2) = o; }
            }
    }
};

DI void transpose_item(const float* W, int K, int N, bf16_t* WT, LAS float* scr, int item, int lane) {
    const int nblk = N / 32, kb = item / nblk, nb = item % nblk, k0 = 64 * kb, n0 = 32 * nb;
#pragma unroll 8
    for (int i = 0; i < 32; ++i) { const int kk = 2 * i + (lane >> 5); scr[kk * 33 + (lane & 31)] = W[(size_t)(k0 + kk) * N + n0 + (lane & 31)]; }
    LDS_WAIT();
    const int c = lane & 7;
#pragma unroll
    for (int j = 0; j < 4; ++j) {
        const int n = (lane >> 3) + 8 * j; const LAS float* s = scr + (8 * c) * 33 + n;
        u32x4 o; o.x = pk2(s[0 * 33], s[1 * 33]); o.y = pk2(s[2 * 33], s[3 * 33]); o.z = pk2(s[4 * 33], s[5 * 33]); o.w = pk2(s[6 * 33], s[7 * 33]);
        *(u32x4*)(WT + (size_t)(n0 + n) * K + k0 + 8 * c) = o;
    }
    LDS_WAIT();
}

DI void phase0(const Params& P, LAS unsigned char* lds, int tid, int lane, int wave) {
    tid = launder_v(tid); lane = launder_v(lane); wave = launder_s(wave);
    bf16_t* win_t = (bf16_t*)(P.ws + WS_WIN); bf16_t* wout_t = (bf16_t*)(P.ws + WS_WOUT); float* mod = (float*)(P.ws + WS_MOD);
    for (int i = blockIdx.x * NTHREADS + tid; i < DEPTH * 4 * 128 * 128 / 8; i += gridDim.x * NTHREADS) {
        const f32x4 w0 = *(const f32x4*)(P.sgu_w + (size_t)i * 8), w1 = *(const f32x4*)(P.sgu_w + (size_t)i * 8 + 4);
        u32x4 o; o.x = pk2(w0[0], w0[1]); o.y = pk2(w0[2], w0[3]); o.z = pk2(w1[0], w1[1]); o.w = pk2(w1[2], w1[3]);
        *(u32x4*)(P.ws + WS_SGW + (size_t)i * 16) = o;
    }
    {
        LAS float* scr = (LAS float*)(lds + wave * 16384);
        const int gw = blockIdx.x * NWAVES + wave, NGW = gridDim.x * NWAVES;
        constexpr int I_IN = (D / 64) * (NIN / 32), I_OUT = (D / 64) * (D / 32);
        for (int it = gw; it < DEPTH * (I_IN + I_OUT); it += NGW) {
            const int l = it / (I_IN + I_OUT); int r = it % (I_IN + I_OUT);
            if (r < I_IN) transpose_item(P.w_in + (size_t)l * D * NIN, D, NIN, win_t + (size_t)l * NIN * D, scr, r, lane);
            else transpose_item(P.w_out + (size_t)l * D * D, D, D, wout_t + (size_t)l * D * D, scr, r - I_IN, lane);
        }
    }
    __syncthreads();
    LAS float* sc = (LAS float*)lds;
    for (int item = blockIdx.x; item < DEPTH * 96; item += gridDim.x) {
        const int l = item / 96, j0 = (item % 96) * 32;
        for (int e = tid; e < BATCH * D; e += NTHREADS) { const int b = e >> 10, k = e & 1023; sc[k * 32 + b] = silu_f(P.c[e]); }
        __syncthreads();
        const int j = tid & 31, ks = tid >> 5;
        float acc[32];
#pragma unroll
        for (int b = 0; b < 32; ++b) acc[b] = 0.f;
        const float* wp = P.ada_w + ((size_t)l * D + ks * 64) * 3072 + j0 + j;
#pragma unroll 2
        for (int kk = 0; kk < 64; ++kk) {
            const float w = wp[(size_t)kk * 3072];
            const LAS f32x4* s4 = (const LAS f32x4*)(sc + (ks * 64 + kk) * 32);
#pragma unroll
            for (int q = 0; q < 8; ++q) { const f32x4 v = s4[q]; acc[4 * q] += v[0] * w; acc[4 * q + 1] += v[1] * w; acc[4 * q + 2] += v[2] * w; acc[4 * q + 3] += v[3] * w; }
        }
        __syncthreads();
        LAS float* red = (LAS float*)lds;
#pragma unroll
        for (int b = 0; b < 32; ++b) red[(ks * 32 + b) * 32 + j] = acc[b];
        __syncthreads();
#pragma unroll
        for (int o2 = 0; o2 < 2; ++o2) {
            const int o = tid + o2 * NTHREADS, b = o >> 5, jj = o & 31;
            float s = P.ada_b[l * 3072 + j0 + jj];
#pragma unroll
            for (int q = 0; q < 16; ++q) s += red[(q * 32 + b) * 32 + jj];
            mod[((size_t)l * BATCH + b) * 3072 + j0 + jj] = s;
        }
        __syncthreads();
    }
}

template <int MODE>
DI void row_pass(const Params& P, int lane, int wave) {
    lane = launder_v(lane); wave = launder_s(wave);
    const int gw = blockIdx.x * NWAVES + wave, NGW = gridDim.x * NWAVES;
    const float* mod = (const float*)(P.ws + WS_MOD) + (MODE == 1 ? (size_t)BATCH * 3072 : 0);
    const float* pstat = (const float*)(P.ws + WS_PSTAT);
    float* rstat = (float*)(P.ws + WS_RSTAT);
    bf16_t* hb = (bf16_t*)(P.ws + WS_HB);
    const bf16_t* rsrc = (const bf16_t*)(P.ws + (MODE == 1 ? WS_R0 : WS_R1));
    const float* lg = P.ln_g + (MODE == 2 ? D : 0); const float* lb = P.ln_b + (MODE == 2 ? D : 0);
    constexpr int RU = 4;
    for (int row0 = gw * RU; row0 < MTOK; row0 += NGW * RU) {
        f32x4 v[RU][2][2];
        if (MODE == 0) {
#pragma unroll
            for (int u = 0; u < RU; ++u)
#pragma unroll
                for (int j = 0; j < 2; ++j) { const float* xp = P.x + (size_t)(row0 + u) * D + 8 * lane + 512 * j; v[u][j][0] = *(const f32x4*)xp; v[u][j][1] = *(const f32x4*)(xp + 4); }
        } else {
            u32x4 raw[RU][2];
#pragma unroll
            for (int u = 0; u < RU; ++u)
#pragma unroll
                for (int j = 0; j < 2; ++j) raw[u][j] = *(const u32x4*)(rsrc + (size_t)(row0 + u) * D + 8 * lane + 512 * j);
#pragma unroll
            for (int u = 0; u < RU; ++u)
#pragma unroll
                for (int j = 0; j < 2; ++j) {
                    v[u][j][0] = (f32x4){bflo(raw[u][j].x), bfhi(raw[u][j].x), bflo(raw[u][j].y), bfhi(raw[u][j].y)};
                    v[u][j][1] = (f32x4){bflo(raw[u][j].z), bfhi(raw[u][j].z), bflo(raw[u][j].w), bfhi(raw[u][j].w)};
                }
        }
        float mean[RU], rstd[RU];
#pragma unroll
        for (int u = 0; u < RU; ++u) { mean[u] = 0.f; rstd[u] = 1.f; }
        if (MODE != 0) {
            const f32x2_t st = *(const f32x2_t*)(pstat + ((size_t)(row0 + (lane >> 4)) * 16 + (lane & 15)) * 2);
            float s = st.x, ss = st.y;
#pragma unroll
            for (int o = 1; o < 16; o <<= 1) { s += __shfl_xor(s, o); ss += __shfl_xor(ss, o); }
            const float m = s * (1.f / D); const float var = fmaxf(ss * (1.f / D) - m * m, 0.f); const float rs = 1.f / sqrtf(var + LN_EPS);
            if (MODE == 1 && (lane & 15) == 0) { f32x2_t o = {m, rs}; *(f32x2_t*)(rstat + (size_t)(row0 + (lane >> 4)) * 2) = o; }
#pragma unroll
            for (int u = 0; u < RU; ++u) { mean[u] = __shfl(m, 16 * u); rstd[u] = __shfl(rs, 16 * u); }
        }
        const int b = row0 >> 11;
#pragma unroll
        for (int j = 0; j < 2; ++j)
#pragma unroll
            for (int q = 0; q < 2; ++q) {
                const int col = 8 * lane + 512 * j + 4 * q;
                f32x4 g = {1.f, 1.f, 1.f, 1.f}, bb = {0.f, 0.f, 0.f, 0.f}, sh = bb, scl = bb;
                if (MODE != 0) { g = *(const f32x4*)(lg + col); bb = *(const f32x4*)(lb + col); }
                if (MODE != 2) { sh = *(const f32x4*)(mod + (size_t)b * 3072 + col); scl = *(const f32x4*)(mod + (size_t)b * 3072 + 1024 + col); }
#pragma unroll
                for (int u = 0; u < RU; ++u) {
                    f32x4 w = v[u][j][q];
                    if (MODE != 0) w = (w - mean[u]) * rstd[u] * g + bb;
                    if (MODE == 2) *(f32x4*)(P.out + (size_t)(row0 + u) * D + col) = w;
                    else v[u][j][q] = w * (scl + 1.f) + sh;
                }
            }
        if (MODE != 2) {
#pragma unroll
            for (int u = 0; u < RU; ++u)
#pragma unroll
                for (int j = 0; j < 2; ++j) {
                    const f32x4 a = v[u][j][0], c = v[u][j][1];
                    u32x4 o; o.x = pk2(a[0], a[1]); o.y = pk2(a[2], a[3]); o.z = pk2(c[0], c[1]); o.w = pk2(c[2], c[3]);
                    *(u32x4*)(hb + (size_t)(row0 + u) * D + 8 * lane + 512 * j) = o;
                }
        }
    }
}

constexpr int VT_PITCH = 272;
constexpr int SG_OST = 36;
DI int vt_off(int ch) { return ch * VT_PITCH + (ch >> 6) * 32; }
DI void sgu_unit(const Params& P, int l, int unit, LAS unsigned char* lds, int tid, int lane, int wave) {
    const bf16_t* p = (const bf16_t*)(P.ws + WS_P); bf16_t* Y = (bf16_t*)(P.ws + WS_Y);
    const int tok0 = unit * 128;
    {
        const int s = tid >> 2, qd = tid & 3;
        const bf16_t* vp = p + (size_t)(tok0 + s) * NP + C_VS + qd * 64;
        u32x4 raw[8];
#pragma unroll
        for (int c = 0; c < 8; ++c) raw[c] = *(const u32x4*)(vp + 8 * c);
        float sm = 0.f, sq = 0.f;
#pragma unroll
        for (int c = 0; c < 8; ++c) {
            const float a0 = bflo(raw[c].x), a1 = bfhi(raw[c].x), a2 = bflo(raw[c].y), a3 = bfhi(raw[c].y), a4 = bflo(raw[c].z), a5 = bfhi(raw[c].z), a6 = bflo(raw[c].w), a7 = bfhi(raw[c].w);
            sm += ((a0 + a1) + (a2 + a3)) + ((a4 + a5) + (a6 + a7));
            sq += ((a0 * a0 + a1 * a1) + (a2 * a2 + a3 * a3)) + ((a4 * a4 + a5 * a5) + (a6 * a6 + a7 * a7));
        }
        sm += __shfl_xor(sm, 1); sq += __shfl_xor(sq, 1);
        sm += __shfl_xor(sm, 2); sq += __shfl_xor(sq, 2);
        const float mean = sm * (1.f / 256.f);
        const float var = fmaxf(sq * (1.f / 256.f) - mean * mean, 0.f);
        const float rstd = 1.f / sqrtf(var + LN_EPS);
        const float* gp = P.sgu_ln_g + l * 256 + qd * 64; const float* bp = P.sgu_ln_b + l * 256 + qd * 64;
        LAS bf16_t* vt = (LAS bf16_t*)(lds + vt_off(qd * 64) + s * 2);
#pragma unroll
        for (int c = 0; c < 8; ++c) {
            const f32x4 g0 = *(const f32x4*)(gp + 8 * c), g1 = *(const f32x4*)(gp + 8 * c + 4), b0 = *(const f32x4*)(bp + 8 * c), b1 = *(const f32x4*)(bp + 8 * c + 4);
            const float a[8] = {bflo(raw[c].x), bfhi(raw[c].x), bflo(raw[c].y), bfhi(raw[c].y), bflo(raw[c].z), bfhi(raw[c].z), bflo(raw[c].w), bfhi(raw[c].w)};
#pragma unroll
            for (int e = 0; e < 8; ++e) {
                const float gg = e < 4 ? g0[e & 3] : g1[e & 3], bb = e < 4 ? b0[e & 3] : b1[e & 3];
                vt[(8 * c + e) * (VT_PITCH / 2)] = (bf16_t)(pk2((a[e] - mean) * rstd * gg + bb, 0.f) & 0xffffu);
            }
        }
    }
    const int h = wave & 3, dblk = wave >> 2, r = lane & 31, hh = lane >> 5;
    const int ch = h * 64 + 32 * dblk + r;
    const bf16_t* wb = (const bf16_t*)(P.ws + WS_SGW) + ((size_t)(l * 4 + h) * 128 + r) * 128 + 8 * hh;
    bf16x8 af[24];
#pragma unroll
    for (int ks = 0; ks < 4; ++ks)
#pragma unroll
        for (int tb = 0; tb < 4; ++tb) af[ks * 4 + tb] = *(const bf16x8*)(wb + (size_t)(32 * tb) * 128 + 16 * ks);
#pragma unroll
    for (int ks = 4; ks < 8; ++ks)
#pragma unroll
        for (int tb = 2; tb < 4; ++tb) af[16 + (ks - 4) * 2 + (tb - 2)] = *(const bf16x8*)(wb + (size_t)(32 * tb) * 128 + 16 * ks);
    __syncthreads();
    f32x16 acc[4];
#pragma unroll
    for (int tb = 0; tb < 4; ++tb)
#pragma unroll
        for (int i = 0; i < 16; ++i) acc[tb][i] = 0.f;
#pragma unroll
    for (int ks = 0; ks < 8; ++ks) {
        const bf16x8 bfrag = *(const LAS bf16x8*)(lds + vt_off(ch) + (16 * ks + 8 * hh) * 2);
#pragma unroll
        for (int tb = (ks < 4 ? 0 : 2); tb < 4; ++tb)
            acc[tb] = MFMA32(ks < 4 ? af[ks * 4 + tb] : af[16 + (ks - 4) * 2 + (tb - 2)], bfrag, acc[tb]);
    }
    const int erow = lane >> 2, edc = lane & 3;
    const size_t ecol = (size_t)h * 64 + 32 * dblk + edc * 8;
    u32x4 uu[8], gg[8];
#pragma unroll
    for (int k = 0; k < 8; ++k) {
        const size_t tok = (size_t)(tok0 + erow + 16 * k);
        uu[k] = *(const u32x4*)(p + tok * NP + C_U + ecol); gg[k] = *(const u32x4*)(p + tok * NP + C_GB + ecol);
    }
    __syncthreads();
    LAS float* ost = (LAS float*)(lds + wave * (64 * SG_OST * 4));
    const float* sb = P.sgu_b + (l * 4 + h) * 128;
#pragma unroll
    for (int half = 0; half < 2; ++half) {
#pragma unroll
        for (int tb2 = 0; tb2 < 2; ++tb2)
#pragma unroll
            for (int i = 0; i < 16; ++i) ost[(32 * tb2 + crow(i, hh)) * SG_OST + r] = acc[2 * half + tb2][i];
#pragma unroll
        for (int it = 0; it < 4; ++it) {
            const int k = 4 * half + it, t = erow + 16 * k;
            const LAS float* op = ost + (erow + 16 * it) * SG_OST + edc * 8;
            const f32x4 a = *(const LAS f32x4*)op, b = *(const LAS f32x4*)(op + 4);
            const float bias = sb[t];
            const u32x4 u = uu[k], g = gg[k];
            u32x4 w;
            w.x = pk2(bflo(u.x) * (a[0] + bias) * silu_f(bflo(g.x)), bfhi(u.x) * (a[1] + bias) * silu_f(bfhi(g.x)));
            w.y = pk2(bflo(u.y) * (a[2] + bias) * silu_f(bflo(g.y)), bfhi(u.y) * (a[3] + bias) * silu_f(bfhi(g.y)));
            w.z = pk2(bflo(u.z) * (b[0] + bias) * silu_f(bflo(g.z)), bfhi(u.z) * (b[1] + bias) * silu_f(bfhi(g.z)));
            w.w = pk2(bflo(u.w) * (b[2] + bias) * silu_f(bflo(g.w)), bfhi(u.w) * (b[3] + bias) * silu_f(bfhi(g.w)));
            *(u32x4*)(Y + (size_t)(tok0 + t) * D + 256 + ecol) = w;
        }
    }
    __syncthreads();
}

typedef short v4i16_t __attribute__((ext_vector_type(4)));
DI v4i16_t lds_tr16(const LAS unsigned char* p) { return __builtin_amdgcn_ds_read_tr16_b64_v4i16((LAS v4i16_t*)p); }
constexpr int OST_PITCH = 68;
DI void tile_epilogue(const f32x16& o0, const f32x16& o1, LAS float* ost, int lane, const bf16_t* grow  , bf16_t* yrow, const float* colscale) {
    const int r = lane & 31, hh = lane >> 5;
#pragma unroll
    for (int i = 0; i < 16; ++i) { ost[crow(i, hh) * OST_PITCH + r] = o0[i]; ost[crow(i, hh) * OST_PITCH + 32 + r] = o1[i]; }
#pragma unroll
    for (int it = 0; it < 4; ++it) {
        const int c = lane + 64 * it, q = c >> 3, dc = c & 7;
        const u32x4 g = *(const u32x4*)(grow + (size_t)q * NP + dc * 8);
        const f32x4 a = *(const LAS f32x4*)(ost + q * OST_PITCH + dc * 8), b = *(const LAS f32x4*)(ost + q * OST_PITCH + dc * 8 + 4);
        f32x4 s0 = {1.f, 1.f, 1.f, 1.f}, s1 = s0;
        if (colscale) { s0 = *(const f32x4*)(colscale + dc * 8); s1 = *(const f32x4*)(colscale + dc * 8 + 4); }
        u32x4 w;
        w.x = pk2(a[0] * s0[0] * silu_f(bflo(g.x)), a[1] * s0[1] * silu_f(bfhi(g.x)));
        w.y = pk2(a[2] * s0[2] * silu_f(bflo(g.y)), a[3] * s0[3] * silu_f(bfhi(g.y)));
        w.z = pk2(b[0] * s1[0] * silu_f(bflo(g.z)), b[1] * s1[1] * silu_f(bfhi(g.z)));
        w.w = pk2(b[2] * s1[2] * silu_f(bflo(g.w)), b[3] * s1[3] * silu_f(bfhi(g.w)));
        *(u32x4*)(yrow + (size_t)q * D + dc * 8) = w;
    }
}

constexpr int PA_PITCH = 144;
DI void pool_wave(const Params& P, int l, int gw, int NGW, int lane, LAS unsigned char* wl) {
    const bf16_t* p = (const bf16_t*)(P.ws + WS_P); bf16_t* Y = (bf16_t*)(P.ws + WS_Y);
    const int g = gw & 3, r = lane & 31, hh = lane >> 5;
    const int win = 2 << g;
    LAS float* ost = (LAS float*)(wl + 7168);
    bf16x8 bw[4][2];
#pragma unroll
    for (int s = 0; s < 4; ++s)
#pragma unroll
        for (int db = 0; db < 2; ++db) {
            const float* wp = P.pool_w + ((size_t)(l * 4 + g) * 64 + 16 * s + 8 * hh) * 64 + 32 * db + r;
            u32x4 a; a.x = pk2(wp[0], wp[64]); a.y = pk2(wp[128], wp[192]); a.z = pk2(wp[256], wp[320]); a.w = pk2(wp[384], wp[448]);
            bw[s][db] = __builtin_bit_cast(bf16x8, a);
        }
    for (int tile = gw >> 2; tile < MTOK / 32; tile += NGW >> 2) {
        const int tok0 = tile * 32, pos0 = tok0 & (SEQ - 1), pos = pos0 + r;
#pragma unroll
        for (int it = 0; it < 6; ++it) {
            const int c = lane + 64 * it, row = c >> 3, dc = c & 7;
            u32x4 v = {0u, 0u, 0u, 0u};
            if (row >= 16 || pos0 != 0) v = *(const u32x4*)(p + (size_t)(tok0 - 16 + row) * NP + C_A + g * 64 + dc * 8);
            *(LAS u32x4*)(wl + row * PA_PITCH + dc * 16) = v;
        }
        const int cnt = (pos + 1 < win) ? pos + 1 : win;
        const float inv = 1.f / (float)cnt;
        f32x16 acc0, acc1;
#pragma unroll
        for (int i = 0; i < 16; ++i) { acc0[i] = 0.f; acc1[i] = 0.f; }
#pragma unroll
        for (int s = 0; s < 4; ++s) {
            const LAS unsigned char* base = wl + (16 + r) * PA_PITCH + (16 * s + 8 * hh) * 2;
            const u32x4 own = *(const LAS u32x4*)base;
            float sum[8];
            sum[0] = bflo(own.x); sum[1] = bfhi(own.x); sum[2] = bflo(own.y); sum[3] = bfhi(own.y); sum[4] = bflo(own.z); sum[5] = bfhi(own.z); sum[6] = bflo(own.w); sum[7] = bfhi(own.w);
            for (int j = 1; j < win; ++j) {
                const u32x4 v = *(const LAS u32x4*)(base - j * PA_PITCH);
                sum[0] += bflo(v.x); sum[1] += bfhi(v.x); sum[2] += bflo(v.y); sum[3] += bfhi(v.y); sum[4] += bflo(v.z); sum[5] += bfhi(v.z); sum[6] += bflo(v.w); sum[7] += bfhi(v.w);
            }
            u32x4 a;
            a.x = pk2(sum[0] * inv - bflo(own.x), sum[1] * inv - bfhi(own.x)); a.y = pk2(sum[2] * inv - bflo(own.y), sum[3] * inv - bfhi(own.y));
            a.z = pk2(sum[4] * inv - bflo(own.z), sum[5] * inv - bfhi(own.z)); a.w = pk2(sum[6] * inv - bflo(own.w), sum[7] * inv - bfhi(own.w));
            const bf16x8 af = __builtin_bit_cast(bf16x8, a);
            acc0 = MFMA32(af, bw[s][0], acc0);
            acc1 = MFMA32(af, bw[s][1], acc1);
        }
        tile_epilogue(acc0, acc1, ost, lane, p + (size_t)tok0 * NP + C_GA + g * 64, Y + (size_t)tok0 * D + g * 64, P.pool_scale + l * 256 + g * 64);
    }
}

constexpr int KT_PITCH = 144;
constexpr int VT_OFF = 32 * KT_PITCH;
DI bool attn_tile(const bf16x8 (&qf)[4], f32x16& o0, f32x16& o1, float& carry, bool diag, LAS unsigned char* wl, int frd, int trbase, int r, int hh) {
    const float CZ = 0.125f * LOG2E;
    f32x16 z;
#pragma unroll
    for (int i = 0; i < 16; ++i) z[i] = 0.f;
#pragma unroll
    for (int s = 0; s < 4; ++s) { const bf16x8 kf = *(const LAS bf16x8*)(wl + frd + s * 32); z = MFMA32(kf, qf[s], z); }
    float l1m[16], lbv[16];
#pragma unroll
    for (int i = 0; i < 16; ++i) {
        const float t = z[i] * CZ;
        const float e = __builtin_amdgcn_exp2f(-fabsf(t));
        const float sp = fmaxf(t, 0.f) + __builtin_amdgcn_logf(1.f + e);
        l1m[i] = -sp; lbv[i] = t - sp;
    }
    if (diag) {
#pragma unroll
        for (int i = 0; i < 16; ++i) if (crow(i, hh) >= r) { l1m[i] = 0.f; lbv[i] = -__builtin_inff(); }
    }
    float gs[4], og[4];
#pragma unroll
    for (int q = 0; q < 4; ++q) { gs[q] = (l1m[4 * q] + l1m[4 * q + 1]) + (l1m[4 * q + 2] + l1m[4 * q + 3]); og[q] = swap32(gs[q], hh); }
    float suf = carry;
    float a[16];
#pragma unroll
    for (int q = 3; q >= 0; --q) {
        float lat = suf + (hh == 0 ? og[q] : 0.f);
        a[4 * q + 3] = __builtin_amdgcn_exp2f(lbv[4 * q + 3] + lat); lat += l1m[4 * q + 3];
        a[4 * q + 2] = __builtin_amdgcn_exp2f(lbv[4 * q + 2] + lat); lat += l1m[4 * q + 2];
        a[4 * q + 1] = __builtin_amdgcn_exp2f(lbv[4 * q + 1] + lat); lat += l1m[4 * q + 1];
        a[4 * q] = __builtin_amdgcn_exp2f(lbv[4 * q] + lat);
        suf += gs[q] + og[q];
    }
    carry = suf;
    u32x4 pa0, pa1;
    pa0.x = pk2(a[0], a[1]); pa0.y = pk2(a[2], a[3]); pa0.z = pk2(a[4], a[5]); pa0.w = pk2(a[6], a[7]);
    pa1.x = pk2(a[8], a[9]); pa1.y = pk2(a[10], a[11]); pa1.z = pk2(a[12], a[13]); pa1.w = pk2(a[14], a[15]);
    bf16x8 vf[2][2];
#pragma unroll
    for (int s = 0; s < 2; ++s)
#pragma unroll
        for (int db = 0; db < 2; ++db) {
            const v4i16_t lo = lds_tr16(wl + trbase + db * 2048 + (16 * s) * 64), hi = lds_tr16(wl + trbase + db * 2048 + (16 * s + 8) * 64);
            vf[s][db] = __builtin_shufflevector(lo, hi, 0, 1, 2, 3, 4, 5, 6, 7);
        }
    o0 = MFMA32(__builtin_bit_cast(bf16x8, pa0), vf[0][0], o0);
    o0 = MFMA32(__builtin_bit_cast(bf16x8, pa1), vf[1][0], o0);
    o1 = MFMA32(__builtin_bit_cast(bf16x8, pa0), vf[0][1], o1);
    o1 = MFMA32(__builtin_bit_cast(bf16x8, pa1), vf[1][1], o1);
    return __ballot(carry > -160.f) == 0ull;
}
DI void attn_store(const f32x16& o0, const f32x16& o1, LAS float* ost, int lane, const bf16_t* gp  , bf16_t* yp  ) {
    const int r = lane & 31, hh = lane >> 5;
    u32x4 gt[4];
#pragma unroll
    for (int it = 0; it < 4; ++it) gt[it] = *(const u32x4*)(gp + (size_t)it * 8 * NP);
#pragma unroll
    for (int i = 0; i < 16; ++i) { ost[crow(i, hh) * OST_PITCH + r] = o0[i]; ost[crow(i, hh) * OST_PITCH + 32 + r] = o1[i]; }
#pragma unroll
    for (int it = 0; it < 4; ++it) {
        const LAS float* op = ost + ((lane >> 3) + 8 * it) * OST_PITCH + (lane & 7) * 8;
        const f32x4 a = *(const LAS f32x4*)op, bq = *(const LAS f32x4*)(op + 4);
        const u32x4 g = gt[it];
        u32x4 w;
        w.x = pk2(a[0] * silu_f(bflo(g.x)), a[1] * silu_f(bfhi(g.x)));
        w.y = pk2(a[2] * silu_f(bflo(g.y)), a[3] * silu_f(bfhi(g.y)));
        w.z = pk2(bq[0] * silu_f(bflo(g.z)), bq[1] * silu_f(bfhi(g.z)));
        w.w = pk2(bq[2] * silu_f(bflo(g.w)), bq[3] * silu_f(bfhi(g.w)));
        *(u32x4*)(yp + (size_t)it * 8 * D) = w;
    }
}
DI void attn_wave(const Params& P, int gw, int NGW, int lane, LAS unsigned char* wl) {
    const bf16_t* p = (const bf16_t*)(P.ws + WS_P); bf16_t* Y = (bf16_t*)(P.ws + WS_Y);
    constexpr int NU = BATCH * 8 * 32;
    const int r = lane & 31, hh = lane >> 5;
    LAS float* ost = (LAS float*)wl;
    const int klds = (lane >> 3) * KT_PITCH + (lane & 7) * 16;
    const int vlds = VT_OFF + ((lane & 7) >> 2) * 2048 + (lane >> 3) * 64 + (lane & 3) * 16;
    const int frd = r * KT_PITCH + hh * 16;
    const int trbase = VT_OFF + (4 * hh + ((lane & 15) >> 2)) * 64 + ((lane >> 4) & 1) * 32 + (lane & 3) * 8;
    const bf16_t* qb = (const bf16_t*)(P.ws + WS_QKV); const bf16_t* kbuf = qb + QKV_ONE; const bf16_t* vbuf = qb + 2 * QKV_ONE;
    for (int unit = gw; unit < NU; unit += NGW) {
        const int j = unit & 31, pair = unit >> 5, h = pair & 7, b = pair >> 3;
        const size_t pairoff = (size_t)pair * QKV_PAIR + (size_t)lane * 8;
        const bf16_t* kp0 = kbuf + pairoff; const bf16_t* vp0 = vbuf + pairoff;
        const int qtB = 2 * j + 1, qtA = 2 * j;
        u32x4 kn[4], vn[4];
        bf16x8 qfA[4], qfB[4];
        {
            u32x4 qa[4], qv[4];
#pragma unroll
            for (int it = 0; it < 4; ++it) qa[it] = *(const u32x4*)(qb + pairoff + (size_t)qtA * 2048 + it * 512);
#pragma unroll
            for (int it = 0; it < 4; ++it) qv[it] = *(const u32x4*)(qb + pairoff + (size_t)qtB * 2048 + it * 512);
#pragma unroll
            for (int it = 0; it < 4; ++it) kn[it] = *(const u32x4*)(kp0 + (size_t)qtB * 2048 + it * 512);
#pragma unroll
            for (int it = 0; it < 4; ++it) vn[it] = *(const u32x4*)(vp0 + (size_t)qtB * 2048 + it * 512);
#pragma unroll
            for (int it = 0; it < 4; ++it) *(LAS u32x4*)(wl + klds + it * 8 * KT_PITCH) = qa[it];
#pragma unroll
            for (int s = 0; s < 4; ++s) qfA[s] = *(const LAS bf16x8*)(wl + frd + s * 32);
#pragma unroll
            for (int it = 0; it < 4; ++it) *(LAS u32x4*)(wl + klds + it * 8 * KT_PITCH) = qv[it];
#pragma unroll
            for (int s = 0; s < 4; ++s) qfB[s] = *(const LAS bf16x8*)(wl + frd + s * 32);
        }
        f32x16 oA0, oA1, oB0, oB1;
#pragma unroll
        for (int i = 0; i < 16; ++i) { oA0[i] = 0.f; oA1[i] = 0.f; oB0[i] = 0.f; oB1[i] = 0.f; }
        float carryA = 0.f, carryB = 0.f;
        bool doneA = false, doneB = false;
        for (int kb = qtB; kb >= 0; --kb) {
#pragma unroll
            for (int it = 0; it < 4; ++it) *(LAS u32x4*)(wl + klds + it * 8 * KT_PITCH) = kn[it];
#pragma unroll
            for (int it = 0; it < 4; ++it) *(LAS u32x4*)(wl + vlds + it * 512) = vn[it];
            if (kb > 0) {
                const size_t o = (size_t)(kb - 1) * 2048;
#pragma unroll
                for (int it = 0; it < 4; ++it) kn[it] = *(const u32x4*)(kp0 + o + it * 512);
#pragma unroll
                for (int it = 0; it < 4; ++it) vn[it] = *(const u32x4*)(vp0 + o + it * 512);
            }
            if (!doneB) doneB = attn_tile(qfB, oB0, oB1, carryB, kb == qtB, wl, frd, trbase, r, hh);
            if (kb <= qtA && !doneA) doneA = attn_tile(qfA, oA0, oA1, carryA, kb == qtA, wl, frd, trbase, r, hh);
            if (doneA && doneB) break;
        }
        const size_t tokb = (size_t)b * SEQ;
        const bf16_t* gp = p + (tokb + qtA * 32 + (lane >> 3)) * NP + C_GC + h * 64 + (lane & 7) * 8;
        bf16_t* yp = Y + (tokb + qtA * 32 + (lane >> 3)) * D + 512 + h * 64 + (lane & 7) * 8;
        attn_store(oA0, oA1, ost, lane, gp, yp);
        attn_store(oB0, oB1, ost, lane, gp + (size_t)32 * NP, yp + (size_t)32 * D);
    }
}

DI void mixers(const Params& P, int l, LAS unsigned char* lds, int lane, int wave) {
    lane = launder_v(lane); wave = launder_s(wave);
    const int gw = blockIdx.x * NWAVES + wave, NGW = gridDim.x * NWAVES;
#ifndef MXMASK
#define MXMASK 7
#endif
    for (int rep = 0; rep < ((DUP & 4) ? 2 : 1); ++rep)
    if (MXMASK & 1) for (int unit = blockIdx.x; unit < BATCH * 16; unit += gridDim.x) sgu_unit(P, l, unit, lds, launder_v(threadIdx.x), lane, wave);
    for (int rep = 0; rep < ((DUP & 8) ? 2 : 1); ++rep)
    if (MXMASK & 2) pool_wave(P, l, gw, NGW, lane, lds + wave * 16384);
    for (int rep = 0; rep < ((DUP & 16) ? 2 : 1); ++rep)
    if (MXMASK & 4) attn_wave(P, gw, NGW, lane, lds + wave * 16384);
}

__global__ void __launch_bounds__(NTHREADS, 2) fwd_mega(Params P) {
    extern __shared__ __attribute__((aligned(16))) unsigned char lds_raw[];
    LAS unsigned char* lds = (LAS unsigned char*)lds_raw;
    cg::grid_group grid = cg::this_grid();
    const int tid = threadIdx.x, lane = tid & 63, wave = __builtin_amdgcn_readfirstlane(tid >> 6);
    const int lo = P.ph_lo, hi = P.ph_hi;
#ifndef PHMASK
#define PHMASK 0x3ff
#endif
#define IN(k) (((PHMASK >> (k)) & 1) && lo <= (k) && (k) < hi)
#define SEAM(k) do { if (IN(k) && IN((k) + 1)) grid.sync(); } while (0)
    bf16_t* hb = (bf16_t*)(P.ws + WS_HB); bf16_t* pbuf = (bf16_t*)(P.ws + WS_P); bf16_t* ybuf = (bf16_t*)(P.ws + WS_Y);
    const bf16_t* win_t = (const bf16_t*)(P.ws + WS_WIN); const bf16_t* wout_t = (const bf16_t*)(P.ws + WS_WOUT);
    const float* mod = (const float*)(P.ws + WS_MOD);

    if (IN(0)) for (int rep = 0; rep < ((DUP & 64) ? 2 : 1); ++rep) phase0(P, lds, tid, lane, wave);
    SEAM(0);
    if (IN(1)) for (int rep = 0; rep < ((DUP & 32) ? 2 : 1); ++rep) row_pass<0>(P, lane, wave);
    SEAM(1);
#pragma unroll 1
    for (int l = 0; l < DEPTH; ++l) {
        const int pb = 2 + 4 * l;
        if (IN(pb)) for (int rep = 0; rep < ((DUP & 1) ? 2 : 1); ++rep) {
            pg8::Gemm g{hb, win_t + (size_t)l * NIN * D, MTOK, NIN, D}; pg8::StaticOrder S; S.init(MTOK, NIN, (int)gridDim.x, (int)blockIdx.x);
            EpiP E{pbuf, (bf16_t*)(P.ws + WS_QKV)};
            pg8::gemm_phase<EpiP, pg8::StaticOrder, true, true>(lds, g, S, E);
        }
        SEAM(pb);
        if (IN(pb + 1)) mixers(P, l, lds, lane, wave);
        SEAM(pb + 1);
        if (IN(pb + 2)) for (int rep = 0; rep < ((DUP & 2) ? 2 : 1); ++rep) {
            pg8::Gemm g{ybuf, wout_t + (size_t)l * D * D, MTOK, D, D}; pg8::StaticOrder S; S.init(MTOK, D, (int)gridDim.x, (int)blockIdx.x);
            EpiRes E{P.x, l == 0 ? nullptr : (const bf16_t*)(P.ws + WS_R0), (const float*)(P.ws + WS_RSTAT), P.ln_g, P.ln_b,
                     mod + (size_t)l * BATCH * 3072 + 2048, (bf16_t*)(P.ws + (l == 0 ? WS_R0 : WS_R1)), (float*)(P.ws + WS_PSTAT)};
            pg8::gemm_phase<EpiRes, pg8::StaticOrder, true, true>(lds, g, S, E);
        }
        SEAM(pb + 2);
        if (IN(pb + 3)) { if (l == 0) { for (int rep = 0; rep < ((DUP & 32) ? 2 : 1); ++rep) row_pass<1>(P, lane, wave); } else row_pass<2>(P, lane, wave); }
        SEAM(pb + 3);
    }
#undef IN
#undef SEAM
}

#ifndef N_LAUNCH_PER_PHASE
#define N_LAUNCH_PER_PHASE 0
#endif
extern "C" void kernel_launch(void* const* d_in, const int* in_sizes, int n_in, void* d_out, int out_size, void* d_ws, size_t ws_size, hipStream_t stream) {
    static int grid = 0;
    if (grid == 0) {
        if (n_in != 14 || out_size != MTOK * D || ws_size < WS_END) { fprintf(stderr, "kernel_launch: unexpected shapes (n_in %d out %d ws %zu need %zu)\n", n_in, out_size, ws_size, (size_t)WS_END); grid = -1; return; }
        int dev = 0, cus = 0, per_cu = 0;
        hipGetDevice(&dev);
        hipDeviceGetAttribute(&cus, hipDeviceAttributeMultiprocessorCount, dev);
        if (hipFuncSetAttribute((const void*)fwd_mega, hipFuncAttributeMaxDynamicSharedMemorySize, LDS_BYTES) != hipSuccess) { fprintf(stderr, "kernel_launch: hipFuncSetAttribute failed\n"); grid = -1; return; }
        if (hipOccupancyMaxActiveBlocksPerMultiprocessor(&per_cu, (const void*)fwd_mega, NTHREADS, LDS_BYTES) != hipSuccess || per_cu < 1) { fprintf(stderr, "kernel_launch: occupancy query says %d\n", per_cu); per_cu = 1; }
        (void)hipGetLastError();
        grid = cus * 1;
        if (grid != 256) fprintf(stderr, "kernel_launch: note: grid %d\n", grid);
    }
    if (grid < 0) return;
    Params p{};
    p.x = (const float*)d_in[0]; p.c = (const float*)d_in[1]; p.w_in = (const float*)d_in[2]; p.pool_w = (const float*)d_in[3]; p.pool_scale = (const float*)d_in[4];
    p.sgu_ln_g = (const float*)d_in[5]; p.sgu_ln_b = (const float*)d_in[6]; p.sgu_w = (const float*)d_in[7]; p.sgu_b = (const float*)d_in[8]; p.w_out = (const float*)d_in[9];
    p.ada_w = (const float*)d_in[10]; p.ada_b = (const float*)d_in[11]; p.ln_g = (const float*)d_in[12]; p.ln_b = (const float*)d_in[13];
    p.out = (float*)d_out; p.ws = (unsigned char*)d_ws;
#if N_LAUNCH_PER_PHASE
    for (int ph = 0; ph < 10; ++ph) {
        p.ph_lo = ph; p.ph_hi = ph + 1;
        hipLaunchKernelGGL(fwd_mega, dim3(grid), dim3(NTHREADS), LDS_BYTES, stream, p);
    }
#else
    p.ph_lo = 0; p.ph_hi = 10;
    void* args[] = {&p};
    hipError_t e = hipLaunchCooperativeKernel((const void*)fwd_mega, dim3(grid), dim3(NTHREADS), args, LDS_BYTES, stream);
    if (e != hipSuccess) fprintf(stderr, "kernel_launch: cooperative launch failed: %s (grid %d)\n", hipGetErrorString(e), grid);
#endif
}
```

```cpp
#include <hip/hip_runtime.h>
#include <hip/hip_cooperative_groups.h>
#include <cstdio>
#include <cstdint>
namespace cg = cooperative_groups;
__device__ __forceinline__ int launder_v(int x) { asm volatile("" : "+v"(x)); return x; }
__device__ __forceinline__ int launder_s(int x) { asm volatile("" : "+s"(x)); return x; }
namespace pg8 {
#define PG8_LAS __attribute__((address_space(3)))
typedef unsigned short bf16_t;
typedef short bf16x8 __attribute__((ext_vector_type(8)));
typedef float f32x4 __attribute__((ext_vector_type(4)));
typedef unsigned u32x4 __attribute__((ext_vector_type(4)));
constexpr int BM = 256, BK = 64, HALF = 128, HTB = HALF * BK * 2  , STAGE_BYTES = 8 * HTB, NXCD = 8, WGM = 8;

__host__ __device__ __forceinline__ int lds_byte(int r, int c) { const int st = (r >> 4) * 2 + (c >> 5), rr = r & 15, cc = c & 31, ob = rr * 64 + cc * 2; return st * 1024 + (ob ^ (((ob >> 9) & 1) << 5)); }
__host__ __device__ __forceinline__ void stage_rc(int b, int& R, int& C) { const int st = b / 1024, sb = b % 1024, swz = sb ^ (((sb >> 9) & 1) << 5); R = (st >> 1) * 16 + swz / 64; C = (st & 1) * 32 + (swz % 64) / 2; }
__host__ __device__ __forceinline__ int perm32(int rho) { const int n = rho >> 4, i = rho & 15; return 8 * (i >> 2) + 4 * n + (i & 3); }

struct Unit { int pm, pn; };
struct Gemm { const bf16_t* A; const bf16_t* Bt; int M, N, K; };

struct StaticOrder {
    int nM, nN, nwg, G, c;
    __host__ __device__ void init(int M, int N, int G_, int c_) { nM = M / BM; nN = N / BM; nwg = nM * nN; G = G_; c = c_; }
    __host__ __device__ bool next(int i, Unit& u) const {
        const long L = (long)i * G + c; if (L >= nwg) return false;
        int wgid = (int)L; { const int q = nwg / NXCD, r = nwg % NXCD, xcd = wgid % NXCD, off = wgid / NXCD; wgid = (xcd < r ? xcd * (q + 1) : r * (q + 1) + (xcd - r) * q) + off; }
        const int nig = WGM * nN, gid = wgid / nig, fm = gid * WGM, gsz = (nM - fm) < WGM ? (nM - fm) : WGM;
        u.pm = fm + ((wgid % nig) % gsz); u.pn = (wgid % nig) / gsz; return true;
    }
    __device__ __forceinline__ void a_ready(const Unit&) const {}
    __device__ __forceinline__ void done(const Unit&) const {}
};

__device__ __forceinline__ unsigned cvt_pk_bf16(float lo, float hi) { unsigned r; asm volatile("v_cvt_pk_bf16_f32 %0, %1, %2" : "=v"(r) : "v"(lo), "v"(hi)); return r; }
template <class Epi, class Sched, bool ALIGN_EPI = false, bool SP2 = false>
__device__ __forceinline__ void gemm_phase(PG8_LAS unsigned char* lds, const Gemm g, const Sched& S, const Epi& E) {
    const int tid = launder_v(threadIdx.x), wid = __builtin_amdgcn_readfirstlane(tid >> 6), lane = tid & 63, wr = wid >> 2, wc = wid & 3, fr = lane & 15, fq = lane >> 4;
    const int K = g.K, nt = K / BK;
    unsigned voffA[2], voffB[2];
#pragma unroll
    for (int i = 0; i < 2; ++i) { int R, C; stage_rc(tid * 16 + i * 8192, R, C); const int Rb = Epi::PERM ? ((R & ~31) + perm32(R & 31)) : R;
        voffA[i] = (unsigned)(R * K + C) * 2u; voffB[i] = (unsigned)(Rb * K + C) * 2u; }
    const size_t kstep = (size_t)(BK * 2);
    const size_t hstep = (size_t)HALF * K * 2;
    const size_t tstep = 2 * hstep;
    const unsigned ldsw = (unsigned)wid * 1024u;
    const int aoff = lds_byte(wr * 64 + fr, fq * 8), boff = lds_byte(wc * 32 + fr, fq * 8);
#define PG8_SA(b, h) (((b) * 2 + (h)) * HTB)
#define PG8_SB(b, h) ((4 + (b) * 2 + (h)) * HTB)
#define PG8_STAGE(bufoff, gbase, voff) do { _Pragma("unroll") for (int _i = 0; _i < 2; ++_i) \
        __builtin_amdgcn_global_load_lds((const unsigned*)((const char*)(gbase) + (voff)[_i]), (PG8_LAS unsigned*)(lds + (bufoff) + ldsw + _i * 8192), 16, 0, 0); } while (0)
#define PG8_LDA(dst, b, h) do { _Pragma("unroll") for (int m = 0; m < 4; ++m) _Pragma("unroll") for (int k = 0; k < 2; ++k) dst[m][k] = *(const PG8_LAS bf16x8*)(lds + PG8_SA(b, h) + aoff + m * 2048 + k * 1024); } while (0)
#define PG8_LDB(dst, b, h) do { _Pragma("unroll") for (int n = 0; n < 2; ++n) _Pragma("unroll") for (int k = 0; k < 2; ++k) dst[n][k] = *(const PG8_LAS bf16x8*)(lds + PG8_SB(b, h) + boff + n * 2048 + k * 1024); } while (0)
#define PG8_MMA(ai, bj, At, Bt) do { __builtin_amdgcn_s_setprio(1); _Pragma("unroll") for (int m = 0; m < 4; ++m) _Pragma("unroll") for (int n = 0; n < 2; ++n) _Pragma("unroll") for (int k = 0; k < 2; ++k) \
        acc[ai][bj][m][n] = __builtin_amdgcn_mfma_f32_16x16x32_bf16(Bt[n][k], At[m][k], acc[ai][bj][m][n], 0, 0, 0); __builtin_amdgcn_s_setprio(0); } while (0)
#define PG8_WAIT_V(n) asm volatile("s_waitcnt vmcnt(" #n ")" ::: "memory")
#define PG8_WAIT_L(n) asm volatile("s_waitcnt lgkmcnt(" #n ")" ::: "memory")
#define PG8_BAR __builtin_amdgcn_s_barrier()
#define PG8_SCHED __builtin_amdgcn_sched_barrier(0)
    Unit cur, nxt; int ui = 0;
    if (!S.next(0, cur)) return;
    f32x4 acc[2][2][4][2];
#pragma unroll
    for (int a = 0; a < 2; ++a)
#pragma unroll
        for (int b = 0; b < 2; ++b)
#pragma unroll
            for (int m = 0; m < 4; ++m)
#pragma unroll
                for (int n = 0; n < 2; ++n) acc[a][b][m][n] = (f32x4){0.f, 0.f, 0.f, 0.f};
    bf16x8 At[4][2], B0[2][2], B1[2][2];
    const char* cA = (const char*)g.A + (size_t)cur.pm * tstep; const char* cB = (const char*)g.Bt + (size_t)cur.pn * tstep;
    S.a_ready(cur);
    if constexpr (SP2) {
        PG8_STAGE(PG8_SB(0, 0), cB, voffB); PG8_STAGE(PG8_SB(0, 1), cB + hstep, voffB); PG8_STAGE(PG8_SA(0, 0), cA, voffA); PG8_STAGE(PG8_SA(0, 1), cA + hstep, voffA);
        if (wr == 1) PG8_BAR;
        PG8_WAIT_V(2); PG8_BAR;
        PG8_STAGE(PG8_SB(1, 0), cB + kstep, voffB); PG8_STAGE(PG8_SA(1, 0), cA + kstep, voffA); PG8_STAGE(PG8_SB(1, 1), cB + hstep + kstep, voffB);
        PG8_WAIT_V(6); PG8_BAR;
    } else {
        PG8_STAGE(PG8_SB(0, 0), cB, voffB); PG8_STAGE(PG8_SA(0, 0), cA, voffA); PG8_STAGE(PG8_SB(0, 1), cB + hstep, voffB); PG8_STAGE(PG8_SA(0, 1), cA + hstep, voffA);
        if (wr == 1) PG8_BAR;
        PG8_WAIT_V(4); PG8_BAR;
        PG8_STAGE(PG8_SB(1, 0), cB + kstep, voffB); PG8_STAGE(PG8_SA(1, 0), cA + kstep, voffA); PG8_STAGE(PG8_SB(1, 1), cB + hstep + kstep, voffB);
        PG8_WAIT_V(6); PG8_BAR;
    }
    for (;;) {
        const bool has_next = S.next(ui + 1, nxt);
        const char* nA = has_next ? (const char*)g.A + (size_t)nxt.pm * tstep : cA; const char* nB = has_next ? (const char*)g.Bt + (size_t)nxt.pn * tstep : cB;
        for (int t = 0; t < nt; t += 2) {
            const bool last = (t == nt - 2);
            const char* a1 = cA + (size_t)(t + 1) * kstep;
            const char* a2 = last ? nA : cA + (size_t)(t + 2) * kstep; const char* b2 = last ? nB : cB + (size_t)(t + 2) * kstep;
            const char* a3 = a2 + kstep; const char* b3 = b2 + kstep;
            if (last && has_next) S.a_ready(nxt);
            if constexpr (SP2) {
            PG8_LDB(B0, 0, 0); PG8_LDB(B1, 0, 1); PG8_SCHED; PG8_LDA(At, 0, 0); PG8_STAGE(PG8_SA(1, 1), a1 + hstep, voffA);
            PG8_WAIT_V(8); PG8_WAIT_L(0); PG8_BAR; PG8_MMA(0, 0, At, B0); PG8_MMA(0, 1, At, B1); PG8_BAR; PG8_SCHED;
            PG8_LDA(At, 0, 1); PG8_STAGE(PG8_SB(0, 0), b2, voffB); PG8_STAGE(PG8_SB(0, 1), b2 + hstep, voffB); PG8_STAGE(PG8_SA(0, 0), a2, voffA);
            PG8_WAIT_V(8); PG8_WAIT_L(0); PG8_BAR; PG8_MMA(1, 0, At, B0); PG8_MMA(1, 1, At, B1); PG8_BAR; PG8_SCHED;
            PG8_LDB(B0, 1, 0); PG8_LDB(B1, 1, 1); PG8_SCHED; PG8_LDA(At, 1, 0); PG8_STAGE(PG8_SA(0, 1), a2 + hstep, voffA);
            PG8_WAIT_V(8); PG8_WAIT_L(0); PG8_BAR; PG8_MMA(0, 0, At, B0); PG8_MMA(0, 1, At, B1); PG8_BAR; PG8_SCHED;
            PG8_LDA(At, 1, 1); PG8_STAGE(PG8_SB(1, 0), b3, voffB); PG8_STAGE(PG8_SB(1, 1), b3 + hstep, voffB); PG8_STAGE(PG8_SA(1, 0), a3, voffA);
            PG8_WAIT_V(8); PG8_WAIT_L(0); PG8_BAR; PG8_MMA(1, 0, At, B0); PG8_MMA(1, 1, At, B1); PG8_BAR; PG8_SCHED;
            } else {
            PG8_LDB(B0, 0, 0); PG8_SCHED; PG8_LDA(At, 0, 0); PG8_STAGE(PG8_SA(1, 1), a1 + hstep, voffA);
            PG8_WAIT_L(8); PG8_BAR; PG8_WAIT_L(0); PG8_MMA(0, 0, At, B0); PG8_BAR; PG8_SCHED;
            PG8_LDB(B1, 0, 1); PG8_STAGE(PG8_SB(0, 0), b2, voffB);
            PG8_BAR; PG8_WAIT_L(0); PG8_MMA(0, 1, At, B1); PG8_BAR;
            PG8_LDA(At, 0, 1); PG8_STAGE(PG8_SA(0, 0), a2, voffA);
            PG8_BAR; PG8_WAIT_L(0); PG8_MMA(1, 0, At, B0); PG8_BAR; PG8_SCHED;
            PG8_STAGE(PG8_SB(0, 1), b2 + hstep, voffB);
            PG8_WAIT_V(6); PG8_BAR; PG8_MMA(1, 1, At, B1); PG8_BAR;
            PG8_LDB(B0, 1, 0); PG8_SCHED; PG8_LDA(At, 1, 0); PG8_STAGE(PG8_SA(0, 1), a2 + hstep, voffA);
            PG8_WAIT_L(8); PG8_BAR; PG8_WAIT_L(0); PG8_MMA(0, 0, At, B0); PG8_BAR; PG8_SCHED;
            PG8_LDB(B1, 1, 1); PG8_STAGE(PG8_SB(1, 0), b3, voffB);
            PG8_BAR; PG8_WAIT_L(0); PG8_MMA(0, 1, At, B1); PG8_BAR;
            PG8_LDA(At, 1, 1); PG8_STAGE(PG8_SA(1, 0), a3, voffA);
            PG8_BAR; PG8_WAIT_L(0); PG8_MMA(1, 0, At, B0); PG8_BAR; PG8_SCHED;
            PG8_STAGE(PG8_SB(1, 1), b3 + hstep, voffB);
            PG8_WAIT_V(6); PG8_BAR; PG8_MMA(1, 1, At, B1); PG8_BAR;
            }
        }
        if constexpr (ALIGN_EPI) { if (wr == 0) PG8_BAR; }
        if constexpr (!Epi::AFTER_DRAIN) { E(acc, cur, wr, wc, fr, fq); S.done(cur); }
        if (!has_next) break;
#pragma unroll
        for (int a = 0; a < 2; ++a)
#pragma unroll
            for (int b = 0; b < 2; ++b)
#pragma unroll
                for (int m = 0; m < 4; ++m)
#pragma unroll
                    for (int n = 0; n < 2; ++n) acc[a][b][m][n] = (f32x4){0.f, 0.f, 0.f, 0.f};
        cur = nxt; cA = nA; cB = nB; ++ui;
        if constexpr (ALIGN_EPI) { if (wr == 1) PG8_BAR; }
    }
    PG8_WAIT_V(0);
    if constexpr (!ALIGN_EPI) { if (wr == 0) PG8_BAR; }
    PG8_BAR;
    if constexpr (Epi::AFTER_DRAIN) { E.fused(acc, cur, wr, wc, fr, fq, lds, wid, lane); S.done(cur); }
#undef PG8_SA
#undef PG8_SB
#undef PG8_STAGE
#undef PG8_LDA
#undef PG8_LDB
#undef PG8_MMA
#undef PG8_WAIT_V
#undef PG8_WAIT_L
#undef PG8_BAR
#undef PG8_SCHED
}
}

#define DI __device__ __forceinline__
#define LAS __attribute__((address_space(3)))
typedef unsigned short bf16_t;
typedef short bf16x8 __attribute__((ext_vector_type(8)));
typedef float f32x4 __attribute__((ext_vector_type(4)));
typedef float f32x16 __attribute__((ext_vector_type(16)));
typedef unsigned u32x4 __attribute__((ext_vector_type(4)));
typedef unsigned u32x2 __attribute__((ext_vector_type(2)));
typedef __bf16 bf16x2_t __attribute__((ext_vector_type(2)));
typedef float f32x2_t __attribute__((ext_vector_type(2)));

constexpr int D = 1024, BATCH = 32, SEQ = 2048, MTOK = BATCH * SEQ, NIN = 3328, DEPTH = 2;
constexpr int NP = 1792;
constexpr int C_A = 0, C_GA = 256, C_U = 512, C_VS = 768, C_GB = 1024, C_GC = 1280;
constexpr size_t QKV_PAIR = (size_t)SEQ * 64;
constexpr size_t QKV_ONE = (size_t)BATCH * 8 * QKV_PAIR;
constexpr float DN_ALPHA = 1.41421356237309515f;
constexpr float LN_EPS = 1e-5f;
constexpr float LOG2E = 1.44269504088896341f;

constexpr size_t WS_WIN = 0;
constexpr size_t WS_WOUT = WS_WIN + (size_t)DEPTH * NIN * D * 2;
constexpr size_t WS_MOD = WS_WOUT + (size_t)DEPTH * D * D * 2;
constexpr size_t WS_HB = WS_MOD + (size_t)DEPTH * BATCH * 3 * D * 4;
constexpr size_t WS_P = WS_HB + (size_t)MTOK * D * 2;
constexpr size_t WS_QKV = WS_P + (size_t)MTOK * NP * 2;
constexpr size_t WS_Y = WS_QKV + 3 * QKV_ONE * 2;
constexpr size_t WS_R0 = WS_Y + (size_t)MTOK * D * 2;
constexpr size_t WS_R1 = WS_R0 + (size_t)MTOK * D * 2;
constexpr size_t WS_PSTAT = WS_R1 + (size_t)MTOK * D * 2;
constexpr size_t WS_RSTAT = WS_PSTAT + (size_t)MTOK * 16 * 2 * 4;
constexpr size_t WS_SGW = WS_RSTAT + (size_t)MTOK * 2 * 4;
constexpr size_t WS_END = WS_SGW + (size_t)DEPTH * 4 * 128 * 128 * 2;

constexpr int LDS_BYTES = 139264;
constexpr int NTHREADS = 512, NWAVES = 8;
#ifndef DUP
#define DUP 0
#endif

struct Params {
    const float *x, *c, *w_in, *pool_w, *pool_scale, *sgu_ln_g, *sgu_ln_b, *sgu_w, *sgu_b, *w_out, *ada_w, *ada_b, *ln_g, *ln_b;
    float* out; unsigned char* ws;
    int ph_lo, ph_hi;
};

DI unsigned pk2(float lo, float hi) { f32x2_t v = {lo, hi}; bf16x2_t b = __builtin_convertvector(v, bf16x2_t); return __builtin_bit_cast(unsigned, b); }
DI float bf2f(unsigned short u) { return __builtin_bit_cast(float, (unsigned)u << 16); }
DI float bflo(unsigned u) { return __builtin_bit_cast(float, u << 16); }
DI float bfhi(unsigned u) { return __builtin_bit_cast(float, u & 0xffff0000u); }
DI float silu_f(float v) { return v * __builtin_amdgcn_rcpf(1.f + __builtin_amdgcn_exp2f(-v * LOG2E)); }
DI float wave_sum(float v) {
#pragma unroll
    for (int o = 1; o < 64; o <<= 1) v += __shfl_xor(v, o);
    return v;
}
DI float swap32(float v, int hh) {
    const unsigned u = __builtin_bit_cast(unsigned, v);
    const auto rr = __builtin_amdgcn_permlane32_swap(u, u, false, false);
    return __builtin_bit_cast(float, hh ? rr[0] : rr[1]);
}
DI int crow(int i, int hh) { return (i & 3) + 8 * (i >> 2) + 4 * hh; }
#define MFMA32(a, b, c) __builtin_amdgcn_mfma_f32_32x32x16_bf16((a), (b), (c), 0, 0, 0)
#define LDS_WAIT() asm volatile("s_waitcnt lgkmcnt(0)" ::: "memory")

struct EpiP {
    static constexpr bool PERM = true, AFTER_DRAIN = false;
    bf16_t* O; bf16_t* QKV;
    DI void operator()(const pg8::f32x4 (&acc)[2][2][4][2], const pg8::Unit& u, int wr, int wc, int fr, int fq) const {
        const int row0 = u.pm * 256 + wr * 64 + fr;
        const bool qkv = (u.pn >= 5 && u.pn < 11);
        bf16_t* base; size_t rstride; int bjstride;
        if (qkv) {
            const int which = (u.pn - 5) >> 1, b = (u.pm * 256) >> 11, s0 = (u.pm * 256) & (SEQ - 1);
            base = QKV + (size_t)which * QKV_ONE + ((size_t)b * 8 + ((u.pn - 5) & 1) * 4 + (wc >> 1)) * QKV_PAIR + (size_t)(s0 + wr * 64 + fr) * 64 + (wc & 1) * 32 + 8 * fq;
            rstride = 64; bjstride = 2 * (int)QKV_PAIR;
        } else {
            const int pcol = (u.pn < 5 ? u.pn * 256 : u.pn * 256 - 1536) + wc * 32 + 8 * fq;
            base = O + (size_t)row0 * NP + pcol; rstride = NP; bjstride = 128;
        }
#pragma unroll
        for (int ai = 0; ai < 2; ++ai)
#pragma unroll
            for (int m = 0; m < 4; ++m) {
                bf16_t* rowp = base + (size_t)(ai * 128 + m * 16) * rstride;
#pragma unroll
                for (int bj = 0; bj < 2; ++bj) {
                    const pg8::f32x4 v0 = acc[ai][bj][m][0], v1 = acc[ai][bj][m][1];
                    u32x4 w; w.x = pk2(v0[0], v0[1]); w.y = pk2(v0[2], v0[3]); w.z = pk2(v1[0], v1[1]); w.w = pk2(v1[2], v1[3]);
                    *(u32x4*)(rowp + (size_t)bj * bjstride) = w;
                }
            }
    }
};
struct EpiRes {
    static constexpr bool PERM = true, AFTER_DRAIN = false;
    const float* xsrc;
    const bf16_t* rsrc;
    const float* rstat;
    const float* lng; const float* lnb;
    const float* gate;
    bf16_t* R; float* pstat;
    DI void operator()(const pg8::f32x4 (&acc)[2][2][4][2], const pg8::Unit& u, int wr, int wc, int fr, int fq) const {
        const int row0 = u.pm * 256 + wr * 64 + fr, col0 = u.pn * 256 + wc * 32 + 8 * fq;
        const int b = (u.pm * 256) >> 11;
        f32x4 ga[2][2];
#pragma unroll
        for (int bj = 0; bj < 2; ++bj)
#pragma unroll
            for (int n = 0; n < 2; ++n) ga[bj][n] = *(const f32x4*)(gate + (size_t)b * 3072 + col0 + bj * 128 + 4 * n);
#pragma unroll
        for (int ai = 0; ai < 2; ++ai)
#pragma unroll
            for (int m = 0; m < 4; ++m) {
                const int row = row0 + ai * 128 + m * 16;
                float mean = 0.f, rstd = 1.f;
                if (rsrc) { const f32x2_t st = *(const f32x2_t*)(rstat + (size_t)row * 2); mean = st.x; rstd = st.y; }
                float s = 0.f, ss = 0.f;
#pragma unroll
                for (int bj = 0; bj < 2; ++bj) {
                    const int col = col0 + bj * 128;
                    f32x4 x0, x1;
                    if (rsrc) {
                        const u32x4 rv = *(const u32x4*)(rsrc + (size_t)row * D + col);
                        x0 = (f32x4){bflo(rv.x), bfhi(rv.x), bflo(rv.y), bfhi(rv.y)}; x1 = (f32x4){bflo(rv.z), bfhi(rv.z), bflo(rv.w), bfhi(rv.w)};
                        x0 = (x0 - mean) * rstd * *(const f32x4*)(lng + col) + *(const f32x4*)(lnb + col);
                        x1 = (x1 - mean) * rstd * *(const f32x4*)(lng + col + 4) + *(const f32x4*)(lnb + col + 4);
                    } else { x0 = *(const f32x4*)(xsrc + (size_t)row * D + col); x1 = *(const f32x4*)(xsrc + (size_t)row * D + col + 4); }
                    const f32x4 v0 = x0 * DN_ALPHA + ga[bj][0] * acc[ai][bj][m][0], v1 = x1 * DN_ALPHA + ga[bj][1] * acc[ai][bj][m][1];
                    u32x4 w; w.x = pk2(v0[0], v0[1]); w.y = pk2(v0[2], v0[3]); w.z = pk2(v1[0], v1[1]); w.w = pk2(v1[2], v1[3]);
                    *(u32x4*)(R + (size_t)row * D + col) = w;
                    const float r0 = bflo(w.x), r1 = bfhi(w.x), r2 = bflo(w.y), r3 = bfhi(w.y), r4 = bflo(w.z), r5 = bfhi(w.z), r6 = bflo(w.w), r7 = bfhi(w.w);
                    s += ((r0 + r1) + (r2 + r3)) + ((r4 + r5) + (r6 + r7));
                    ss += ((r0 * r0 + r1 * r1) + (r2 * r2 + r3 * r3)) + ((r4 * r4 + r5 * r5) + (r6 * r6 + r7 * r7));
                }
                s += __shfl_xor(s, 16); ss += __shfl_xor(ss, 16);
                s += __shfl_xor(s, 32); ss += __shfl_xor(ss, 32);
                if (fq == 0) { f32x2_t o = {s, ss}; *(f32x2_t*)(pstat + ((size_t)row * 16 + u.pn * 4 + wc) * 2) = o; }
            }
    }
};

DI void transpose_item(const float* W, int K, int N, bf16_t* WT, LAS float* scr, int item, int lane) {
    const int nblk = N / 32, kb = item / nblk, nb = item % nblk, k0 = 64 * kb, n0 = 32 * nb;
#pragma unroll 8
    for (int i = 0; i < 32; ++i) { const int kk = 2 * i + (lane >> 5); scr[kk * 33 + (lane & 31)] = W[(size_t)(k0 + kk) * N + n0 + (lane & 31)]; }
    LDS_WAIT();
    const int c = lane & 7;
#pragma unroll
    for (int j = 0; j < 4; ++j) {
        const int n = (lane >> 3) + 8 * j; const LAS float* s = scr + (8 * c) * 33 + n;
        u32x4 o; o.x = pk2(s[0 * 33], s[1 * 33]); o.y = pk2(s[2 * 33], s[3 * 33]); o.z = pk2(s[4 * 33], s[5 * 33]); o.w = pk2(s[6 * 33], s[7 * 33]);
        *(u32x4*)(WT + (size_t)(n0 + n) * K + k0 + 8 * c) = o;
    }
    LDS_WAIT();
}

DI void phase0(const Params& P, LAS unsigned char* lds, int tid, int lane, int wave) {
    tid = launder_v(tid); lane = launder_v(lane); wave = launder_s(wave);
    bf16_t* win_t = (bf16_t*)(P.ws + WS_WIN); bf16_t* wout_t = (bf16_t*)(P.ws + WS_WOUT); float* mod = (float*)(P.ws + WS_MOD);
    for (int i = blockIdx.x * NTHREADS + tid; i < DEPTH * 4 * 128 * 128 / 8; i += gridDim.x * NTHREADS) {
        const f32x4 w0 = *(const f32x4*)(P.sgu_w + (size_t)i * 8), w1 = *(const f32x4*)(P.sgu_w + (size_t)i * 8 + 4);
        u32x4 o; o.x = pk2(w0[0], w0[1]); o.y = pk2(w0[2], w0[3]); o.z = pk2(w1[0], w1[1]); o.w = pk2(w1[2], w1[3]);
        *(u32x4*)(P.ws + WS_SGW + (size_t)i * 16) = o;
    }
    {
        LAS float* scr = (LAS float*)(lds + wave * 16384);
        const int gw = blockIdx.x * NWAVES + wave, NGW = gridDim.x * NWAVES;
        constexpr int I_IN = (D / 64) * (NIN / 32), I_OUT = (D / 64) * (D / 32);
        for (int it = gw; it < DEPTH * (I_IN + I_OUT); it += NGW) {
            const int l = it / (I_IN + I_OUT); int r = it % (I_IN + I_OUT);
            if (r < I_IN) transpose_item(P.w_in + (size_t)l * D * NIN, D, NIN, win_t + (size_t)l * NIN * D, scr, r, lane);
            else transpose_item(P.w_out + (size_t)l * D * D, D, D, wout_t + (size_t)l * D * D, scr, r - I_IN, lane);
        }
    }
    __syncthreads();
    LAS float* sc = (LAS float*)lds;
    for (int item = blockIdx.x; item < DEPTH * 96; item += gridDim.x) {
        const int l = item / 96, j0 = (item % 96) * 32;
        for (int e = tid; e < BATCH * D; e += NTHREADS) { const int b = e >> 10, k = e & 1023; sc[k * 32 + b] = silu_f(P.c[e]); }
        __syncthreads();
        const int j = tid & 31, ks = tid >> 5;
        float acc[32];
#pragma unroll
        for (int b = 0; b < 32; ++b) acc[b] = 0.f;
        const float* wp = P.ada_w + ((size_t)l * D + ks * 64) * 3072 + j0 + j;
#pragma unroll 2
        for (int kk = 0; kk < 64; ++kk) {
            const float w = wp[(size_t)kk * 3072];
            const LAS f32x4* s4 = (const LAS f32x4*)(sc + (ks * 64 + kk) * 32);
#pragma unroll
            for (int q = 0; q < 8; ++q) { const f32x4 v = s4[q]; acc[4 * q] += v[0] * w; acc[4 * q + 1] += v[1] * w; acc[4 * q + 2] += v[2] * w; acc[4 * q + 3] += v[3] * w; }
        }
        __syncthreads();
        LAS float* red = (LAS float*)lds;
#pragma unroll
        for (int b = 0; b < 32; ++b) red[(ks * 32 + b) * 32 + j] = acc[b];
        __syncthreads();
#pragma unroll
        for (int o2 = 0; o2 < 2; ++o2) {
            const int o = tid + o2 * NTHREADS, b = o >> 5, jj = o & 31;
            float s = P.ada_b[l * 3072 + j0 + jj];
#pragma unroll
            for (int q = 0; q < 16; ++q) s += red[(q * 32 + b) * 32 + jj];
            mod[((size_t)l * BATCH + b) * 3072 + j0 + jj] = s;
        }
        __syncthreads();
    }
}

template <int MODE>
DI void row_pass(const Params& P, int lane, int wave) {
    lane = launder_v(lane); wave = launder_s(wave);
    const int gw = blockIdx.x * NWAVES + wave, NGW = gridDim.x * NWAVES;
    const float* mod = (const float*)(P.ws + WS_MOD) + (MODE == 1 ? (size_t)BATCH * 3072 : 0);
    const float* pstat = (const float*)(P.ws + WS_PSTAT);
    float* rstat = (float*)(P.ws + WS_RSTAT);
    bf16_t* hb = (bf16_t*)(P.ws + WS_HB);
    const bf16_t* rsrc = (const bf16_t*)(P.ws + (MODE == 1 ? WS_R0 : WS_R1));
    const float* lg = P.ln_g + (MODE == 2 ? D : 0); const float* lb = P.ln_b + (MODE == 2 ? D : 0);
    constexpr int RU = 4;
    for (int row0 = gw * RU; row0 < MTOK; row0 += NGW * RU) {
        f32x4 v[RU][2][2];
        if (MODE == 0) {
#pragma unroll
            for (int u = 0; u < RU; ++u)
#pragma unroll
                for (int j = 0; j < 2; ++j) { const float* xp = P.x + (size_t)(row0 + u) * D + 8 * lane + 512 * j; v[u][j][0] = *(const f32x4*)xp; v[u][j][1] = *(const f32x4*)(xp + 4); }
        } else {
            u32x4 raw[RU][2];
#pragma unroll
            for (int u = 0; u < RU; ++u)
#pragma unroll
                for (int j = 0; j < 2; ++j) raw[u][j] = *(const u32x4*)(rsrc + (size_t)(row0 + u) * D + 8 * lane + 512 * j);
#pragma unroll
            for (int u = 0; u < RU; ++u)
#pragma unroll
                for (int j = 0; j < 2; ++j) {
                    v[u][j][0] = (f32x4){bflo(raw[u][j].x), bfhi(raw[u][j].x), bflo(raw[u][j].y), bfhi(raw[u][j].y)};
                    v[u][j][1] = (f32x4){bflo(raw[u][j].z), bfhi(raw[u][j].z), bflo(raw[u][j].w), bfhi(raw[u][j].w)};
                }
        }
        float mean[RU], rstd[RU];
#pragma unroll
        for (int u = 0; u < RU; ++u) { mean[u] = 0.f; rstd[u] = 1.f; }
        if (MODE != 0) {
            const f32x2_t st = *(const f32x2_t*)(pstat + ((size_t)(row0 + (lane >> 4)) * 16 + (lane & 15)) * 2);
            float s = st.x, ss = st.y;
#pragma unroll
            for (int o = 1; o < 16; o <<= 1) { s += __shfl_xor(s, o); ss += __shfl_xor(ss, o); }
            const float m = s * (1.f / D); const float var = fmaxf(ss * (1.f / D) - m * m, 0.f); const float rs = 1.f / sqrtf(var + LN_EPS);
            if (MODE == 1 && (lane & 15) == 0) { f32x2_t o = {m, rs}; *(f32x2_t*)(rstat + (size_t)(row0 + (lane >> 4)) * 2) = o; }
#pragma unroll
            for (int u = 0; u < RU; ++u) { mean[u] = __shfl(m, 16 * u); rstd[u] = __shfl(rs, 16 * u); }
        }
        const int b = row0 >> 11;
#pragma unroll
        for (int j = 0; j < 2; ++j)
#pragma unroll
            for (int q = 0; q < 2; ++q) {
                const int col = 8 * lane + 512 * j + 4 * q;
                f32x4 g = {1.f, 1.f, 1.f, 1.f}, bb = {0.f, 0.f, 0.f, 0.f}, sh = bb, scl = bb;
                if (MODE != 0) { g = *(const f32x4*)(lg + col); bb = *(const f32x4*)(lb + col); }
                if (MODE != 2) { sh = *(const f32x4*)(mod + (size_t)b * 3072 + col); scl = *(const f32x4*)(mod + (size_t)b * 3072 + 1024 + col); }
#pragma unroll
                for (int u = 0; u < RU; ++u) {
                    f32x4 w = v[u][j][q];
                    if (MODE != 0) w = (w - mean[u]) * rstd[u] * g + bb;
                    if (MODE == 2) *(f32x4*)(P.out + (size_t)(row0 + u) * D + col) = w;
                    else v[u][j][q] = w * (scl + 1.f) + sh;
                }
            }
        if (MODE != 2) {
#pragma unroll
            for (int u = 0; u < RU; ++u)
#pragma unroll
                for (int j = 0; j < 2; ++j) {
                    const f32x4 a = v[u][j][0], c = v[u][j][1];
                    u32x4 o; o.x = pk2(a[0], a[1]); o.y = pk2(a[2], a[3]); o.z = pk2(c[0], c[1]); o.w = pk2(c[2], c[3]);
                    *(u32x4*)(hb + (size_t)(row0 + u) * D + 8 * lane + 512 * j) = o;
                }
        }
    }
}

constexpr int VT_PITCH = 272;
constexpr int SG_OST = 36;
DI int vt_off(int ch) { return ch * VT_PITCH + (ch >> 6) * 32; }
DI void sgu_unit(const Params& P, int l, int unit, LAS unsigned char* lds, int tid, int lane, int wave) {
    const bf16_t* p = (const bf16_t*)(P.ws + WS_P); bf16_t* Y = (bf16_t*)(P.ws + WS_Y);
    const int tok0 = unit * 128;
    {
        const int s = tid >> 2, qd = tid & 3;
        const bf16_t* vp = p + (size_t)(tok0 + s) * NP + C_VS + qd * 64;
        u32x4 raw[8];
#pragma unroll
        for (int c = 0; c < 8; ++c) raw[c] = *(const u32x4*)(vp + 8 * c);
        float sm = 0.f, sq = 0.f;
#pragma unroll
        for (int c = 0; c < 8; ++c) {
            const float a0 = bflo(raw[c].x), a1 = bfhi(raw[c].x), a2 = bflo(raw[c].y), a3 = bfhi(raw[c].y), a4 = bflo(raw[c].z), a5 = bfhi(raw[c].z), a6 = bflo(raw[c].w), a7 = bfhi(raw[c].w);
            sm += ((a0 + a1) + (a2 + a3)) + ((a4 + a5) + (a6 + a7));
            sq += ((a0 * a0 + a1 * a1) + (a2 * a2 + a3 * a3)) + ((a4 * a4 + a5 * a5) + (a6 * a6 + a7 * a7));
        }
        sm += __shfl_xor(sm, 1); sq += __shfl_xor(sq, 1);
        sm += __shfl_xor(sm, 2); sq += __shfl_xor(sq, 2);
        const float mean = sm * (1.f / 256.f);
        const float var = fmaxf(sq * (1.f / 256.f) - mean * mean, 0.f);
        const float rstd = 1.f / sqrtf(var + LN_EPS);
        const float* gp = P.sgu_ln_g + l * 256 + qd * 64; const float* bp = P.sgu_ln_b + l * 256 + qd * 64;
        LAS bf16_t* vt = (LAS bf16_t*)(lds + vt_off(qd * 64) + s * 2);
#pragma unroll
        for (int c = 0; c < 8; ++c) {
            const f32x4 g0 = *(const f32x4*)(gp + 8 * c), g1 = *(const f32x4*)(gp + 8 * c + 4), b0 = *(const f32x4*)(bp + 8 * c), b1 = *(const f32x4*)(bp + 8 * c + 4);
            const float a[8] = {bflo(raw[c].x), bfhi(raw[c].x), bflo(raw[c].y), bfhi(raw[c].y), bflo(raw[c].z), bfhi(raw[c].z), bflo(raw[c].w), bfhi(raw[c].w)};
#pragma unroll
            for (int e = 0; e < 8; ++e) {
                const float gg = e < 4 ? g0[e & 3] : g1[e & 3], bb = e < 4 ? b0[e & 3] : b1[e & 3];
                vt[(8 * c + e) * (VT_PITCH / 2)] = (bf16_t)(pk2((a[e] - mean) * rstd * gg + bb, 0.f) & 0xffffu);
            }
        }
    }
    const int h = wave & 3, dblk = wave >> 2, r = lane & 31, hh = lane >> 5;
    const int ch = h * 64 + 32 * dblk + r;
    const bf16_t* wb = (const bf16_t*)(P.ws + WS_SGW) + ((size_t)(l * 4 + h) * 128 + r) * 128 + 8 * hh;
    bf16x8 af[24];
#pragma unroll
    for (int ks = 0; ks < 4; ++ks)
#pragma unroll
        for (int tb = 0; tb < 4; ++tb) af[ks * 4 + tb] = *(const bf16x8*)(wb + (size_t)(32 * tb) * 128 + 16 * ks);
#pragma unroll
    for (int ks = 4; ks < 8; ++ks)
#pragma unroll
        for (int tb = 2; tb < 4; ++tb) af[16 + (ks - 4) * 2 + (tb - 2)] = *(const bf16x8*)(wb + (size_t)(32 * tb) * 128 + 16 * ks);
    __syncthreads();
    f32x16 acc[4];
#pragma unroll
    for (int tb = 0; tb < 4; ++tb)
#pragma unroll
        for (int i = 0; i < 16; ++i) acc[tb][i] = 0.f;
#pragma unroll
    for (int ks = 0; ks < 8; ++ks) {
        const bf16x8 bfrag = *(const LAS bf16x8*)(lds + vt_off(ch) + (16 * ks + 8 * hh) * 2);
#pragma unroll
        for (int tb = (ks < 4 ? 0 : 2); tb < 4; ++tb)
            acc[tb] = MFMA32(ks < 4 ? af[ks * 4 + tb] : af[16 + (ks - 4) * 2 + (tb - 2)], bfrag, acc[tb]);
    }
    const int erow = lane >> 2, edc = lane & 3;
    const size_t ecol = (size_t)h * 64 + 32 * dblk + edc * 8;
    u32x4 uu[8], gg[8];
#pragma unroll
    for (int k = 0; k < 8; ++k) {
        const size_t tok = (size_t)(tok0 + erow + 16 * k);
        uu[k] = *(const u32x4*)(p + tok * NP + C_U + ecol); gg[k] = *(const u32x4*)(p + tok * NP + C_GB + ecol);
    }
    __syncthreads();
    LAS float* ost = (LAS float*)(lds + wave * (64 * SG_OST * 4));
    const float* sb = P.sgu_b + (l * 4 + h) * 128;
#pragma unroll
    for (int half = 0; half < 2; ++half) {
#pragma unroll
        for (int tb2 = 0; tb2 < 2; ++tb2)
#pragma unroll
            for (int i = 0; i < 16; ++i) ost[(32 * tb2 + crow(i, hh)) * SG_OST + r] = acc[2 * half + tb2][i];
#pragma unroll
        for (int it = 0; it < 4; ++it) {
            const int k = 4 * half + it, t = erow + 16 * k;
            const LAS float* op = ost + (erow + 16 * it) * SG_OST + edc * 8;
            const f32x4 a = *(const LAS f32x4*)op, b = *(const LAS f32x4*)(op + 4);
            const float bias = sb[t];
            const u32x4 u = uu[k], g = gg[k];
            u32x4 w;
            w.x = pk2(bflo(u.x) * (a[0] + bias) * silu_f(bflo(g.x)), bfhi(u.x) * (a[1] + bias) * silu_f(bfhi(g.x)));
            w.y = pk2(bflo(u.y) * (a[2] + bias) * silu_f(bflo(g.y)), bfhi(u.y) * (a[3] + bias) * silu_f(bfhi(g.y)));
            w.z = pk2(bflo(u.z) * (b[0] + bias) * silu_f(bflo(g.z)), bfhi(u.z) * (b[1] + bias) * silu_f(bfhi(g.z)));
            w.w = pk2(bflo(u.w) * (b[2] + bias) * silu_f(bflo(g.w)), bfhi(u.w) * (b[3] + bias) * silu_f(bfhi(g.w)));
            *(u32x4*)(Y + (size_t)(tok0 + t) * D + 256 + ecol) = w;
        }
    }
    __syncthreads();
}

typedef short v4i16_t __attribute__((ext_vector_type(4)));
DI v4i16_t lds_tr16(const LAS unsigned char* p) { return __builtin_amdgcn_ds_read_tr16_b64_v4i16((LAS v4i16_t*)p); }
constexpr int OST_PITCH = 68;
DI void tile_epilogue(const f32x16& o0, const f32x16& o1, LAS float* ost, int lane, const bf16_t* grow  , bf16_t* yrow, const float* colscale) {
    const int r = lane & 31, hh = lane >> 5;
#pragma unroll
    for (int i = 0; i < 16; ++i) { ost[crow(i, hh) * OST_PITCH + r] = o0[i]; ost[crow(i, hh) * OST_PITCH + 32 + r] = o1[i]; }
#pragma unroll
    for (int it = 0; it < 4; ++it) {
        const int c = lane + 64 * it, q = c >> 3, dc = c & 7;
        const u32x4 g = *(const u32x4*)(grow + (size_t)q * NP + dc * 8);
        const f32x4 a = *(const LAS f32x4*)(ost + q * OST_PITCH + dc * 8), b = *(const LAS f32x4*)(ost + q * OST_PITCH + dc * 8 + 4);
        f32x4 s0 = {1.f, 1.f, 1.f, 1.f}, s1 = s0;
        if (colscale) { s0 = *(const f32x4*)(colscale + dc * 8); s1 = *(const f32x4*)(colscale + dc * 8 + 4); }
        u32x4 w;
        w.x = pk2(a[0] * s0[0] * silu_f(bflo(g.x)), a[1] * s0[1] * silu_f(bfhi(g.x)));
        w.y = pk2(a[2] * s0[2] * silu_f(bflo(g.y)), a[3] * s0[3] * silu_f(bfhi(g.y)));
        w.z = pk2(b[0] * s1[0] * silu_f(bflo(g.z)), b[1] * s1[1] * silu_f(bfhi(g.z)));
        w.w = pk2(b[2] * s1[2] * silu_f(bflo(g.w)), b[3] * s1[3] * silu_f(bfhi(g.w)));
        *(u32x4*)(yrow + (size_t)q * D + dc * 8) = w;
    }
}

constexpr int PA_PITCH = 144;
DI void pool_wave(const Params& P, int l, int gw, int NGW, int lane, LAS unsigned char* wl) {
    const bf16_t* p = (const bf16_t*)(P.ws + WS_P); bf16_t* Y = (bf16_t*)(P.ws + WS_Y);
    const int g = gw & 3, r = lane & 31, hh = lane >> 5;
    const int win = 2 << g;
    LAS float* ost = (LAS float*)(wl + 7168);
    bf16x8 bw[4][2];
#pragma unroll
    for (int s = 0; s < 4; ++s)
#pragma unroll
        for (int db = 0; db < 2; ++db) {
            const float* wp = P.pool_w + ((size_t)(l * 4 + g) * 64 + 16 * s + 8 * hh) * 64 + 32 * db + r;
            u32x4 a; a.x = pk2(wp[0], wp[64]); a.y = pk2(wp[128], wp[192]); a.z = pk2(wp[256], wp[320]); a.w = pk2(wp[384], wp[448]);
            bw[s][db] = __builtin_bit_cast(bf16x8, a);
        }
    const f32x4 ps0 = *(const f32x4*)(P.pool_scale + l * 256 + g * 64 + (lane & 7) * 8), ps1 = *(const f32x4*)(P.pool_scale + l * 256 + g * 64 + (lane & 7) * 8 + 4);
    const int tstep = NGW >> 2;
    int tile = gw >> 2;
    if (tile >= MTOK / 32) return;
    u32x4 av[6], gv[4];
#pragma unroll
    for (int it = 0; it < 6; ++it) {
        const int row = (lane >> 3) + 8 * it;
        av[it] = (u32x4){0u, 0u, 0u, 0u};
        if (row >= 16 || ((tile * 32) & (SEQ - 1)) != 0) av[it] = *(const u32x4*)(p + (size_t)(tile * 32 - 16 + row) * NP + C_A + g * 64 + (lane & 7) * 8);
    }
#pragma unroll
    for (int it = 0; it < 4; ++it) gv[it] = *(const u32x4*)(p + (size_t)(tile * 32 + (lane >> 3) + 8 * it) * NP + C_GA + g * 64 + (lane & 7) * 8);
    for (;;) {
        const int tok0 = tile * 32, pos = (tok0 & (SEQ - 1)) + r;
#pragma unroll
        for (int it = 0; it < 6; ++it) *(LAS u32x4*)(wl + ((lane >> 3) + 8 * it) * PA_PITCH + (lane & 7) * 16) = av[it];
        const int ntile = tile + tstep;
        const bool has_next = ntile < MTOK / 32;
        if (has_next) {
#pragma unroll
            for (int it = 0; it < 6; ++it) {
                const int row = (lane >> 3) + 8 * it;
                av[it] = (u32x4){0u, 0u, 0u, 0u};
                if (row >= 16 || ((ntile * 32) & (SEQ - 1)) != 0) av[it] = *(const u32x4*)(p + (size_t)(ntile * 32 - 16 + row) * NP + C_A + g * 64 + (lane & 7) * 8);
            }
        }
        const int cnt = (pos + 1 < win) ? pos + 1 : win;
        const float inv = 1.f / (float)cnt;
        f32x16 acc0, acc1;
#pragma unroll
        for (int i = 0; i < 16; ++i) { acc0[i] = 0.f; acc1[i] = 0.f; }
#pragma unroll
        for (int s = 0; s < 4; ++s) {
            const LAS unsigned char* base = wl + (16 + r) * PA_PITCH + (16 * s + 8 * hh) * 2;
            const u32x4 own = *(const LAS u32x4*)base;
            float sum[8];
            sum[0] = bflo(own.x); sum[1] = bfhi(own.x); sum[2] = bflo(own.y); sum[3] = bfhi(own.y); sum[4] = bflo(own.z); sum[5] = bfhi(own.z); sum[6] = bflo(own.w); sum[7] = bfhi(own.w);
            for (int j = 1; j < win; ++j) {
                const u32x4 v = *(const LAS u32x4*)(base - j * PA_PITCH);
                sum[0] += bflo(v.x); sum[1] += bfhi(v.x); sum[2] += bflo(v.y); sum[3] += bfhi(v.y); sum[4] += bflo(v.z); sum[5] += bfhi(v.z); sum[6] += bflo(v.w); sum[7] += bfhi(v.w);
            }
            u32x4 a;
            a.x = pk2(sum[0] * inv - bflo(own.x), sum[1] * inv - bfhi(own.x)); a.y = pk2(sum[2] * inv - bflo(own.y), sum[3] * inv - bfhi(own.y));
            a.z = pk2(sum[4] * inv - bflo(own.z), sum[5] * inv - bfhi(own.z)); a.w = pk2(sum[6] * inv - bflo(own.w), sum[7] * inv - bfhi(own.w));
            const bf16x8 af = __builtin_bit_cast(bf16x8, a);
            acc0 = MFMA32(af, bw[s][0], acc0);
            acc1 = MFMA32(af, bw[s][1], acc1);
        }
#pragma unroll
        for (int i = 0; i < 16; ++i) { ost[crow(i, hh) * OST_PITCH + r] = acc0[i]; ost[crow(i, hh) * OST_PITCH + 32 + r] = acc1[i]; }
#pragma unroll
        for (int it = 0; it < 4; ++it) {
            const int q = (lane >> 3) + 8 * it;
            const LAS float* op = ost + q * OST_PITCH + (lane & 7) * 8;
            const f32x4 a = *(const LAS f32x4*)op, b = *(const LAS f32x4*)(op + 4);
            const u32x4 gq = gv[it];
            u32x4 w;
            w.x = pk2(a[0] * ps0[0] * silu_f(bflo(gq.x)), a[1] * ps0[1] * silu_f(bfhi(gq.x)));
            w.y = pk2(a[2] * ps0[2] * silu_f(bflo(gq.y)), a[3] * ps0[3] * silu_f(bfhi(gq.y)));
            w.z = pk2(b[0] * ps1[0] * silu_f(bflo(gq.z)), b[1] * ps1[1] * silu_f(bfhi(gq.z)));
            w.w = pk2(b[2] * ps1[2] * silu_f(bflo(gq.w)), b[3] * ps1[3] * silu_f(bfhi(gq.w)));
            *(u32x4*)(Y + (size_t)(tok0 + q) * D + g * 64 + (lane & 7) * 8) = w;
        }
        if (!has_next) break;
#pragma unroll
        for (int it = 0; it < 4; ++it) gv[it] = *(const u32x4*)(p + (size_t)(ntile * 32 + (lane >> 3) + 8 * it) * NP + C_GA + g * 64 + (lane & 7) * 8);
        tile = ntile;
    }
}

constexpr int KT_PITCH = 144;
constexpr int VT_OFF = 32 * KT_PITCH;
DI bool attn_tile(const bf16x8 (&qf)[4], f32x16& o0, f32x16& o1, float& carry, bool diag, LAS unsigned char* wl, int frd, int trbase, int r, int hh) {
    const float CZ = 0.125f * LOG2E;
    f32x16 z;
#pragma unroll
    for (int i = 0; i < 16; ++i) z[i] = 0.f;
#pragma unroll
    for (int s = 0; s < 4; ++s) { const bf16x8 kf = *(const LAS bf16x8*)(wl + frd + s * 32); z = MFMA32(kf, qf[s], z); }
    float l1m[16], lbv[16];
#pragma unroll
    for (int i = 0; i < 16; ++i) {
        const float t = z[i] * CZ;
        const float e = __builtin_amdgcn_exp2f(-fabsf(t));
        const float sp = fmaxf(t, 0.f) + __builtin_amdgcn_logf(1.f + e);
        l1m[i] = -sp; lbv[i] = t - sp;
    }
    if (diag) {
#pragma unroll
        for (int i = 0; i < 16; ++i) if (crow(i, hh) >= r) { l1m[i] = 0.f; lbv[i] = -__builtin_inff(); }
    }
    float gs[4], og[4];
#pragma unroll
    for (int q = 0; q < 4; ++q) { gs[q] = (l1m[4 * q] + l1m[4 * q + 1]) + (l1m[4 * q + 2] + l1m[4 * q + 3]); og[q] = swap32(gs[q], hh); }
    float suf = carry;
    float a[16];
#pragma unroll
    for (int q = 3; q >= 0; --q) {
        float lat = suf + (hh == 0 ? og[q] : 0.f);
        a[4 * q + 3] = __builtin_amdgcn_exp2f(lbv[4 * q + 3] + lat); lat += l1m[4 * q + 3];
        a[4 * q + 2] = __builtin_amdgcn_exp2f(lbv[4 * q + 2] + lat); lat += l1m[4 * q + 2];
        a[4 * q + 1] = __builtin_amdgcn_exp2f(lbv[4 * q + 1] + lat); lat += l1m[4 * q + 1];
        a[4 * q] = __builtin_amdgcn_exp2f(lbv[4 * q] + lat);
        suf += gs[q] + og[q];
    }
    carry = suf;
    u32x4 pa0, pa1;
    pa0.x = pk2(a[0], a[1]); pa0.y = pk2(a[2], a[3]); pa0.z = pk2(a[4], a[5]); pa0.w = pk2(a[6], a[7]);
    pa1.x = pk2(a[8], a[9]); pa1.y = pk2(a[10], a[11]); pa1.z = pk2(a[12], a[13]); pa1.w = pk2(a[14], a[15]);
    bf16x8 vf[2][2];
#pragma unroll
    for (int s = 0; s < 2; ++s)
#pragma unroll
        for (int db = 0; db < 2; ++db) {
            const v4i16_t lo = lds_tr16(wl + trbase + db * 2048 + (16 * s) * 64), hi = lds_tr16(wl + trbase + db * 2048 + (16 * s + 8) * 64);
            vf[s][db] = __builtin_shufflevector(lo, hi, 0, 1, 2, 3, 4, 5, 6, 7);
        }
    o0 = MFMA32(__builtin_bit_cast(bf16x8, pa0), vf[0][0], o0);
    o0 = MFMA32(__builtin_bit_cast(bf16x8, pa1), vf[1][0], o0);
    o1 = MFMA32(__builtin_bit_cast(bf16x8, pa0), vf[0][1], o1);
    o1 = MFMA32(__builtin_bit_cast(bf16x8, pa1), vf[1][1], o1);
    return __ballot(carry > -160.f) == 0ull;
}
DI void attn_store(const f32x16& o0, const f32x16& o1, LAS float* ost, int lane, const bf16_t* gp  , bf16_t* yp  ) {
    const int r = lane & 31, hh = lane >> 5;
    u32x4 gt[4];
#pragma unroll
    for (int it = 0; it < 4; ++it) gt[it] = *(const u32x4*)(gp + (size_t)it * 8 * NP);
#pragma unroll
    for (int i = 0; i < 16; ++i) { ost[crow(i, hh) * OST_PITCH + r] = o0[i]; ost[crow(i, hh) * OST_PITCH + 32 + r] = o1[i]; }
#pragma unroll
    for (int it = 0; it < 4; ++it) {
        const LAS float* op = ost + ((lane >> 3) + 8 * it) * OST_PITCH + (lane & 7) * 8;
        const f32x4 a = *(const LAS f32x4*)op, bq = *(const LAS f32x4*)(op + 4);
        const u32x4 g = gt[it];
        u32x4 w;
        w.x = pk2(a[0] * silu_f(bflo(g.x)), a[1] * silu_f(bfhi(g.x)));
        w.y = pk2(a[2] * silu_f(bflo(g.y)), a[3] * silu_f(bfhi(g.y)));
        w.z = pk2(bq[0] * silu_f(bflo(g.z)), bq[1] * silu_f(bfhi(g.z)));
        w.w = pk2(bq[2] * silu_f(bflo(g.w)), bq[3] * silu_f(bfhi(g.w)));
        *(u32x4*)(yp + (size_t)it * 8 * D) = w;
    }
}
DI void attn_wave(const Params& P, int gw, int NGW, int lane, LAS unsigned char* wl) {
    const bf16_t* p = (const bf16_t*)(P.ws + WS_P); bf16_t* Y = (bf16_t*)(P.ws + WS_Y);
    constexpr int NU = BATCH * 8 * 32;
    const int r = lane & 31, hh = lane >> 5;
    LAS float* ost = (LAS float*)wl;
    const int klds = (lane >> 3) * KT_PITCH + (lane & 7) * 16;
    const int vlds = VT_OFF + ((lane & 7) >> 2) * 2048 + (lane >> 3) * 64 + (lane & 3) * 16;
    const int frd = r * KT_PITCH + hh * 16;
    const int trbase = VT_OFF + (4 * hh + ((lane & 15) >> 2)) * 64 + ((lane >> 4) & 1) * 32 + (lane & 3) * 8;
    const bf16_t* qb = (const bf16_t*)(P.ws + WS_QKV); const bf16_t* kbuf = qb + QKV_ONE; const bf16_t* vbuf = qb + 2 * QKV_ONE;
    for (int unit = gw; unit < NU; unit += NGW) {
        const int j = unit & 31, pair = unit >> 5, h = pair & 7, b = pair >> 3;
        const size_t pairoff = (size_t)pair * QKV_PAIR + (size_t)lane * 8;
        const bf16_t* kp0 = kbuf + pairoff; const bf16_t* vp0 = vbuf + pairoff;
        const int qtB = 2 * j + 1, qtA = 2 * j;
        u32x4 kn[4], vn[4];
        bf16x8 qfA[4], qfB[4];
        {
            u32x4 qa[4], qv[4];
#pragma unroll
            for (int it = 0; it < 4; ++it) qa[it] = *(const u32x4*)(qb + pairoff + (size_t)qtA * 2048 + it * 512);
#pragma unroll
            for (int it = 0; it < 4; ++it) qv[it] = *(const u32x4*)(qb + pairoff + (size_t)qtB * 2048 + it * 512);
#pragma unroll
            for (int it = 0; it < 4; ++it) kn[it] = *(const u32x4*)(kp0 + (size_t)qtB * 2048 + it * 512);
#pragma unroll
            for (int it = 0; it < 4; ++it) vn[it] = *(const u32x4*)(vp0 + (size_t)qtB * 2048 + it * 512);
#pragma unroll
            for (int it = 0; it < 4; ++it) *(LAS u32x4*)(wl + klds + it * 8 * KT_PITCH) = qa[it];
#pragma unroll
            for (int s = 0; s < 4; ++s) qfA[s] = *(const LAS bf16x8*)(wl + frd + s * 32);
#pragma unroll
            for (int it = 0; it < 4; ++it) *(LAS u32x4*)(wl + klds + it * 8 * KT_PITCH) = qv[it];
#pragma unroll
            for (int s = 0; s < 4; ++s) qfB[s] = *(const LAS bf16x8*)(wl + frd + s * 32);
        }
        f32x16 oA0, oA1, oB0, oB1;
#pragma unroll
        for (int i = 0; i < 16; ++i) { oA0[i] = 0.f; oA1[i] = 0.f; oB0[i] = 0.f; oB1[i] = 0.f; }
        float carryA = 0.f, carryB = 0.f;
        bool doneA = false, doneB = false;
        for (int kb = qtB; kb >= 0; --kb) {
#pragma unroll
            for (int it = 0; it < 4; ++it) *(LAS u32x4*)(wl + klds + it * 8 * KT_PITCH) = kn[it];
#pragma unroll
            for (int it = 0; it < 4; ++it) *(LAS u32x4*)(wl + vlds + it * 512) = vn[it];
            if (kb > 0) {
                const size_t o = (size_t)(kb - 1) * 2048;
#pragma unroll
                for (int it = 0; it < 4; ++it) kn[it] = *(const u32x4*)(kp0 + o + it * 512);
#pragma unroll
                for (int it = 0; it < 4; ++it) vn[it] = *(const u32x4*)(vp0 + o + it * 512);
            }
            if (!doneB) doneB = attn_tile(qfB, oB0, oB1, carryB, kb == qtB, wl, frd, trbase, r, hh);
            if (kb <= qtA && !doneA) doneA = attn_tile(qfA, oA0, oA1, carryA, kb == qtA, wl, frd, trbase, r, hh);
            if (doneA && doneB) break;
        }
        const size_t tokb = (size_t)b * SEQ;
        const bf16_t* gp = p + (tokb + qtA * 32 + (lane >> 3)) * NP + C_GC + h * 64 + (lane & 7) * 8;
        bf16_t* yp = Y + (tokb + qtA * 32 + (lane >> 3)) * D + 512 + h * 64 + (lane & 7) * 8;
        attn_store(oA0, oA1, ost, lane, gp, yp);
        attn_store(oB0, oB1, ost, lane, gp + (size_t)32 * NP, yp + (size_t)32 * D);
    }
}

DI void mixers(const Params& P, int l, LAS unsigned char* lds, int lane, int wave) {
    lane = launder_v(lane); wave = launder_s(wave);
    const int gw = blockIdx.x * NWAVES + wave, NGW = gridDim.x * NWAVES;
#ifndef MXMASK
#define MXMASK 7
#endif
    for (int rep = 0; rep < ((DUP & 4) ? 2 : 1); ++rep)
    if (MXMASK & 1) for (int unit = blockIdx.x; unit < BATCH * 16; unit += gridDim.x) sgu_unit(P, l, unit, lds, launder_v(threadIdx.x), lane, wave);
    for (int rep = 0; rep < ((DUP & 8) ? 2 : 1); ++rep)
    if (MXMASK & 2) pool_wave(P, l, gw, NGW, lane, lds + wave * 16384);
    for (int rep = 0; rep < ((DUP & 16) ? 2 : 1); ++rep)
    if (MXMASK & 4) attn_wave(P, gw, NGW, lane, lds + wave * 16384);
}

__global__ void __launch_bounds__(NTHREADS, 2) fwd_mega(Params P) {
    extern __shared__ __attribute__((aligned(16))) unsigned char lds_raw[];
    LAS unsigned char* lds = (LAS unsigned char*)lds_raw;
    cg::grid_group grid = cg::this_grid();
    const int tid = threadIdx.x, lane = tid & 63, wave = __builtin_amdgcn_readfirstlane(tid >> 6);
    const int lo = P.ph_lo, hi = P.ph_hi;
#ifndef PHMASK
#define PHMASK 0x3ff
#endif
#define IN(k) (((PHMASK >> (k)) & 1) && lo <= (k) && (k) < hi)
#define SEAM(k) do { if (IN(k) && IN((k) + 1)) grid.sync(); } while (0)
    bf16_t* hb = (bf16_t*)(P.ws + WS_HB); bf16_t* pbuf = (bf16_t*)(P.ws + WS_P); bf16_t* ybuf = (bf16_t*)(P.ws + WS_Y);
    const bf16_t* win_t = (const bf16_t*)(P.ws + WS_WIN); const bf16_t* wout_t = (const bf16_t*)(P.ws + WS_WOUT);
    const float* mod = (const float*)(P.ws + WS_MOD);

    if (IN(0)) for (int rep = 0; rep < ((DUP & 64) ? 2 : 1); ++rep) phase0(P, lds, tid, lane, wave);
    SEAM(0);
    if (IN(1)) for (int rep = 0; rep < ((DUP & 32) ? 2 : 1); ++rep) row_pass<0>(P, lane, wave);
    SEAM(1);
#pragma unroll 1
    for (int l = 0; l < DEPTH; ++l) {
        const int pb = 2 + 4 * l;
        if (IN(pb)) for (int rep = 0; rep < ((DUP & 1) ? 2 : 1); ++rep) {
            pg8::Gemm g{hb, win_t + (size_t)l * NIN * D, MTOK, NIN, D}; pg8::StaticOrder S; S.init(MTOK, NIN, (int)gridDim.x, (int)blockIdx.x);
            EpiP E{pbuf, (bf16_t*)(P.ws + WS_QKV)};
            pg8::gemm_phase<EpiP, pg8::StaticOrder, true, true>(lds, g, S, E);
        }
        SEAM(pb);
        if (IN(pb + 1)) mixers(P, l, lds, lane, wave);
        SEAM(pb + 1);
        if (IN(pb + 2)) for (int rep = 0; rep < ((DUP & 2) ? 2 : 1); ++rep) {
            pg8::Gemm g{ybuf, wout_t + (size_t)l * D * D, MTOK, D, D}; pg8::StaticOrder S; S.init(MTOK, D, (int)gridDim.x, (int)blockIdx.x);
            EpiRes E{P.x, l == 0 ? nullptr : (const bf16_t*)(P.ws + WS_R0), (const float*)(P.ws + WS_RSTAT), P.ln_g, P.ln_b,
                     mod + (size_t)l * BATCH * 3072 + 2048, (bf16_t*)(P.ws + (l == 0 ? WS_R0 : WS_R1)), (float*)(P.ws + WS_PSTAT)};
            pg8::gemm_phase<EpiRes, pg8::StaticOrder, true, true>(lds, g, S, E);
        }
        SEAM(pb + 2);
        if (IN(pb + 3)) { if (l == 0) { for (int rep = 0; rep < ((DUP & 32) ? 2 : 1); ++rep) row_pass<1>(P, lane, wave); } else row_pass<2>(P, lane, wave); }
        SEAM(pb + 3);
    }
#undef IN
#undef SEAM
}

#ifndef N_LAUNCH_PER_PHASE
#define N_LAUNCH_PER_PHASE 0
#endif
extern "C" void kernel_launch(void* const* d_in, const int* in_sizes, int n_in, void* d_out, int out_size, void* d_ws, size_t ws_size, hipStream_t stream) {
    static int grid = 0;
    if (grid == 0) {
        if (n_in != 14 || out_size != MTOK * D || ws_size < WS_END) { fprintf(stderr, "kernel_launch: unexpected shapes (n_in %d out %d ws %zu need %zu)\n", n_in, out_size, ws_size, (size_t)WS_END); grid = -1; return; }
        int dev = 0, cus = 0, per_cu = 0;
        hipGetDevice(&dev);
        hipDeviceGetAttribute(&cus, hipDeviceAttributeMultiprocessorCount, dev);
        if (hipFuncSetAttribute((const void*)fwd_mega, hipFuncAttributeMaxDynamicSharedMemorySize, LDS_BYTES) != hipSuccess) { fprintf(stderr, "kernel_launch: hipFuncSetAttribute failed\n"); grid = -1; return; }
        if (hipOccupancyMaxActiveBlocksPerMultiprocessor(&per_cu, (const void*)fwd_mega, NTHREADS, LDS_BYTES) != hipSuccess || per_cu < 1) { fprintf(stderr, "kernel_launch: occupancy query says %d\n", per_cu); per_cu = 1; }
        (void)hipGetLastError();
        grid = cus * 1;
        if (grid != 256) fprintf(stderr, "kernel_launch: note: grid %d\n", grid);
    }
    if (grid < 0) return;
    Params p{};
    p.x = (const float*)d_in[0]; p.c = (const float*)d_in[1]; p.w_in = (const float*)d_in[2]; p.pool_w = (const float*)d_in[3]; p.pool_scale = (const float*)d_in[4];
    p.sgu_ln_g = (const float*)d_in[5]; p.sgu_ln_b = (const float*)d_in[6]; p.sgu_w = (const float*)d_in[7]; p.sgu_b = (const float*)d_in[8]; p.w_out = (const float*)d_in[9];
    p.ada_w = (const float*)d_in[10]; p.ada_b = (const float*)d_in[11]; p.ln_g = (const float*)d_in[12]; p.ln_b = (const float*)d_in[13];
    p.out = (float*)d_out; p.ws = (unsigned char*)d_ws;
#if N_LAUNCH_PER_PHASE
    for (int ph = 0; ph < 10; ++ph) {
        p.ph_lo = ph; p.ph_hi = ph + 1;
        hipLaunchKernelGGL(fwd_mega, dim3(grid), dim3(NTHREADS), LDS_BYTES, stream, p);
    }
#else
    p.ph_lo = 0; p.ph_hi = 10;
    void* args[] = {&p};
    hipError_t e = hipLaunchCooperativeKernel((const void*)fwd_mega, dim3(grid), dim3(NTHREADS), args, LDS_BYTES, stream);
    if (e != hipSuccess) fprintf(stderr, "kernel_launch: cooperative launch failed: %s (grid %d)\n", hipGetErrorString(e), grid);
#endif
}
```

```cpp
#include <hip/hip_runtime.h>
#include <hip/hip_cooperative_groups.h>
#include <cstdio>
#include <cstdint>
namespace cg = cooperative_groups;
__device__ __forceinline__ int launder_v(int x) { asm volatile("" : "+v"(x)); return x; }
__device__ __forceinline__ int launder_s(int x) { asm volatile("" : "+s"(x)); return x; }
namespace pg8 {
#define PG8_LAS __attribute__((address_space(3)))
typedef unsigned short bf16_t;
typedef short bf16x8 __attribute__((ext_vector_type(8)));
typedef float f32x4 __attribute__((ext_vector_type(4)));
typedef unsigned u32x4 __attribute__((ext_vector_type(4)));
constexpr int BM = 256, BK = 64, HALF = 128, HTB = HALF * BK * 2  , STAGE_BYTES = 8 * HTB, NXCD = 8, WGM = 8;

__host__ __device__ __forceinline__ int lds_byte(int r, int c) { const int st = (r >> 4) * 2 + (c >> 5), rr = r & 15, cc = c & 31, ob = rr * 64 + cc * 2; return st * 1024 + (ob ^ (((ob >> 9) & 1) << 5)); }
__host__ __device__ __forceinline__ void stage_rc(int b, int& R, int& C) { const int st = b / 1024, sb = b % 1024, swz = sb ^ (((sb >> 9) & 1) << 5); R = (st >> 1) * 16 + swz / 64; C = (st & 1) * 32 + (swz % 64) / 2; }
__host__ __device__ __forceinline__ int perm32(int rho) { const int n = rho >> 4, i = rho & 15; return 8 * (i >> 2) + 4 * n + (i & 3); }

struct Unit { int pm, pn; };
struct Gemm { const bf16_t* A; const bf16_t* Bt; int M, N, K; };

struct StaticOrder {
    int nM, nN, nwg, G, c;
    __host__ __device__ void init(int M, int N, int G_, int c_) { nM = M / BM; nN = N / BM; nwg = nM * nN; G = G_; c = c_; }
    __host__ __device__ bool next(int i, Unit& u) const {
        const long L = (long)i * G + c; if (L >= nwg) return false;
        int wgid = (int)L; { const int q = nwg / NXCD, r = nwg % NXCD, xcd = wgid % NXCD, off = wgid / NXCD; wgid = (xcd < r ? xcd * (q + 1) : r * (q + 1) + (xcd - r) * q) + off; }
        const int nig = WGM * nN, gid = wgid / nig, fm = gid * WGM, gsz = (nM - fm) < WGM ? (nM - fm) : WGM;
        u.pm = fm + ((wgid % nig) % gsz); u.pn = (wgid % nig) / gsz; return true;
    }
    __device__ __forceinline__ void a_ready(const Unit&) const {}
    __device__ __forceinline__ void done(const Unit&) const {}
};

__device__ __forceinline__ unsigned cvt_pk_bf16(float lo, float hi) { unsigned r; asm volatile("v_cvt_pk_bf16_f32 %0, %1, %2" : "=v"(r) : "v"(lo), "v"(hi)); return r; }
template <class Epi, class Sched, bool ALIGN_EPI = false, bool SP2 = false>
__device__ __forceinline__ void gemm_phase(PG8_LAS unsigned char* lds, const Gemm g, const Sched& S, const Epi& E) {
    const int tid = launder_v(threadIdx.x), wid = __builtin_amdgcn_readfirstlane(tid >> 6), lane = tid & 63, wr = wid >> 2, wc = wid & 3, fr = lane & 15, fq = lane >> 4;
    const int K = g.K, nt = K / BK;
    unsigned voffA[2], voffB[2];
#pragma unroll
    for (int i = 0; i < 2; ++i) { int R, C; stage_rc(tid * 16 + i * 8192, R, C); const int Rb = Epi::PERM ? ((R & ~31) + perm32(R & 31)) : R;
        voffA[i] = (unsigned)(R * K + C) * 2u; voffB[i] = (unsigned)(Rb * K + C) * 2u; }
    const size_t kstep = (size_t)(BK * 2);
    const size_t hstep = (size_t)HALF * K * 2;
    const size_t tstep = 2 * hstep;
    const unsigned ldsw = (unsigned)wid * 1024u;
    const int aoff = lds_byte(wr * 64 + fr, fq * 8), boff = lds_byte(wc * 32 + fr, fq * 8);
#define PG8_SA(b, h) (((b) * 2 + (h)) * HTB)
#define PG8_SB(b, h) ((4 + (b) * 2 + (h)) * HTB)
#define PG8_STAGE(bufoff, gbase, voff) do { _Pragma("unroll") for (int _i = 0; _i < 2; ++_i) \
        __builtin_amdgcn_global_load_lds((const unsigned*)((const char*)(gbase) + (voff)[_i]), (PG8_LAS unsigned*)(lds + (bufoff) + ldsw + _i * 8192), 16, 0, 0); } while (0)
#define PG8_LDA(dst, b, h) do { _Pragma("unroll") for (int m = 0; m < 4; ++m) _Pragma("unroll") for (int k = 0; k < 2; ++k) dst[m][k] = *(const PG8_LAS bf16x8*)(lds + PG8_SA(b, h) + aoff + m * 2048 + k * 1024); } while (0)
#define PG8_LDB(dst, b, h) do { _Pragma("unroll") for (int n = 0; n < 2; ++n) _Pragma("unroll") for (int k = 0; k < 2; ++k) dst[n][k] = *(const PG8_LAS bf16x8*)(lds + PG8_SB(b, h) + boff + n * 2048 + k * 1024); } while (0)
#define PG8_MMA(ai, bj, At, Bt) do { __builtin_amdgcn_s_setprio(1); _Pragma("unroll") for (int m = 0; m < 4; ++m) _Pragma("unroll") for (int n = 0; n < 2; ++n) _Pragma("unroll") for (int k = 0; k < 2; ++k) \
        acc[ai][bj][m][n] = __builtin_amdgcn_mfma_f32_16x16x32_bf16(Bt[n][k], At[m][k], acc[ai][bj][m][n], 0, 0, 0); __builtin_amdgcn_s_setprio(0); } while (0)
#define PG8_WAIT_V(n) asm volatile("s_waitcnt vmcnt(" #n ")" ::: "memory")
#define PG8_WAIT_L(n) asm volatile("s_waitcnt lgkmcnt(" #n ")" ::: "memory")
#define PG8_BAR __builtin_amdgcn_s_barrier()
#define PG8_SCHED __builtin_amdgcn_sched_barrier(0)
    Unit cur, nxt; int ui = 0;
    if (!S.next(0, cur)) return;
    f32x4 acc[2][2][4][2];
#pragma unroll
    for (int a = 0; a < 2; ++a)
#pragma unroll
        for (int b = 0; b < 2; ++b)
#pragma unroll
            for (int m = 0; m < 4; ++m)
#pragma unroll
                for (int n = 0; n < 2; ++n) acc[a][b][m][n] = (f32x4){0.f, 0.f, 0.f, 0.f};
    bf16x8 At[4][2], B0[2][2], B1[2][2];
    const char* cA = (const char*)g.A + (size_t)cur.pm * tstep; const char* cB = (const char*)g.Bt + (size_t)cur.pn * tstep;
    S.a_ready(cur);
    if constexpr (SP2) {
        PG8_STAGE(PG8_SB(0, 0), cB, voffB); PG8_STAGE(PG8_SB(0, 1), cB + hstep, voffB); PG8_STAGE(PG8_SA(0, 0), cA, voffA); PG8_STAGE(PG8_SA(0, 1), cA + hstep, voffA);
        if (wr == 1) PG8_BAR;
        PG8_WAIT_V(2); PG8_BAR;
        PG8_STAGE(PG8_SB(1, 0), cB + kstep, voffB); PG8_STAGE(PG8_SA(1, 0), cA + kstep, voffA); PG8_STAGE(PG8_SB(1, 1), cB + hstep + kstep, voffB);
        PG8_WAIT_V(6); PG8_BAR;
    } else {
        PG8_STAGE(PG8_SB(0, 0), cB, voffB); PG8_STAGE(PG8_SA(0, 0), cA, voffA); PG8_STAGE(PG8_SB(0, 1), cB + hstep, voffB); PG8_STAGE(PG8_SA(0, 1), cA + hstep, voffA);
        if (wr == 1) PG8_BAR;
        PG8_WAIT_V(4); PG8_BAR;
        PG8_STAGE(PG8_SB(1, 0), cB + kstep, voffB); PG8_STAGE(PG8_SA(1, 0), cA + kstep, voffA); PG8_STAGE(PG8_SB(1, 1), cB + hstep + kstep, voffB);
        PG8_WAIT_V(6); PG8_BAR;
    }
    for (;;) {
        const bool has_next = S.next(ui + 1, nxt);
        const char* nA = has_next ? (const char*)g.A + (size_t)nxt.pm * tstep : cA; const char* nB = has_next ? (const char*)g.Bt + (size_t)nxt.pn * tstep : cB;
        for (int t = 0; t < nt; t += 2) {
            const bool last = (t == nt - 2);
            const char* a1 = cA + (size_t)(t + 1) * kstep;
            const char* a2 = last ? nA : cA + (size_t)(t + 2) * kstep; const char* b2 = last ? nB : cB + (size_t)(t + 2) * kstep;
            const char* a3 = a2 + kstep; const char* b3 = b2 + kstep;
            if (last && has_next) S.a_ready(nxt);
            if constexpr (SP2) {
            PG8_LDB(B0, 0, 0); PG8_LDB(B1, 0, 1); PG8_SCHED; PG8_LDA(At, 0, 0); PG8_STAGE(PG8_SA(1, 1), a1 + hstep, voffA);
            PG8_WAIT_V(8); PG8_WAIT_L(0); PG8_BAR; PG8_MMA(0, 0, At, B0); PG8_MMA(0, 1, At, B1); PG8_BAR; PG8_SCHED;
            PG8_LDA(At, 0, 1); PG8_STAGE(PG8_SB(0, 0), b2, voffB); PG8_STAGE(PG8_SB(0, 1), b2 + hstep, voffB); PG8_STAGE(PG8_SA(0, 0), a2, voffA);
            PG8_WAIT_V(8); PG8_WAIT_L(0); PG8_BAR; PG8_MMA(1, 0, At, B0); PG8_MMA(1, 1, At, B1); PG8_BAR; PG8_SCHED;
            PG8_LDB(B0, 1, 0); PG8_LDB(B1, 1, 1); PG8_SCHED; PG8_LDA(At, 1, 0); PG8_STAGE(PG8_SA(0, 1), a2 + hstep, voffA);
            PG8_WAIT_V(8); PG8_WAIT_L(0); PG8_BAR; PG8_MMA(0, 0, At, B0); PG8_MMA(0, 1, At, B1); PG8_BAR; PG8_SCHED;
            PG8_LDA(At, 1, 1); PG8_STAGE(PG8_SB(1, 0), b3, voffB); PG8_STAGE(PG8_SB(1, 1), b3 + hstep, voffB); PG8_STAGE(PG8_SA(1, 0), a3, voffA);
            PG8_WAIT_V(8); PG8_WAIT_L(0); PG8_BAR; PG8_MMA(1, 0, At, B0); PG8_MMA(1, 1, At, B1); PG8_BAR; PG8_SCHED;
            } else {
            PG8_LDB(B0, 0, 0); PG8_SCHED; PG8_LDA(At, 0, 0); PG8_STAGE(PG8_SA(1, 1), a1 + hstep, voffA);
            PG8_WAIT_L(8); PG8_BAR; PG8_WAIT_L(0); PG8_MMA(0, 0, At, B0); PG8_BAR; PG8_SCHED;
            PG8_LDB(B1, 0, 1); PG8_STAGE(PG8_SB(0, 0), b2, voffB);
            PG8_BAR; PG8_WAIT_L(0); PG8_MMA(0, 1, At, B1); PG8_BAR;
            PG8_LDA(At, 0, 1); PG8_STAGE(PG8_SA(0, 0), a2, voffA);
            PG8_BAR; PG8_WAIT_L(0); PG8_MMA(1, 0, At, B0); PG8_BAR; PG8_SCHED;
            PG8_STAGE(PG8_SB(0, 1), b2 + hstep, voffB);
            PG8_WAIT_V(6); PG8_BAR; PG8_MMA(1, 1, At, B1); PG8_BAR;
            PG8_LDB(B0, 1, 0); PG8_SCHED; PG8_LDA(At, 1, 0); PG8_STAGE(PG8_SA(0, 1), a2 + hstep, voffA);
            PG8_WAIT_L(8); PG8_BAR; PG8_WAIT_L(0); PG8_MMA(0, 0, At, B0); PG8_BAR; PG8_SCHED;
            PG8_LDB(B1, 1, 1); PG8_STAGE(PG8_SB(1, 0), b3, voffB);
            PG8_BAR; PG8_WAIT_L(0); PG8_MMA(0, 1, At, B1); PG8_BAR;
            PG8_LDA(At, 1, 1); PG8_STAGE(PG8_SA(1, 0), a3, voffA);
            PG8_BAR; PG8_WAIT_L(0); PG8_MMA(1, 0, At, B0); PG8_BAR; PG8_SCHED;
            PG8_STAGE(PG8_SB(1, 1), b3 + hstep, voffB);
            PG8_WAIT_V(6); PG8_BAR; PG8_MMA(1, 1, At, B1); PG8_BAR;
            }
        }
        if constexpr (ALIGN_EPI) { if (wr == 0) PG8_BAR; }
        if constexpr (!Epi::AFTER_DRAIN) { E(acc, cur, wr, wc, fr, fq); S.done(cur); }
        if (!has_next) break;
#pragma unroll
        for (int a = 0; a < 2; ++a)
#pragma unroll
            for (int b = 0; b < 2; ++b)
#pragma unroll
                for (int m = 0; m < 4; ++m)
#pragma unroll
                    for (int n = 0; n < 2; ++n) acc[a][b][m][n] = (f32x4){0.f, 0.f, 0.f, 0.f};
        cur = nxt; cA = nA; cB = nB; ++ui;
        if constexpr (ALIGN_EPI) { if (wr == 1) PG8_BAR; }
    }
    PG8_WAIT_V(0);
    if constexpr (!ALIGN_EPI) { if (wr == 0) PG8_BAR; }
    PG8_BAR;
    if constexpr (Epi::AFTER_DRAIN) { E.fused(acc, cur, wr, wc, fr, fq, lds, wid, lane); S.done(cur); }
#undef PG8_SA
#undef PG8_SB
#undef PG8_STAGE
#undef PG8_LDA
#undef PG8_LDB
#undef PG8_MMA
#undef PG8_WAIT_V
#undef PG8_WAIT_L
#undef PG8_BAR
#undef PG8_SCHED
}
}

#define DI __device__ __forceinline__
#define LAS __attribute__((address_space(3)))
typedef unsigned short bf16_t;
typedef short bf16x8 __attribute__((ext_vector_type(8)));
typedef float f32x4 __attribute__((ext_vector_type(4)));
typedef float f32x16 __attribute__((ext_vector_type(16)));
typedef unsigned u32x4 __attribute__((ext_vector_type(4)));
typedef unsigned u32x2 __attribute__((ext_vector_type(2)));
typedef __bf16 bf16x2_t __attribute__((ext_vector_type(2)));
typedef float f32x2_t __attribute__((ext_vector_type(2)));

constexpr int D = 1024, BATCH = 32, SEQ = 2048, MTOK = BATCH * SEQ, NIN = 3328, DEPTH = 2;
constexpr int NP = 1792;
constexpr int C_A = 0, C_GA = 256, C_U = 512, C_VS = 768, C_GB = 1024, C_GC = 1280;
constexpr size_t QKV_PAIR = (size_t)SEQ * 64;
constexpr size_t QKV_ONE = (size_t)BATCH * 8 * QKV_PAIR;
constexpr float DN_ALPHA = 1.41421356237309515f;
constexpr float LN_EPS = 1e-5f;
constexpr float LOG2E = 1.44269504088896341f;

constexpr size_t WS_WIN = 0;
constexpr size_t WS_WOUT = WS_WIN + (size_t)DEPTH * NIN * D * 2;
constexpr size_t WS_MOD = WS_WOUT + (size_t)DEPTH * D * D * 2;
constexpr size_t WS_HB = WS_MOD + (size_t)DEPTH * BATCH * 3 * D * 4;
constexpr size_t WS_P = WS_HB + (size_t)MTOK * D * 2;
constexpr size_t WS_QKV = WS_P + (size_t)MTOK * NP * 2;
constexpr size_t WS_Y = WS_QKV + 3 * QKV_ONE * 2;
constexpr size_t WS_R0 = WS_Y + (size_t)MTOK * D * 2;
constexpr size_t WS_R1 = WS_R0 + (size_t)MTOK * D * 2;
constexpr size_t WS_PSTAT = WS_R1 + (size_t)MTOK * D * 2;
constexpr size_t WS_RSTAT = WS_PSTAT + (size_t)MTOK * 16 * 2 * 4;
constexpr size_t WS_SGW = WS_RSTAT + (size_t)MTOK * 2 * 4;
constexpr size_t WS_BAR = WS_SGW + (size_t)DEPTH * 4 * 128 * 128 * 2;
constexpr size_t WS_END = WS_BAR + 16384;

constexpr int LDS_BYTES = 139264;
constexpr int NTHREADS = 512, NWAVES = 8;
#ifndef DUP
#define DUP 0
#endif

struct Params {
    const float *x, *c, *w_in, *pool_w, *pool_scale, *sgu_ln_g, *sgu_ln_b, *sgu_w, *sgu_b, *w_out, *ada_w, *ada_b, *ln_g, *ln_b;
    float* out; unsigned char* ws;
    int ph_lo, ph_hi;
};

DI unsigned pk2(float lo, float hi) { f32x2_t v = {lo, hi}; bf16x2_t b = __builtin_convertvector(v, bf16x2_t); return __builtin_bit_cast(unsigned, b); }
DI float bf2f(unsigned short u) { return __builtin_bit_cast(float, (unsigned)u << 16); }
DI float bflo(unsigned u) { return __builtin_bit_cast(float, u << 16); }
DI float bfhi(unsigned u) { return __builtin_bit_cast(float, u & 0xffff0000u); }
DI float silu_f(float v) { return v * __builtin_amdgcn_rcpf(1.f + __builtin_amdgcn_exp2f(-v * LOG2E)); }
DI float wave_sum(float v) {
#pragma unroll
    for (int o = 1; o < 64; o <<= 1) v += __shfl_xor(v, o);
    return v;
}
DI float swap32(float v, int hh) {
    const unsigned u = __builtin_bit_cast(unsigned, v);
    const auto rr = __builtin_amdgcn_permlane32_swap(u, u, false, false);
    return __builtin_bit_cast(float, hh ? rr[0] : rr[1]);
}
DI int crow(int i, int hh) { return (i & 3) + 8 * (i >> 2) + 4 * hh; }
#define MFMA32(a, b, c) __builtin_amdgcn_mfma_f32_32x32x16_bf16((a), (b), (c), 0, 0, 0)
#define LDS_WAIT() asm volatile("s_waitcnt lgkmcnt(0)" ::: "memory")

#define XB_TMO      128
#define XB_XCNT(j)  (256  + 64 * (j))
#define XB_XSUB(j)  (1280 + 64 * (j))
#define XB_XGEN(j)  (2304 + 64 * (j))
#define XB_TOP      3328
#define XB_TOPGEN   3392
#define XCD_BAR_WORDS 3456
#define XB_SPIN_CAP (1u << 18)

__device__ __forceinline__ unsigned xb_ld(unsigned* p)              { return __hip_atomic_load(p, __ATOMIC_RELAXED, __HIP_MEMORY_SCOPE_AGENT); }
__device__ __forceinline__ unsigned xb_add(unsigned* p, unsigned v) { return __hip_atomic_fetch_add(p, v, __ATOMIC_RELAXED, __HIP_MEMORY_SCOPE_AGENT); }
__device__ __forceinline__ unsigned xb_xcc_id() { return (unsigned)__builtin_amdgcn_s_getreg((3 << 11) | 20) & 0xFu; }
#define XB_SPIN(cond, bar) do { unsigned _sp = 0; while (cond) { __builtin_amdgcn_s_sleep(1); \
    if ((++_sp & 255u) == 0u) { if (xb_ld(&(bar)[XB_TMO])) break; if (_sp > XB_SPIN_CAP) { atomicAdd(&(bar)[XB_TMO], 1u); break; } } } } while (0)

struct XcdBarrier {
    unsigned* bar; unsigned x;
    volatile LAS unsigned* st;
};

__device__ __forceinline__ XcdBarrier xcd_barrier_post(unsigned* bar, volatile LAS unsigned* st) {
    XcdBarrier b; b.bar = bar; b.x = xb_xcc_id(); b.st = st;
    if (threadIdx.x == 0) (void)xb_add(&bar[XB_XCNT(b.x)], 1u);
    return b;
}
__device__ __forceinline__ void xcd_barrier_complete(unsigned* bar, unsigned x, unsigned& nloc, unsigned& nx) {
    const unsigned G = gridDim.x * gridDim.y * gridDim.z;
    unsigned sum, cnt, mine, sp = 0u;
    for (;;) {
        sum = 0u; cnt = 0u; mine = 0u;
#pragma unroll
        for (unsigned j = 0; j < 16; ++j) { const unsigned c = xb_ld(&bar[XB_XCNT(j)]); sum += c; cnt += (c > 0u) ? 1u : 0u; mine = (j == x) ? c : mine; }
        if (sum == G) break;
        __builtin_amdgcn_s_sleep(1);
        if ((++sp & 255u) == 0u) { if (xb_ld(&bar[XB_TMO])) break; if (sp > XB_SPIN_CAP) { atomicAdd(&bar[XB_TMO], 1u); break; } }
    }
    nloc = mine > 0u ? mine : 1u; nx = cnt > 0u ? cnt : 1u;
}

__device__ __forceinline__ void xcd_barrier(const XcdBarrier& b) {
    asm volatile("s_waitcnt vmcnt(0)" ::: "memory");
    __syncthreads();
    if (threadIdx.x == 0) {
        unsigned* bar = b.bar;
        __builtin_amdgcn_s_waitcnt(0);
        unsigned nloc = b.st[0], nx = b.st[1];
        if (nloc == 0u) { xcd_barrier_complete(bar, b.x, nloc, nx); b.st[0] = nloc; b.st[1] = nx; }
        const unsigned old = xb_add(&bar[XB_XSUB(b.x)], 1u);
        const unsigned gen = old / nloc;
        if (old + 1u == (gen + 1u) * nloc) {
            __builtin_amdgcn_fence(__ATOMIC_RELEASE, "agent");
            asm volatile("s_waitcnt vmcnt(0)" ::: "memory");
            const unsigned og = xb_add(&bar[XB_TOP], 1u);
            const unsigned tg = og / nx;
            if (og + 1u == (tg + 1u) * nx) xb_add(&bar[XB_TOPGEN], 1u);
            else XB_SPIN(xb_ld(&bar[XB_TOPGEN]) == tg, bar);
            __builtin_amdgcn_fence(__ATOMIC_ACQUIRE, "agent");
            xb_add(&bar[XB_XGEN(b.x)], 1u);
            asm volatile("s_waitcnt vmcnt(0)" ::: "memory");
        } else {
            XB_SPIN(xb_ld(&bar[XB_XGEN(b.x)]) == gen, bar);
            __builtin_amdgcn_fence(__ATOMIC_ACQUIRE, "agent");
            asm volatile("s_waitcnt vmcnt(0)" ::: "memory");
        }
    }
    __syncthreads();
}

struct EpiP {
    static constexpr bool PERM = true, AFTER_DRAIN = false;
    bf16_t* O; bf16_t* QKV;
    DI void operator()(const pg8::f32x4 (&acc)[2][2][4][2], const pg8::Unit& u, int wr, int wc, int fr, int fq) const {
        const int row0 = u.pm * 256 + wr * 64 + fr;
        const bool qkv = (u.pn >= 5 && u.pn < 11);
        bf16_t* base; size_t rstride; int bjstride;
        if (qkv) {
            const int which = (u.pn - 5) >> 1, b = (u.pm * 256) >> 11, s0 = (u.pm * 256) & (SEQ - 1);
            base = QKV + (size_t)which * QKV_ONE + ((size_t)b * 8 + ((u.pn - 5) & 1) * 4 + (wc >> 1)) * QKV_PAIR + (size_t)(s0 + wr * 64 + fr) * 64 + (wc & 1) * 32 + 8 * fq;
            rstride = 64; bjstride = 2 * (int)QKV_PAIR;
        } else {
            const int pcol = (u.pn < 5 ? u.pn * 256 : u.pn * 256 - 1536) + wc * 32 + 8 * fq;
            base = O + (size_t)row0 * NP + pcol; rstride = NP; bjstride = 128;
        }
#pragma unroll
        for (int ai = 0; ai < 2; ++ai)
#pragma unroll
            for (int m = 0; m < 4; ++m) {
                bf16_t* rowp = base + (size_t)(ai * 128 + m * 16) * rstride;
#pragma unroll
                for (int bj = 0; bj < 2; ++bj) {
                    const pg8::f32x4 v0 = acc[ai][bj][m][0], v1 = acc[ai][bj][m][1];
                    u32x4 w; w.x = pk2(v0[0], v0[1]); w.y = pk2(v0[2], v0[3]); w.z = pk2(v1[0], v1[1]); w.w = pk2(v1[2], v1[3]);
                    *(u32x4*)(rowp + (size_t)bj * bjstride) = w;
                }
            }
    }
};
struct EpiRes {
    static constexpr bool PERM = true, AFTER_DRAIN = false;
    const float* xsrc;
    const bf16_t* rsrc;
    const float* rstat;
    const float* lng; const float* lnb;
    const float* gate;
    bf16_t* R; float* pstat;
    DI void operator()(const pg8::f32x4 (&acc)[2][2][4][2], const pg8::Unit& u, int wr, int wc, int fr, int fq) const {
        const int row0 = u.pm * 256 + wr * 64 + fr, col0 = u.pn * 256 + wc * 32 + 8 * fq;
        const int b = (u.pm * 256) >> 11;
        f32x4 ga[2][2];
#pragma unroll
        for (int bj = 0; bj < 2; ++bj)
#pragma unroll
            for (int n = 0; n < 2; ++n) ga[bj][n] = *(const f32x4*)(gate + (size_t)b * 3072 + col0 + bj * 128 + 4 * n);
#pragma unroll
        for (int ai = 0; ai < 2; ++ai)
#pragma unroll
            for (int m = 0; m < 4; ++m) {
                const int row = row0 + ai * 128 + m * 16;
                float mean = 0.f, rstd = 1.f;
                if (rsrc) { const f32x2_t st = *(const f32x2_t*)(rstat + (size_t)row * 2); mean = st.x; rstd = st.y; }
                float s = 0.f, ss = 0.f;
#pragma unroll
                for (int bj = 0; bj < 2; ++bj) {
                    const int col = col0 + bj * 128;
                    f32x4 x0, x1;
                    if (rsrc) {
                        const u32x4 rv = *(const u32x4*)(rsrc + (size_t)row * D + col);
                        x0 = (f32x4){bflo(rv.x), bfhi(rv.x), bflo(rv.y), bfhi(rv.y)}; x1 = (f32x4){bflo(rv.z), bfhi(rv.z), bflo(rv.w), bfhi(rv.w)};
                        x0 = (x0 - mean) * rstd * *(const f32x4*)(lng + col) + *(const f32x4*)(lnb + col);
                        x1 = (x1 - mean) * rstd * *(const f32x4*)(lng + col + 4) + *(const f32x4*)(lnb + col + 4);
                    } else { x0 = *(const f32x4*)(xsrc + (size_t)row * D + col); x1 = *(const f32x4*)(xsrc + (size_t)row * D + col + 4); }
                    const f32x4 v0 = x0 * DN_ALPHA + ga[bj][0] * acc[ai][bj][m][0], v1 = x1 * DN_ALPHA + ga[bj][1] * acc[ai][bj][m][1];
                    u32x4 w; w.x = pk2(v0[0], v0[1]); w.y = pk2(v0[2], v0[3]); w.z = pk2(v1[0], v1[1]); w.w = pk2(v1[2], v1[3]);
                    *(u32x4*)(R + (size_t)row * D + col) = w;
                    const float r0 = bflo(w.x), r1 = bfhi(w.x), r2 = bflo(w.y), r3 = bfhi(w.y), r4 = bflo(w.z), r5 = bfhi(w.z), r6 = bflo(w.w), r7 = bfhi(w.w);
                    s += ((r0 + r1) + (r2 + r3)) + ((r4 + r5) + (r6 + r7));
                    ss += ((r0 * r0 + r1 * r1) + (r2 * r2 + r3 * r3)) + ((r4 * r4 + r5 * r5) + (r6 * r6 + r7 * r7));
                }
                s += __shfl_xor(s, 16); ss += __shfl_xor(ss, 16);
                s += __shfl_xor(s, 32); ss += __shfl_xor(ss, 32);
                if (fq == 0) { f32x2_t o = {s, ss}; *(f32x2_t*)(pstat + ((size_t)row * 16 + u.pn * 4 + wc) * 2) = o; }
            }
    }
};

DI void transpose_item(const float* W, int K, int N, bf16_t* WT, LAS float* scr, int item, int lane) {
    const int nblk = N / 32, kb = item / nblk, nb = item % nblk, k0 = 64 * kb, n0 = 32 * nb;
#pragma unroll 8
    for (int i = 0; i < 32; ++i) { const int kk = 2 * i + (lane >> 5); scr[kk * 33 + (lane & 31)] = W[(size_t)(k0 + kk) * N + n0 + (lane & 31)]; }
    LDS_WAIT();
    const int c = lane & 7;
#pragma unroll
    for (int j = 0; j < 4; ++j) {
        const int n = (lane >> 3) + 8 * j; const LAS float* s = scr + (8 * c) * 33 + n;
        u32x4 o; o.x = pk2(s[0 * 33], s[1 * 33]); o.y = pk2(s[2 * 33], s[3 * 33]); o.z = pk2(s[4 * 33], s[5 * 33]); o.w = pk2(s[6 * 33], s[7 * 33]);
        *(u32x4*)(WT + (size_t)(n0 + n) * K + k0 + 8 * c) = o;
    }
    LDS_WAIT();
}

DI void phase0(const Params& P, LAS unsigned char* lds, int tid, int lane, int wave) {
    tid = launder_v(tid); lane = launder_v(lane); wave = launder_s(wave);
    bf16_t* win_t = (bf16_t*)(P.ws + WS_WIN); bf16_t* wout_t = (bf16_t*)(P.ws + WS_WOUT); float* mod = (float*)(P.ws + WS_MOD);
    for (int i = blockIdx.x * NTHREADS + tid; i < DEPTH * 4 * 128 * 128 / 8; i += gridDim.x * NTHREADS) {
        const f32x4 w0 = *(const f32x4*)(P.sgu_w + (size_t)i * 8), w1 = *(const f32x4*)(P.sgu_w + (size_t)i * 8 + 4);
        u32x4 o; o.x = pk2(w0[0], w0[1]); o.y = pk2(w0[2], w0[3]); o.z = pk2(w1[0], w1[1]); o.w = pk2(w1[2], w1[3]);
        *(u32x4*)(P.ws + WS_SGW + (size_t)i * 16) = o;
    }
    {
        LAS float* scr = (LAS float*)(lds + wave * 16384);
        const int gw = blockIdx.x * NWAVES + wave, NGW = gridDim.x * NWAVES;
        constexpr int I_IN = (D / 64) * (NIN / 32), I_OUT = (D / 64) * (D / 32);
        for (int it = gw; it < DEPTH * (I_IN + I_OUT); it += NGW) {
            const int l = it / (I_IN + I_OUT); int r = it % (I_IN + I_OUT);
            if (r < I_IN) transpose_item(P.w_in + (size_t)l * D * NIN, D, NIN, win_t + (size_t)l * NIN * D, scr, r, lane);
            else transpose_item(P.w_out + (size_t)l * D * D, D, D, wout_t + (size_t)l * D * D, scr, r - I_IN, lane);
        }
    }
    __syncthreads();
    LAS float* sc = (LAS float*)lds;
    for (int item = blockIdx.x; item < DEPTH * 96; item += gridDim.x) {
        const int l = item / 96, j0 = (item % 96) * 32;
        for (int e = tid; e < BATCH * D; e += NTHREADS) { const int b = e >> 10, k = e & 1023; sc[k * 32 + b] = silu_f(P.c[e]); }
        __syncthreads();
        const int j = tid & 31, ks = tid >> 5;
        float acc[32];
#pragma unroll
        for (int b = 0; b < 32; ++b) acc[b] = 0.f;
        const float* wp = P.ada_w + ((size_t)l * D + ks * 64) * 3072 + j0 + j;
#pragma unroll 2
        for (int kk = 0; kk < 64; ++kk) {
            const float w = wp[(size_t)kk * 3072];
            const LAS f32x4* s4 = (const LAS f32x4*)(sc + (ks * 64 + kk) * 32);
#pragma unroll
            for (int q = 0; q < 8; ++q) { const f32x4 v = s4[q]; acc[4 * q] += v[0] * w; acc[4 * q + 1] += v[1] * w; acc[4 * q + 2] += v[2] * w; acc[4 * q + 3] += v[3] * w; }
        }
        __syncthreads();
        LAS float* red = (LAS float*)lds;
#pragma unroll
        for (int b = 0; b < 32; ++b) red[(ks * 32 + b) * 32 + j] = acc[b];
        __syncthreads();
#pragma unroll
        for (int o2 = 0; o2 < 2; ++o2) {
            const int o = tid + o2 * NTHREADS, b = o >> 5, jj = o & 31;
            float s = P.ada_b[l * 3072 + j0 + jj];
#pragma unroll
            for (int q = 0; q < 16; ++q) s += red[(q * 32 + b) * 32 + jj];
            mod[((size_t)l * BATCH + b) * 3072 + j0 + jj] = s;
        }
        __syncthreads();
    }
}

template <int MODE>
DI void row_pass(const Params& P, int lane, int wave) {
    lane = launder_v(lane); wave = launder_s(wave);
    const int gw = blockIdx.x * NWAVES + wave, NGW = gridDim.x * NWAVES;
    const float* mod = (const float*)(P.ws + WS_MOD) + (MODE == 1 ? (size_t)BATCH * 3072 : 0);
    const float* pstat = (const float*)(P.ws + WS_PSTAT);
    float* rstat = (float*)(P.ws + WS_RSTAT);
    bf16_t* hb = (bf16_t*)(P.ws + WS_HB);
    const bf16_t* rsrc = (const bf16_t*)(P.ws + (MODE == 1 ? WS_R0 : WS_R1));
    const float* lg = P.ln_g + (MODE == 2 ? D : 0); const float* lb = P.ln_b + (MODE == 2 ? D : 0);
    constexpr int RU = 4;
    for (int row0 = gw * RU; row0 < MTOK; row0 += NGW * RU) {
        f32x4 v[RU][2][2];
        if (MODE == 0) {
#pragma unroll
            for (int u = 0; u < RU; ++u)
#pragma unroll
                for (int j = 0; j < 2; ++j) { const float* xp = P.x + (size_t)(row0 + u) * D + 8 * lane + 512 * j; v[u][j][0] = *(const f32x4*)xp; v[u][j][1] = *(const f32x4*)(xp + 4); }
        } else {
            u32x4 raw[RU][2];
#pragma unroll
            for (int u = 0; u < RU; ++u)
#pragma unroll
                for (int j = 0; j < 2; ++j) raw[u][j] = *(const u32x4*)(rsrc + (size_t)(row0 + u) * D + 8 * lane + 512 * j);
#pragma unroll
            for (int u = 0; u < RU; ++u)
#pragma unroll
                for (int j = 0; j < 2; ++j) {
                    v[u][j][0] = (f32x4){bflo(raw[u][j].x), bfhi(raw[u][j].x), bflo(raw[u][j].y), bfhi(raw[u][j].y)};
                    v[u][j][1] = (f32x4){bflo(raw[u][j].z), bfhi(raw[u][j].z), bflo(raw[u][j].w), bfhi(raw[u][j].w)};
                }
        }
        float mean[RU], rstd[RU];
#pragma unroll
        for (int u = 0; u < RU; ++u) { mean[u] = 0.f; rstd[u] = 1.f; }
        if (MODE != 0) {
            const f32x2_t st = *(const f32x2_t*)(pstat + ((size_t)(row0 + (lane >> 4)) * 16 + (lane & 15)) * 2);
            float s = st.x, ss = st.y;
#pragma unroll
            for (int o = 1; o < 16; o <<= 1) { s += __shfl_xor(s, o); ss += __shfl_xor(ss, o); }
            const float m = s * (1.f / D); const float var = fmaxf(ss * (1.f / D) - m * m, 0.f); const float rs = 1.f / sqrtf(var + LN_EPS);
            if (MODE == 1 && (lane & 15) == 0) { f32x2_t o = {m, rs}; *(f32x2_t*)(rstat + (size_t)(row0 + (lane >> 4)) * 2) = o; }
#pragma unroll
            for (int u = 0; u < RU; ++u) { mean[u] = __shfl(m, 16 * u); rstd[u] = __shfl(rs, 16 * u); }
        }
        const int b = row0 >> 11;
#pragma unroll
        for (int j = 0; j < 2; ++j)
#pragma unroll
            for (int q = 0; q < 2; ++q) {
                const int col = 8 * lane + 512 * j + 4 * q;
                f32x4 g = {1.f, 1.f, 1.f, 1.f}, bb = {0.f, 0.f, 0.f, 0.f}, sh = bb, scl = bb;
                if (MODE != 0) { g = *(const f32x4*)(lg + col); bb = *(const f32x4*)(lb + col); }
                if (MODE != 2) { sh = *(const f32x4*)(mod + (size_t)b * 3072 + col); scl = *(const f32x4*)(mod + (size_t)b * 3072 + 1024 + col); }
#pragma unroll
                for (int u = 0; u < RU; ++u) {
                    f32x4 w = v[u][j][q];
                    if (MODE != 0) w = (w - mean[u]) * rstd[u] * g + bb;
                    if (MODE == 2) *(f32x4*)(P.out + (size_t)(row0 + u) * D + col) = w;
                    else v[u][j][q] = w * (scl + 1.f) + sh;
                }
            }
        if (MODE != 2) {
#pragma unroll
            for (int u = 0; u < RU; ++u)
#pragma unroll
                for (int j = 0; j < 2; ++j) {
                    const f32x4 a = v[u][j][0], c = v[u][j][1];
                    u32x4 o; o.x = pk2(a[0], a[1]); o.y = pk2(a[2], a[3]); o.z = pk2(c[0], c[1]); o.w = pk2(c[2], c[3]);
                    *(u32x4*)(hb + (size_t)(row0 + u) * D + 8 * lane + 512 * j) = o;
                }
        }
    }
}

constexpr int VT_PITCH = 272;
constexpr int SG_OST = 36;
DI int vt_off(int ch) { return ch * VT_PITCH + (ch >> 6) * 32; }
DI void sgu_unit(const Params& P, int l, int unit, LAS unsigned char* lds, int tid, int lane, int wave) {
    const bf16_t* p = (const bf16_t*)(P.ws + WS_P); bf16_t* Y = (bf16_t*)(P.ws + WS_Y);
    const int tok0 = unit * 128;
    {
        const int s = tid >> 2, qd = tid & 3;
        const bf16_t* vp = p + (size_t)(tok0 + s) * NP + C_VS + qd * 64;
        u32x4 raw[8];
#pragma unroll
        for (int c = 0; c < 8; ++c) raw[c] = *(const u32x4*)(vp + 8 * c);
        float sm = 0.f, sq = 0.f;
#pragma unroll
        for (int c = 0; c < 8; ++c) {
            const float a0 = bflo(raw[c].x), a1 = bfhi(raw[c].x), a2 = bflo(raw[c].y), a3 = bfhi(raw[c].y), a4 = bflo(raw[c].z), a5 = bfhi(raw[c].z), a6 = bflo(raw[c].w), a7 = bfhi(raw[c].w);
            sm += ((a0 + a1) + (a2 + a3)) + ((a4 + a5) + (a6 + a7));
            sq += ((a0 * a0 + a1 * a1) + (a2 * a2 + a3 * a3)) + ((a4 * a4 + a5 * a5) + (a6 * a6 + a7 * a7));
        }
        sm += __shfl_xor(sm, 1); sq += __shfl_xor(sq, 1);
        sm += __shfl_xor(sm, 2); sq += __shfl_xor(sq, 2);
        const float mean = sm * (1.f / 256.f);
        const float var = fmaxf(sq * (1.f / 256.f) - mean * mean, 0.f);
        const float rstd = 1.f / sqrtf(var + LN_EPS);
        const float* gp = P.sgu_ln_g + l * 256 + qd * 64; const float* bp = P.sgu_ln_b + l * 256 + qd * 64;
        LAS bf16_t* vt = (LAS bf16_t*)(lds + vt_off(qd * 64) + s * 2);
#pragma unroll
        for (int c = 0; c < 8; ++c) {
            const f32x4 g0 = *(const f32x4*)(gp + 8 * c), g1 = *(const f32x4*)(gp + 8 * c + 4), b0 = *(const f32x4*)(bp + 8 * c), b1 = *(const f32x4*)(bp + 8 * c + 4);
            const float a[8] = {bflo(raw[c].x), bfhi(raw[c].x), bflo(raw[c].y), bfhi(raw[c].y), bflo(raw[c].z), bfhi(raw[c].z), bflo(raw[c].w), bfhi(raw[c].w)};
#pragma unroll
            for (int e = 0; e < 8; ++e) {
                const float gg = e < 4 ? g0[e & 3] : g1[e & 3], bb = e < 4 ? b0[e & 3] : b1[e & 3];
                vt[(8 * c + e) * (VT_PITCH / 2)] = (bf16_t)(pk2((a[e] - mean) * rstd * gg + bb, 0.f) & 0xffffu);
            }
        }
    }
    const int h = wave & 3, dblk = wave >> 2, r = lane & 31, hh = lane >> 5;
    const int ch = h * 64 + 32 * dblk + r;
    const bf16_t* wb = (const bf16_t*)(P.ws + WS_SGW) + ((size_t)(l * 4 + h) * 128 + r) * 128 + 8 * hh;
    bf16x8 af[24];
#pragma unroll
    for (int ks = 0; ks < 4; ++ks)
#pragma unroll
        for (int tb = 0; tb < 4; ++tb) af[ks * 4 + tb] = *(const bf16x8*)(wb + (size_t)(32 * tb) * 128 + 16 * ks);
#pragma unroll
    for (int ks = 4; ks < 8; ++ks)
#pragma unroll
        for (int tb = 2; tb < 4; ++tb) af[16 + (ks - 4) * 2 + (tb - 2)] = *(const bf16x8*)(wb + (size_t)(32 * tb) * 128 + 16 * ks);
    __syncthreads();
    f32x16 acc[4];
#pragma unroll
    for (int tb = 0; tb < 4; ++tb)
#pragma unroll
        for (int i = 0; i < 16; ++i) acc[tb][i] = 0.f;
#pragma unroll
    for (int ks = 0; ks < 8; ++ks) {
        const bf16x8 bfrag = *(const LAS bf16x8*)(lds + vt_off(ch) + (16 * ks + 8 * hh) * 2);
#pragma unroll
        for (int tb = (ks < 4 ? 0 : 2); tb < 4; ++tb)
            acc[tb] = MFMA32(ks < 4 ? af[ks * 4 + tb] : af[16 + (ks - 4) * 2 + (tb - 2)], bfrag, acc[tb]);
    }
    const int erow = lane >> 2, edc = lane & 3;
    const size_t ecol = (size_t)h * 64 + 32 * dblk + edc * 8;
    u32x4 uu[8], gg[8];
#pragma unroll
    for (int k = 0; k < 8; ++k) {
        const size_t tok = (size_t)(tok0 + erow + 16 * k);
        uu[k] = *(const u32x4*)(p + tok * NP + C_U + ecol); gg[k] = *(const u32x4*)(p + tok * NP + C_GB + ecol);
    }
    __syncthreads();
    LAS float* ost = (LAS float*)(lds + wave * (64 * SG_OST * 4));
    const float* sb = P.sgu_b + (l * 4 + h) * 128;
#pragma unroll
    for (int half = 0; half < 2; ++half) {
#pragma unroll
        for (int tb2 = 0; tb2 < 2; ++tb2)
#pragma unroll
            for (int i = 0; i < 16; ++i) ost[(32 * tb2 + crow(i, hh)) * SG_OST + r] = acc[2 * half + tb2][i];
#pragma unroll
        for (int it = 0; it < 4; ++it) {
            const int k = 4 * half + it, t = erow + 16 * k;
            const LAS float* op = ost + (erow + 16 * it) * SG_OST + edc * 8;
            const f32x4 a = *(const LAS f32x4*)op, b = *(const LAS f32x4*)(op + 4);
            const float bias = sb[t];
            const u32x4 u = uu[k], g = gg[k];
            u32x4 w;
            w.x = pk2(bflo(u.x) * (a[0] + bias) * silu_f(bflo(g.x)), bfhi(u.x) * (a[1] + bias) * silu_f(bfhi(g.x)));
            w.y = pk2(bflo(u.y) * (a[2] + bias) * silu_f(bflo(g.y)), bfhi(u.y) * (a[3] + bias) * silu_f(bfhi(g.y)));
            w.z = pk2(bflo(u.z) * (b[0] + bias) * silu_f(bflo(g.z)), bfhi(u.z) * (b[1] + bias) * silu_f(bfhi(g.z)));
            w.w = pk2(bflo(u.w) * (b[2] + bias) * silu_f(bflo(g.w)), bfhi(u.w) * (b[3] + bias) * silu_f(bfhi(g.w)));
            *(u32x4*)(Y + (size_t)(tok0 + t) * D + 256 + ecol) = w;
        }
    }
    __syncthreads();
}

typedef short v4i16_t __attribute__((ext_vector_type(4)));
DI v4i16_t lds_tr16(const LAS unsigned char* p) { return __builtin_amdgcn_ds_read_tr16_b64_v4i16((LAS v4i16_t*)p); }
constexpr int OST_PITCH = 68;
DI void tile_epilogue(const f32x16& o0, const f32x16& o1, LAS float* ost, int lane, const bf16_t* grow  , bf16_t* yrow, const float* colscale) {
    const int r = lane & 31, hh = lane >> 5;
#pragma unroll
    for (int i = 0; i < 16; ++i) { ost[crow(i, hh) * OST_PITCH + r] = o0[i]; ost[crow(i, hh) * OST_PITCH + 32 + r] = o1[i]; }
#pragma unroll
    for (int it = 0; it < 4; ++it) {
        const int c = lane + 64 * it, q = c >> 3, dc = c & 7;
        const u32x4 g = *(const u32x4*)(grow + (size_t)q * NP + dc * 8);
        const f32x4 a = *(const LAS f32x4*)(ost + q * OST_PITCH + dc * 8), b = *(const LAS f32x4*)(ost + q * OST_PITCH + dc * 8 + 4);
        f32x4 s0 = {1.f, 1.f, 1.f, 1.f}, s1 = s0;
        if (colscale) { s0 = *(const f32x4*)(colscale + dc * 8); s1 = *(const f32x4*)(colscale + dc * 8 + 4); }
        u32x4 w;
        w.x = pk2(a[0] * s0[0] * silu_f(bflo(g.x)), a[1] * s0[1] * silu_f(bfhi(g.x)));
        w.y = pk2(a[2] * s0[2] * silu_f(bflo(g.y)), a[3] * s0[3] * silu_f(bfhi(g.y)));
        w.z = pk2(b[0] * s1[0] * silu_f(bflo(g.z)), b[1] * s1[1] * silu_f(bfhi(g.z)));
        w.w = pk2(b[2] * s1[2] * silu_f(bflo(g.w)), b[3] * s1[3] * silu_f(bfhi(g.w)));
        *(u32x4*)(yrow + (size_t)q * D + dc * 8) = w;
    }
}

constexpr int PA_PITCH = 144;
DI void pool_wave(const Params& P, int l, int gw, int NGW, int lane, LAS unsigned char* wl) {
    const bf16_t* p = (const bf16_t*)(P.ws + WS_P); bf16_t* Y = (bf16_t*)(P.ws + WS_Y);
    const int g = gw & 3, r = lane & 31, hh = lane >> 5;
    const int win = 2 << g;
    LAS float* ost = (LAS float*)(wl + 7168);
    bf16x8 bw[4][2];
#pragma unroll
    for (int s = 0; s < 4; ++s)
#pragma unroll
        for (int db = 0; db < 2; ++db) {
            const float* wp = P.pool_w + ((size_t)(l * 4 + g) * 64 + 16 * s + 8 * hh) * 64 + 32 * db + r;
            u32x4 a; a.x = pk2(wp[0], wp[64]); a.y = pk2(wp[128], wp[192]); a.z = pk2(wp[256], wp[320]); a.w = pk2(wp[384], wp[448]);
            bw[s][db] = __builtin_bit_cast(bf16x8, a);
        }
    const f32x4 ps0 = *(const f32x4*)(P.pool_scale + l * 256 + g * 64 + (lane & 7) * 8), ps1 = *(const f32x4*)(P.pool_scale + l * 256 + g * 64 + (lane & 7) * 8 + 4);
    const int tstep = NGW >> 2;
    int tile = gw >> 2;
    if (tile >= MTOK / 32) return;
    u32x4 av[6], gv[4];
#pragma unroll
    for (int it = 0; it < 6; ++it) {
        const int row = (lane >> 3) + 8 * it;
        av[it] = (u32x4){0u, 0u, 0u, 0u};
        if (row >= 16 || ((tile * 32) & (SEQ - 1)) != 0) av[it] = *(const u32x4*)(p + (size_t)(tile * 32 - 16 + row) * NP + C_A + g * 64 + (lane & 7) * 8);
    }
#pragma unroll
    for (int it = 0; it < 4; ++it) gv[it] = *(const u32x4*)(p + (size_t)(tile * 32 + (lane >> 3) + 8 * it) * NP + C_GA + g * 64 + (lane & 7) * 8);
    for (;;) {
        const int tok0 = tile * 32, pos = (tok0 & (SEQ - 1)) + r;
#pragma unroll
        for (int it = 0; it < 6; ++it) *(LAS u32x4*)(wl + ((lane >> 3) + 8 * it) * PA_PITCH + (lane & 7) * 16) = av[it];
        const int ntile = tile + tstep;
        const bool has_next = ntile < MTOK / 32;
        if (has_next) {
#pragma unroll
            for (int it = 0; it < 6; ++it) {
                const int row = (lane >> 3) + 8 * it;
                av[it] = (u32x4){0u, 0u, 0u, 0u};
                if (row >= 16 || ((ntile * 32) & (SEQ - 1)) != 0) av[it] = *(const u32x4*)(p + (size_t)(ntile * 32 - 16 + row) * NP + C_A + g * 64 + (lane & 7) * 8);
            }
        }
        const int cnt = (pos + 1 < win) ? pos + 1 : win;
        const float inv = 1.f / (float)cnt;
        f32x16 acc0, acc1;
#pragma unroll
        for (int i = 0; i < 16; ++i) { acc0[i] = 0.f; acc1[i] = 0.f; }
#pragma unroll
        for (int s = 0; s < 4; ++s) {
            const LAS unsigned char* base = wl + (16 + r) * PA_PITCH + (16 * s + 8 * hh) * 2;
            const u32x4 own = *(const LAS u32x4*)base;
            float sum[8];
            sum[0] = bflo(own.x); sum[1] = bfhi(own.x); sum[2] = bflo(own.y); sum[3] = bfhi(own.y); sum[4] = bflo(own.z); sum[5] = bfhi(own.z); sum[6] = bflo(own.w); sum[7] = bfhi(own.w);
            for (int j = 1; j < win; ++j) {
                const u32x4 v = *(const LAS u32x4*)(base - j * PA_PITCH);
                sum[0] += bflo(v.x); sum[1] += bfhi(v.x); sum[2] += bflo(v.y); sum[3] += bfhi(v.y); sum[4] += bflo(v.z); sum[5] += bfhi(v.z); sum[6] += bflo(v.w); sum[7] += bfhi(v.w);
            }
            u32x4 a;
            a.x = pk2(sum[0] * inv - bflo(own.x), sum[1] * inv - bfhi(own.x)); a.y = pk2(sum[2] * inv - bflo(own.y), sum[3] * inv - bfhi(own.y));
            a.z = pk2(sum[4] * inv - bflo(own.z), sum[5] * inv - bfhi(own.z)); a.w = pk2(sum[6] * inv - bflo(own.w), sum[7] * inv - bfhi(own.w));
            const bf16x8 af = __builtin_bit_cast(bf16x8, a);
            acc0 = MFMA32(af, bw[s][0], acc0);
            acc1 = MFMA32(af, bw[s][1], acc1);
        }
#pragma unroll
        for (int i = 0; i < 16; ++i) { ost[crow(i, hh) * OST_PITCH + r] = acc0[i]; ost[crow(i, hh) * OST_PITCH + 32 + r] = acc1[i]; }
#pragma unroll
        for (int it = 0; it < 4; ++it) {
            const int q = (lane >> 3) + 8 * it;
            const LAS float* op = ost + q * OST_PITCH + (lane & 7) * 8;
            const f32x4 a = *(const LAS f32x4*)op, b = *(const LAS f32x4*)(op + 4);
            const u32x4 gq = gv[it];
            u32x4 w;
            w.x = pk2(a[0] * ps0[0] * silu_f(bflo(gq.x)), a[1] * ps0[1] * silu_f(bfhi(gq.x)));
            w.y = pk2(a[2] * ps0[2] * silu_f(bflo(gq.y)), a[3] * ps0[3] * silu_f(bfhi(gq.y)));
            w.z = pk2(b[0] * ps1[0] * silu_f(bflo(gq.z)), b[1] * ps1[1] * silu_f(bfhi(gq.z)));
            w.w = pk2(b[2] * ps1[2] * silu_f(bflo(gq.w)), b[3] * ps1[3] * silu_f(bfhi(gq.w)));
            *(u32x4*)(Y + (size_t)(tok0 + q) * D + g * 64 + (lane & 7) * 8) = w;
        }
        if (!has_next) break;
#pragma unroll
        for (int it = 0; it < 4; ++it) gv[it] = *(const u32x4*)(p + (size_t)(ntile * 32 + (lane >> 3) + 8 * it) * NP + C_GA + g * 64 + (lane & 7) * 8);
        tile = ntile;
    }
}

constexpr int KT_PITCH = 144;
constexpr int VT_OFF = 32 * KT_PITCH;
DI bool attn_tile(const bf16x8 (&qf)[4], f32x16& o0, f32x16& o1, float& carry, bool diag, LAS unsigned char* wl, int frd, int trbase, int r, int hh) {
    const float CZ = 0.125f * LOG2E;
    f32x16 z;
#pragma unroll
    for (int i = 0; i < 16; ++i) z[i] = 0.f;
#pragma unroll
    for (int s = 0; s < 4; ++s) { const bf16x8 kf = *(const LAS bf16x8*)(wl + frd + s * 32); z = MFMA32(kf, qf[s], z); }
    float l1m[16], lbv[16];
#pragma unroll
    for (int i = 0; i < 16; ++i) {
        const float t = z[i] * CZ;
        const float e = __builtin_amdgcn_exp2f(-fabsf(t));
        const float sp = fmaxf(t, 0.f) + __builtin_amdgcn_logf(1.f + e);
        l1m[i] = -sp; lbv[i] = t - sp;
    }
    if (diag) {
#pragma unroll
        for (int i = 0; i < 16; ++i) if (crow(i, hh) >= r) { l1m[i] = 0.f; lbv[i] = -__builtin_inff(); }
    }
    float gs[4], og[4];
#pragma unroll
    for (int q = 0; q < 4; ++q) { gs[q] = (l1m[4 * q] + l1m[4 * q + 1]) + (l1m[4 * q + 2] + l1m[4 * q + 3]); og[q] = swap32(gs[q], hh); }
    float suf = carry;
    float a[16];
#pragma unroll
    for (int q = 3; q >= 0; --q) {
        float lat = suf + (hh == 0 ? og[q] : 0.f);
        a[4 * q + 3] = __builtin_amdgcn_exp2f(lbv[4 * q + 3] + lat); lat += l1m[4 * q + 3];
        a[4 * q + 2] = __builtin_amdgcn_exp2f(lbv[4 * q + 2] + lat); lat += l1m[4 * q + 2];
        a[4 * q + 1] = __builtin_amdgcn_exp2f(lbv[4 * q + 1] + lat); lat += l1m[4 * q + 1];
        a[4 * q] = __builtin_amdgcn_exp2f(lbv[4 * q] + lat);
        suf += gs[q] + og[q];
    }
    carry = suf;
    u32x4 pa0, pa1;
    pa0.x = pk2(a[0], a[1]); pa0.y = pk2(a[2], a[3]); pa0.z = pk2(a[4], a[5]); pa0.w = pk2(a[6], a[7]);
    pa1.x = pk2(a[8], a[9]); pa1.y = pk2(a[10], a[11]); pa1.z = pk2(a[12], a[13]); pa1.w = pk2(a[14], a[15]);
    bf16x8 vf[2][2];
#pragma unroll
    for (int s = 0; s < 2; ++s)
#pragma unroll
        for (int db = 0; db < 2; ++db) {
            const v4i16_t lo = lds_tr16(wl + trbase + db * 2048 + (16 * s) * 64), hi = lds_tr16(wl + trbase + db * 2048 + (16 * s + 8) * 64);
            vf[s][db] = __builtin_shufflevector(lo, hi, 0, 1, 2, 3, 4, 5, 6, 7);
        }
    o0 = MFMA32(__builtin_bit_cast(bf16x8, pa0), vf[0][0], o0);
    o0 = MFMA32(__builtin_bit_cast(bf16x8, pa1), vf[1][0], o0);
    o1 = MFMA32(__builtin_bit_cast(bf16x8, pa0), vf[0][1], o1);
    o1 = MFMA32(__builtin_bit_cast(bf16x8, pa1), vf[1][1], o1);
    return __ballot(carry > -160.f) == 0ull;
}
DI void attn_store(const f32x16& o0, const f32x16& o1, LAS float* ost, int lane, const bf16_t* gp  , bf16_t* yp  ) {
    const int r = lane & 31, hh = lane >> 5;
    u32x4 gt[4];
#pragma unroll
    for (int it = 0; it < 4; ++it) gt[it] = *(const u32x4*)(gp + (size_t)it * 8 * NP);
#pragma unroll
    for (int i = 0; i < 16; ++i) { ost[crow(i, hh) * OST_PITCH + r] = o0[i]; ost[crow(i, hh) * OST_PITCH + 32 + r] = o1[i]; }
#pragma unroll
    for (int it = 0; it < 4; ++it) {
        const LAS float* op = ost + ((lane >> 3) + 8 * it) * OST_PITCH + (lane & 7) * 8;
        const f32x4 a = *(const LAS f32x4*)op, bq = *(const LAS f32x4*)(op + 4);
        const u32x4 g = gt[it];
        u32x4 w;
        w.x = pk2(a[0] * silu_f(bflo(g.x)), a[1] * silu_f(bfhi(g.x)));
        w.y = pk2(a[2] * silu_f(bflo(g.y)), a[3] * silu_f(bfhi(g.y)));
        w.z = pk2(bq[0] * silu_f(bflo(g.z)), bq[1] * silu_f(bfhi(g.z)));
        w.w = pk2(bq[2] * silu_f(bflo(g.w)), bq[3] * silu_f(bfhi(g.w)));
        *(u32x4*)(yp + (size_t)it * 8 * D) = w;
    }
}
DI void attn_wave(const Params& P, int gw, int NGW, int lane, LAS unsigned char* wl) {
    const bf16_t* p = (const bf16_t*)(P.ws + WS_P); bf16_t* Y = (bf16_t*)(P.ws + WS_Y);
    constexpr int NU = BATCH * 8 * 32;
    const int r = lane & 31, hh = lane >> 5;
    LAS float* ost = (LAS float*)wl;
    const int klds = (lane >> 3) * KT_PITCH + (lane & 7) * 16;
    const int vlds = VT_OFF + ((lane & 7) >> 2) * 2048 + (lane >> 3) * 64 + (lane & 3) * 16;
    const int frd = r * KT_PITCH + hh * 16;
    const int trbase = VT_OFF + (4 * hh + ((lane & 15) >> 2)) * 64 + ((lane >> 4) & 1) * 32 + (lane & 3) * 8;
    const bf16_t* qb = (const bf16_t*)(P.ws + WS_QKV); const bf16_t* kbuf = qb + QKV_ONE; const bf16_t* vbuf = qb + 2 * QKV_ONE;
    for (int unit = gw; unit < NU; unit += NGW) {
        const int j = unit & 31, pair = unit >> 5, h = pair & 7, b = pair >> 3;
        const size_t pairoff = (size_t)pair * QKV_PAIR + (size_t)lane * 8;
        const bf16_t* kp0 = kbuf + pairoff; const bf16_t* vp0 = vbuf + pairoff;
        const int qtB = 2 * j + 1, qtA = 2 * j;
        u32x4 kn[4], vn[4];
        bf16x8 qfA[4], qfB[4];
        {
            u32x4 qa[4], qv[4];
#pragma unroll
            for (int it = 0; it < 4; ++it) qa[it] = *(const u32x4*)(qb + pairoff + (size_t)qtA * 2048 + it * 512);
#pragma unroll
            for (int it = 0; it < 4; ++it) qv[it] = *(const u32x4*)(qb + pairoff + (size_t)qtB * 2048 + it * 512);
#pragma unroll
            for (int it = 0; it < 4; ++it) kn[it] = *(const u32x4*)(kp0 + (size_t)qtB * 2048 + it * 512);
#pragma unroll
            for (int it = 0; it < 4; ++it) vn[it] = *(const u32x4*)(vp0 + (size_t)qtB * 2048 + it * 512);
#pragma unroll
            for (int it = 0; it < 4; ++it) *(LAS u32x4*)(wl + klds + it * 8 * KT_PITCH) = qa[it];
#pragma unroll
            for (int s = 0; s < 4; ++s) qfA[s] = *(const LAS bf16x8*)(wl + frd + s * 32);
#pragma unroll
            for (int it = 0; it < 4; ++it) *(LAS u32x4*)(wl + klds + it * 8 * KT_PITCH) = qv[it];
#pragma unroll
            for (int s = 0; s < 4; ++s) qfB[s] = *(const LAS bf16x8*)(wl + frd + s * 32);
        }
        f32x16 oA0, oA1, oB0, oB1;
#pragma unroll
        for (int i = 0; i < 16; ++i) { oA0[i] = 0.f; oA1[i] = 0.f; oB0[i] = 0.f; oB1[i] = 0.f; }
        float carryA = 0.f, carryB = 0.f;
        bool doneA = false, doneB = false;
        for (int kb = qtB; kb >= 0; --kb) {
#pragma unroll
            for (int it = 0; it < 4; ++it) *(LAS u32x4*)(wl + klds + it * 8 * KT_PITCH) = kn[it];
#pragma unroll
            for (int it = 0; it < 4; ++it) *(LAS u32x4*)(wl + vlds + it * 512) = vn[it];
            if (kb > 0) {
                const size_t o = (size_t)(kb - 1) * 2048;
#pragma unroll
                for (int it = 0; it < 4; ++it) kn[it] = *(const u32x4*)(kp0 + o + it * 512);
#pragma unroll
                for (int it = 0; it < 4; ++it) vn[it] = *(const u32x4*)(vp0 + o + it * 512);
            }
            if (!doneB) doneB = attn_tile(qfB, oB0, oB1, carryB, kb == qtB, wl, frd, trbase, r, hh);
            if (kb <= qtA && !doneA) doneA = attn_tile(qfA, oA0, oA1, carryA, kb == qtA, wl, frd, trbase, r, hh);
            if (doneA && doneB) break;
        }
        const size_t tokb = (size_t)b * SEQ;
        const bf16_t* gp = p + (tokb + qtA * 32 + (lane >> 3)) * NP + C_GC + h * 64 + (lane & 7) * 8;
        bf16_t* yp = Y + (tokb + qtA * 32 + (lane >> 3)) * D + 512 + h * 64 + (lane & 7) * 8;
        attn_store(oA0, oA1, ost, lane, gp, yp);
        attn_store(oB0, oB1, ost, lane, gp + (size_t)32 * NP, yp + (size_t)32 * D);
    }
}

DI void mixers(const Params& P, int l, LAS unsigned char* lds, int lane, int wave) {
    lane = launder_v(lane); wave = launder_s(wave);
    const int gw = blockIdx.x * NWAVES + wave, NGW = gridDim.x * NWAVES;
#ifndef MXMASK
#define MXMASK 7
#endif
    for (int rep = 0; rep < ((DUP & 4) ? 2 : 1); ++rep)
    if (MXMASK & 1) for (int unit = blockIdx.x; unit < BATCH * 16; unit += gridDim.x) sgu_unit(P, l, unit, lds, launder_v(threadIdx.x), lane, wave);
    for (int rep = 0; rep < ((DUP & 8) ? 2 : 1); ++rep)
    if (MXMASK & 2) pool_wave(P, l, gw, NGW, lane, lds + wave * 16384);
    for (int rep = 0; rep < ((DUP & 16) ? 2 : 1); ++rep)
    if (MXMASK & 4) attn_wave(P, gw, NGW, lane, lds + wave * 16384);
}

__global__ void __launch_bounds__(NTHREADS, 2) fwd_mega(Params P) {
    extern __shared__ __attribute__((aligned(16))) unsigned char lds_raw[];
    LAS unsigned char* lds = (LAS unsigned char*)lds_raw;
    cg::grid_group grid = cg::this_grid();
    const int tid = threadIdx.x, lane = tid & 63, wave = __builtin_amdgcn_readfirstlane(tid >> 6);
    const int lo = P.ph_lo, hi = P.ph_hi;
    volatile LAS unsigned* bst = (volatile LAS unsigned*)(lds + LDS_BYTES - 4096);
    if (tid < 2) bst[tid] = 0u;
    __syncthreads();
    const XcdBarrier xbar = xcd_barrier_post((unsigned*)(P.ws + WS_BAR), bst);
#ifndef PHMASK
#define PHMASK 0x3ff
#endif
#define IN(k) (((PHMASK >> (k)) & 1) && lo <= (k) && (k) < hi)
#define SEAM(k) do { if (IN(k) && IN((k) + 1)) { if ((k) == 0) grid.sync(); else xcd_barrier(xbar); } } while (0)
    bf16_t* hb = (bf16_t*)(P.ws + WS_HB); bf16_t* pbuf = (bf16_t*)(P.ws + WS_P); bf16_t* ybuf = (bf16_t*)(P.ws + WS_Y);
    const bf16_t* win_t = (const bf16_t*)(P.ws + WS_WIN); const bf16_t* wout_t = (const bf16_t*)(P.ws + WS_WOUT);
    const float* mod = (const float*)(P.ws + WS_MOD);

    if (IN(0)) for (int rep = 0; rep < ((DUP & 64) ? 2 : 1); ++rep) phase0(P, lds, tid, lane, wave);
    SEAM(0);
    if (IN(1)) for (int rep = 0; rep < ((DUP & 32) ? 2 : 1); ++rep) row_pass<0>(P, lane, wave);
    SEAM(1);
#pragma unroll 1
    for (int l = 0; l < DEPTH; ++l) {
        const int pb = 2 + 4 * l;
        if (IN(pb)) for (int rep = 0; rep < ((DUP & 1) ? 2 : 1); ++rep) {
            pg8::Gemm g{hb, win_t + (size_t)l * NIN * D, MTOK, NIN, D}; pg8::StaticOrder S; S.init(MTOK, NIN, (int)gridDim.x, (int)blockIdx.x);
            EpiP E{pbuf, (bf16_t*)(P.ws + WS_QKV)};
            pg8::gemm_phase<EpiP, pg8::StaticOrder, true, true>(lds, g, S, E);
        }
        SEAM(pb);
        if (IN(pb + 1)) mixers(P, l, lds, lane, wave);
        SEAM(pb + 1);
        if (IN(pb + 2)) for (int rep = 0; rep < ((DUP & 2) ? 2 : 1); ++rep) {
            pg8::Gemm g{ybuf, wout_t + (size_t)l * D * D, MTOK, D, D}; pg8::StaticOrder S; S.init(MTOK, D, (int)gridDim.x, (int)blockIdx.x);
            EpiRes E{P.x, l == 0 ? nullptr : (const bf16_t*)(P.ws + WS_R0), (const float*)(P.ws + WS_RSTAT), P.ln_g, P.ln_b,
                     mod + (size_t)l * BATCH * 3072 + 2048, (bf16_t*)(P.ws + (l == 0 ? WS_R0 : WS_R1)), (float*)(P.ws + WS_PSTAT)};
            pg8::gemm_phase<EpiRes, pg8::StaticOrder, true, true>(lds, g, S, E);
        }
        SEAM(pb + 2);
        if (IN(pb + 3)) { if (l == 0) { for (int rep = 0; rep < ((DUP & 32) ? 2 : 1); ++rep) row_pass<1>(P, lane, wave); } else row_pass<2>(P, lane, wave); }
        SEAM(pb + 3);
    }
#undef IN
#undef SEAM
}

#ifndef N_LAUNCH_PER_PHASE
#define N_LAUNCH_PER_PHASE 0
#endif
extern "C" void kernel_launch(void* const* d_in, const int* in_sizes, int n_in, void* d_out, int out_size, void* d_ws, size_t ws_size, hipStream_t stream) {
    static int grid = 0;
    if (grid == 0) {
        if (n_in != 14 || out_size != MTOK * D || ws_size < WS_END) { fprintf(stderr, "kernel_launch: unexpected shapes (n_in %d out %d ws %zu need %zu)\n", n_in, out_size, ws_size, (size_t)WS_END); grid = -1; return; }
        int dev = 0, cus = 0, per_cu = 0;
        hipGetDevice(&dev);
        hipDeviceGetAttribute(&cus, hipDeviceAttributeMultiprocessorCount, dev);
        if (hipFuncSetAttribute((const void*)fwd_mega, hipFuncAttributeMaxDynamicSharedMemorySize, LDS_BYTES) != hipSuccess) { fprintf(stderr, "kernel_launch: hipFuncSetAttribute failed\n"); grid = -1; return; }
        if (hipOccupancyMaxActiveBlocksPerMultiprocessor(&per_cu, (const void*)fwd_mega, NTHREADS, LDS_BYTES) != hipSuccess || per_cu < 1) { fprintf(stderr, "kernel_launch: occupancy query says %d\n", per_cu); per_cu = 1; }
        (void)hipGetLastError();
        grid = cus * 1;
        if (grid != 256) fprintf(stderr, "kernel_launch: note: grid %d\n", grid);
    }
    if (grid < 0) return;
    Params p{};
    p.x = (const float*)d_in[0]; p.c = (const float*)d_in[1]; p.w_in = (const float*)d_in[2]; p.pool_w = (const float*)d_in[3]; p.pool_scale = (const float*)d_in[4];
    p.sgu_ln_g = (const float*)d_in[5]; p.sgu_ln_b = (const float*)d_in[6]; p.sgu_w = (const float*)d_in[7]; p.sgu_b = (const float*)d_in[8]; p.w_out = (const float*)d_in[9];
    p.ada_w = (const float*)d_in[10]; p.ada_b = (const float*)d_in[11]; p.ln_g = (const float*)d_in[12]; p.ln_b = (const float*)d_in[13];
    p.out = (float*)d_out; p.ws = (unsigned char*)d_ws;
#if N_LAUNCH_PER_PHASE
    for (int ph = 0; ph < 10; ++ph) {
        p.ph_lo = ph; p.ph_hi = ph + 1;
        hipLaunchKernelGGL(fwd_mega, dim3(grid), dim3(NTHREADS), LDS_BYTES, stream, p);
    }
#else
    p.ph_lo = 0; p.ph_hi = 10;
    if (hipMemsetAsync((char*)d_ws + WS_BAR, 0, 16384, stream) != hipSuccess) { fprintf(stderr, "kernel_launch: hipMemsetAsync of the barrier words failed\n"); return; }
    void* args[] = {&p};
    hipError_t e = hipLaunchCooperativeKernel((const void*)fwd_mega, dim3(grid), dim3(NTHREADS), args, LDS_BYTES, stream);
    if (e != hipSuccess) fprintf(stderr, "kernel_launch: cooperative launch failed: %s (grid %d)\n", hipGetErrorString(e), grid);
#endif
}
```
